# Optimizing an MI355X kernel written in HIP

```python
import math
import jax, jax.numpy as jnp
from jax import lax
import numpy as np

D_MODEL = 1024
BATCH = 4
SEQ = 4096
DEPTH = 2
DEC_BATCH = 2
DEC_SEQ = 8192
PAST_LEN = 128

N_EVEN = (DEPTH + 1) // 2
N_ODD = DEPTH // 2
D_FF = 4 * D_MODEL
EPS = 1e-5
A_WIDTH = D_MODEL // 2
A_GROUPS = 4
A_GROUP_DIM = A_WIDTH // A_GROUPS
CHUNK = 128
B_HEADS = 4
B_QK_DIM = 64
B_V_DIM = 2 * B_QK_DIM
B_WIDTH = B_HEADS * B_V_DIM
Q_BLOCK = 128
ROT_DIM = B_QK_DIM // 4
ROPE_THETA = 500000.0
E_IN = 2 * A_WIDTH + 2 * B_HEADS * 2 * B_QK_DIM + B_WIDTH
E_MIX = A_WIDTH + B_WIDTH
CONV_W = 3

kernel_name = "hybrid_gmlp_diffattn_shortconv_encoder"


def _rmsnorm(x, g):
    x32 = x.astype(jnp.float32)
    y = x32 * lax.rsqrt(jnp.mean(x32 * x32, axis=-1, keepdims=True) + EPS)
    return y.astype(x.dtype) * g


def _lambda_init(layer_idx):
    return 0.8 - 0.6 * math.exp(-0.3 * layer_idx)


def _rope_tables(seq_len, dtype):
    inv = ROPE_THETA ** (-jnp.arange(0, ROT_DIM, 2, dtype=jnp.float32) / ROT_DIM)
    ang = jnp.arange(seq_len, dtype=jnp.float32)[:, None] * inv[None, :]
    return jnp.cos(ang).astype(dtype), jnp.sin(ang).astype(dtype)


def _rope(x, cos, sin):
    xr, xp = x[..., :ROT_DIM], x[..., ROT_DIM:]
    half = ROT_DIM // 2
    x1, x2 = xr[..., :half], xr[..., half:]
    c, s = cos[None, :, None, :], sin[None, :, None, :]
    return jnp.concatenate([x1 * c - x2 * s, x2 * c + x1 * s, xp], axis=-1)


def _gmlp_spatial(a_u, a_v, vnorm_g, w_s, b_s):
    bsz, s, _ = a_u.shape
    u = jax.nn.gelu(a_u)
    v = jax.nn.gelu(a_v).reshape(bsz, s, A_GROUPS, A_GROUP_DIM)
    v = _rmsnorm(v, vnorm_g.reshape(A_GROUPS, A_GROUP_DIM))
    v = v.reshape(bsz, s // CHUNK, CHUNK, A_GROUPS, A_GROUP_DIM)
    mixed = jnp.einsum('gpq,bcqge->bcpge', w_s, v) + b_s.T[None, None, :, :, None]
    return u * mixed.reshape(bsz, s, A_WIDTH)


def _diff_attention(q, k, v, lq1, lk1, lq2, lk2, subln_g, layer_idx):
    bsz, s, _ = q.shape
    q = q.reshape(bsz, s, B_HEADS, 2, B_QK_DIM)
    k = k.reshape(bsz, s, B_HEADS, 2, B_QK_DIM)
    v = v.reshape(bsz, s, B_HEADS, B_V_DIM)
    cos, sin = _rope_tables(s, q.dtype)
    q1, q2 = _rope(q[:, :, :, 0], cos, sin), _rope(q[:, :, :, 1], cos, sin)
    k1, k2 = _rope(k[:, :, :, 0], cos, sin), _rope(k[:, :, :, 1], cos, sin)
    lam_init = _lambda_init(layer_idx)
    lam = (jnp.exp(jnp.sum(lq1.astype(jnp.float32) * lk1.astype(jnp.float32)))
           - jnp.exp(jnp.sum(lq2.astype(jnp.float32) * lk2.astype(jnp.float32))) + lam_init)
    scale = 1.0 / math.sqrt(B_QK_DIM)
    nblk = s // Q_BLOCK

    def to_blocks(t):
        return t.reshape(bsz, nblk, Q_BLOCK, B_HEADS, B_QK_DIM).transpose(1, 0, 2, 3, 4)

    def block(args):
        q1b, q2b = args
        s1 = jnp.einsum('bqhd,bkhd->bhqk', q1b, k1).astype(jnp.float32) * scale
        s2 = jnp.einsum('bqhd,bkhd->bhqk', q2b, k2).astype(jnp.float32) * scale
        p = jax.nn.softmax(s1, axis=-1) - lam * jax.nn.softmax(s2, axis=-1)
        return jnp.einsum('bhqk,bkhe->bqhe', p.astype(v.dtype), v)

    o = lax.map(block, (to_blocks(q1), to_blocks(q2)))
    o = o.transpose(1, 0, 2, 3, 4).reshape(bsz, s, B_HEADS, B_V_DIM)
    o = _rmsnorm(o, subln_g) * (1.0 - lam_init)
    return o.reshape(bsz, s, B_WIDTH)


def _short_conv(xn, w_in, conv_w, w_out):
    z = xn @ w_in
    bg, cg, h = jnp.split(z, 3, axis=-1)
    t = cg * h
    tp = jnp.pad(t, ((0, 0), (1, 1), (0, 0)))
    y = tp[:, :-2] * conv_w[0] + tp[:, 1:-1] * conv_w[1] + tp[:, 2:] * conv_w[2]
    return (bg * y) @ w_out


def _ffn(xn, w1, w2):
    return jnp.square(jax.nn.relu(xn @ w1)) @ w2


def _trunk(x, norm_mix_g, norm_ffn_g, ffn_w1, ffn_w2, e_w_in, e_w_out, a_vnorm_g, a_w_s, a_b_s,
           b_lq1, b_lk1, b_lq2, b_lk2, b_subln_g, c_w_in, c_conv_w, c_w_out, final_g):
    h = x
    splits = [A_WIDTH, 2 * A_WIDTH, 2 * A_WIDTH + 2 * B_HEADS * B_QK_DIM,
              2 * A_WIDTH + 4 * B_HEADS * B_QK_DIM]
    for i in range(DEPTH):
        xn = _rmsnorm(h, norm_mix_g[i])
        if i % 2 == 0:
            e = i // 2
            z = xn @ e_w_in[e]
            a_u, a_v, q, k, v = jnp.split(z, splits, axis=-1)
            out_a = _gmlp_spatial(a_u, a_v, a_vnorm_g[e], a_w_s[e], a_b_s[e])
            out_b = _diff_attention(q, k, v, b_lq1[e], b_lk1[e], b_lq2[e], b_lk2[e], b_subln_g[e], i)
            h = h + jnp.concatenate([out_a, out_b], axis=-1) @ e_w_out[e]
        else:
            o = i // 2
            h = h + _short_conv(xn, c_w_in[o], c_conv_w[o], c_w_out[o])
        h = h + _ffn(_rmsnorm(h, norm_ffn_g[i]), ffn_w1[i], ffn_w2[i])
    return _rmsnorm(h, final_g)


def setup_inputs(seed: int = 0) -> dict:
    key = jax.random.key(seed)
    ks = jax.random.split(key, 24)
    f32 = jnp.float32
    n = lambda k, shape, s: jax.random.normal(k, shape, f32) * s
    return {
        "x_prompt": n(ks[0], (BATCH, SEQ, D_MODEL), 1.0),
        "x_sample": n(ks[1], (DEC_BATCH, DEC_SEQ, D_MODEL), 1.0),
        "norm_mix_g": 1.0 + n(ks[2], (DEPTH, D_MODEL), 0.02),
        "norm_ffn_g": 1.0 + n(ks[3], (DEPTH, D_MODEL), 0.02),
        "ffn_w1": n(ks[4], (DEPTH, D_MODEL, D_FF), D_MODEL ** -0.5),
        "ffn_w2": n(ks[5], (DEPTH, D_FF, D_MODEL), 0.5 * D_FF ** -0.5),
        "e_w_in": n(ks[6], (N_EVEN, D_MODEL, E_IN), D_MODEL ** -0.5),
        "e_w_out": n(ks[7], (N_EVEN, E_MIX, D_MODEL), E_MIX ** -0.5),
        "a_vnorm_g": 1.0 + n(ks[8], (N_EVEN, A_WIDTH), 0.02),
        "a_w_s": n(ks[9], (N_EVEN, A_GROUPS, CHUNK, CHUNK), CHUNK ** -0.5),
        "a_b_s": 1.0 + n(ks[10], (N_EVEN, A_GROUPS, CHUNK), 0.02),
        "b_lq1": n(ks[11], (N_EVEN, B_QK_DIM), 0.1),
        "b_lk1": n(ks[12], (N_EVEN, B_QK_DIM), 0.1),
        "b_lq2": n(ks[13], (N_EVEN, B_QK_DIM), 0.1),
        "b_lk2": n(ks[14], (N_EVEN, B_QK_DIM), 0.1),
        "b_subln_g": 1.0 + n(ks[15], (N_EVEN, B_V_DIM), 0.02),
        "c_w_in": n(ks[16], (N_ODD, D_MODEL, 3 * D_MODEL), D_MODEL ** -0.5),
        "c_conv_w": n(ks[17], (N_ODD, CONV_W, D_MODEL), CONV_W ** -0.5),
        "c_w_out": n(ks[18], (N_ODD, D_MODEL, D_MODEL), D_MODEL ** -0.5),
        "final_g": 1.0 + n(ks[19], (D_MODEL,), 0.02),
    }


def reference(x_prompt, x_sample, norm_mix_g, norm_ffn_g, ffn_w1, ffn_w2, e_w_in, e_w_out,
              a_vnorm_g, a_w_s, a_b_s, b_lq1, b_lk1, b_lq2, b_lk2, b_subln_g,
              c_w_in, c_conv_w, c_w_out, final_g):
    y_prompt = _trunk(x_prompt, norm_mix_g, norm_ffn_g, ffn_w1, ffn_w2, e_w_in, e_w_out, a_vnorm_g,
                      a_w_s, a_b_s, b_lq1, b_lk1, b_lq2, b_lk2, b_subln_g, c_w_in, c_conv_w,
                      c_w_out, final_g)
    y_sample = _trunk(x_sample, norm_mix_g, norm_ffn_g, ffn_w1, ffn_w2, e_w_in, e_w_out, a_vnorm_g,
                      a_w_s, a_b_s, b_lq1, b_lk1, b_lq2, b_lk2, b_subln_g, c_w_in, c_conv_w,
                      c_w_out, final_g)
    return (y_prompt, y_sample)
```

```cpp
#include <hip/hip_runtime.h>
#include <hip/hip_cooperative_groups.h>
#include <cstdio>
#include <cstdint>
namespace cg = cooperative_groups;
namespace pg8 {
#define PG8_LAS __attribute__((address_space(3)))
typedef unsigned short bf16_t;
typedef short bf16x8 __attribute__((ext_vector_type(8)));
typedef float f32x4 __attribute__((ext_vector_type(4)));
typedef unsigned u32x4 __attribute__((ext_vector_type(4)));
constexpr int BM = 256, BK = 64, HALF = 128, HTB = HALF * BK * 2  , STAGE_BYTES = 8 * HTB, NXCD = 8, WGM = 8;

__host__ __device__ __forceinline__ int lds_byte(int r, int c) { const int st = (r >> 4) * 2 + (c >> 5), rr = r & 15, cc = c & 31, ob = rr * 64 + cc * 2; return st * 1024 + (ob ^ (((ob >> 9) & 1) << 5)); }
__host__ __device__ __forceinline__ void stage_rc(int b, int& R, int& C) { const int st = b / 1024, sb = b % 1024, swz = sb ^ (((sb >> 9) & 1) << 5); R = (st >> 1) * 16 + swz / 64; C = (st & 1) * 32 + (swz % 64) / 2; }
__host__ __device__ __forceinline__ int perm32(int rho) { const int n = rho >> 4, i = rho & 15; return 8 * (i >> 2) + 4 * n + (i & 3); }

struct Unit { int pm, pn; };
struct Gemm { const bf16_t* A; const bf16_t* Bt; int M, N, K; };

struct StaticOrder {
    int nM, nN, nwg, G, c;
    __host__ __device__ void init(int M, int N, int G_, int c_) { nM = M / BM; nN = N / BM; nwg = nM * nN; G = G_; c = c_; }
    __host__ __device__ bool next(int i, Unit& u) const {
        const long L = (long)i * G + c; if (L >= nwg) return false;
        int wgid = (int)L; { const int q = nwg / NXCD, r = nwg % NXCD, xcd = wgid % NXCD, off = wgid / NXCD; wgid = (xcd < r ? xcd * (q + 1) : r * (q + 1) + (xcd - r) * q) + off; }
        const int nig = WGM * nN, gid = wgid / nig, fm = gid * WGM, gsz = (nM - fm) < WGM ? (nM - fm) : WGM;
        u.pm = fm + ((wgid % nig) % gsz); u.pn = (wgid % nig) / gsz; return true;
    }
    __device__ __forceinline__ void a_ready(const Unit&) const {}
    __device__ __forceinline__ void done(const Unit&) const {}
};

__device__ __forceinline__ unsigned cvt_pk_bf16(float lo, float hi) { unsigned r; asm volatile("v_cvt_pk_bf16_f32 %0, %1, %2" : "=v"(r) : "v"(lo), "v"(hi)); return r; }
typedef float f32x2 __attribute__((ext_vector_type(2)));
__device__ __forceinline__ f32x2 gelu_pk(f32x2 v) {
    const f32x2 av = __builtin_elementwise_abs(v), d = av * 0.2316418882f + 1.0f;
    f32x2 t; t.x = __builtin_amdgcn_rcpf(d.x); t.y = __builtin_amdgcn_rcpf(d.y);
    f32x2 q = t * 0.5307027145f + (-0.7265760135f); q = q * t + 0.7107068705f; q = q * t + (-0.142248368f); q = q * t + 0.127414796f; q = q * t;
    const f32x2 s = (v * v) * (-0.72134752044f);
    f32x2 e; e.x = __builtin_amdgcn_exp2f(s.x); e.y = __builtin_amdgcn_exp2f(s.y);
    const f32x2 m = v * (q * e), r = v - m;
    f32x2 o; o.x = v.x < 0.f ? m.x : r.x; o.y = v.y < 0.f ? m.y : r.y; return o;
}

template <class Epi, class Sched, bool ALIGN_EPI = false, bool SP2 = false>
__device__ __forceinline__ void gemm_phase(PG8_LAS unsigned char* lds, const Gemm g, const Sched& S, const Epi& E) {
    int tid_ = threadIdx.x; asm volatile("" : "+v"(tid_));
    const int tid = tid_, wid = __builtin_amdgcn_readfirstlane(tid >> 6), lane = tid & 63, wr = wid >> 2, wc = wid & 3, fr = lane & 15, fq = lane >> 4;
    const int K = g.K, nt = K / BK;
    unsigned voffA[2], voffB[2];
#pragma unroll
    for (int i = 0; i < 2; ++i) { int R, C; stage_rc(tid * 16 + i * 8192, R, C); const int Rb = Epi::PERM ? ((R & ~31) + perm32(R & 31)) : R;
        voffA[i] = (unsigned)(R * K + C) * 2u; voffB[i] = (unsigned)(Rb * K + C) * 2u; }
    const size_t kstep = (size_t)(BK * 2);
    const size_t hstep = (size_t)HALF * K * 2;
    const size_t tstep = 2 * hstep;
    const unsigned ldsw = (unsigned)wid * 1024u;
    const int aoff = lds_byte(wr * 64 + fr, fq * 8), boff = lds_byte(wc * 32 + fr, fq * 8);
#define PG8_SA(b, h) (((b) * 2 + (h)) * HTB)
#define PG8_SB(b, h) ((4 + (b) * 2 + (h)) * HTB)
#define PG8_STAGE(bufoff, gbase, voff) do { _Pragma("unroll") for (int _i = 0; _i < 2; ++_i) \
        __builtin_amdgcn_global_load_lds((const unsigned*)((const char*)(gbase) + (voff)[_i]), (PG8_LAS unsigned*)(lds + (bufoff) + ldsw + _i * 8192), 16, 0, 0); } while (0)
#define PG8_LDA(dst, b, h) do { _Pragma("unroll") for (int m = 0; m < 4; ++m) _Pragma("unroll") for (int k = 0; k < 2; ++k) dst[m][k] = *(const PG8_LAS bf16x8*)(lds + PG8_SA(b, h) + aoff + m * 2048 + k * 1024); } while (0)
#define PG8_LDB(dst, b, h) do { _Pragma("unroll") for (int n = 0; n < 2; ++n) _Pragma("unroll") for (int k = 0; k < 2; ++k) dst[n][k] = *(const PG8_LAS bf16x8*)(lds + PG8_SB(b, h) + boff + n * 2048 + k * 1024); } while (0)
#define PG8_MMA(ai, bj, At, Bt) do { __builtin_amdgcn_s_setprio(1); _Pragma("unroll") for (int m = 0; m < 4; ++m) _Pragma("unroll") for (int n = 0; n < 2; ++n) _Pragma("unroll") for (int k = 0; k < 2; ++k) \
        acc[ai][bj][m][n] = __builtin_amdgcn_mfma_f32_16x16x32_bf16(Bt[n][k], At[m][k], acc[ai][bj][m][n], 0, 0, 0); __builtin_amdgcn_s_setprio(0); } while (0)
#define PG8_WAIT_V(n) asm volatile("s_waitcnt vmcnt(" #n ")" ::: "memory")
#define PG8_WAIT_L(n) asm volatile("s_waitcnt lgkmcnt(" #n ")" ::: "memory")
#define PG8_BAR __builtin_amdgcn_s_barrier()
#define PG8_SCHED __builtin_amdgcn_sched_barrier(0)
    Unit cur, nxt; int ui = 0;
    if (!S.next(0, cur)) return;
    f32x4 acc[2][2][4][2];
#pragma unroll
    for (int a = 0; a < 2; ++a)
#pragma unroll
        for (int b = 0; b < 2; ++b)
#pragma unroll
            for (int m = 0; m < 4; ++m)
#pragma unroll
                for (int n = 0; n < 2; ++n) acc[a][b][m][n] = (f32x4){0.f, 0.f, 0.f, 0.f};
    bf16x8 At[4][2], B0[2][2], B1[2][2];
    const char* cA = (const char*)g.A + (size_t)cur.pm * tstep; const char* cB = (const char*)g.Bt + (size_t)cur.pn * tstep;
    S.a_ready(cur);
    if constexpr (SP2) {
        PG8_STAGE(PG8_SB(0, 0), cB, voffB); PG8_STAGE(PG8_SB(0, 1), cB + hstep, voffB); PG8_STAGE(PG8_SA(0, 0), cA, voffA); PG8_STAGE(PG8_SA(0, 1), cA + hstep, voffA);
        if (wr == 1) PG8_BAR;
        PG8_WAIT_V(2); PG8_BAR;
        PG8_STAGE(PG8_SB(1, 0), cB + kstep, voffB); PG8_STAGE(PG8_SA(1, 0), cA + kstep, voffA); PG8_STAGE(PG8_SB(1, 1), cB + hstep + kstep, voffB);
        PG8_WAIT_V(6); PG8_BAR;
    } else {
        PG8_STAGE(PG8_SB(0, 0), cB, voffB); PG8_STAGE(PG8_SA(0, 0), cA, voffA); PG8_STAGE(PG8_SB(0, 1), cB + hstep, voffB); PG8_STAGE(PG8_SA(0, 1), cA + hstep, voffA);
        if (wr == 1) PG8_BAR;
        PG8_WAIT_V(4); PG8_BAR;
        PG8_STAGE(PG8_SB(1, 0), cB + kstep, voffB); PG8_STAGE(PG8_SA(1, 0), cA + kstep, voffA); PG8_STAGE(PG8_SB(1, 1), cB + hstep + kstep, voffB);
        PG8_WAIT_V(6); PG8_BAR;
    }
    for (;;) {
        const bool has_next = S.next(ui + 1, nxt);
        const char* nA = has_next ? (const char*)g.A + (size_t)nxt.pm * tstep : cA; const char* nB = has_next ? (const char*)g.Bt + (size_t)nxt.pn * tstep : cB;
        for (int t = 0; t < nt; t += 2) {
            const bool last = (t == nt - 2);
            const char* a1 = cA + (size_t)(t + 1) * kstep;
            const char* a2 = last ? nA : cA + (size_t)(t + 2) * kstep; const char* b2 = last ? nB : cB + (size_t)(t + 2) * kstep;
            const char* a3 = a2 + kstep; const char* b3 = b2 + kstep;
            if (last && has_next) S.a_ready(nxt);
            if constexpr (SP2) {
            PG8_LDB(B0, 0, 0); PG8_LDB(B1, 0, 1); PG8_SCHED; PG8_LDA(At, 0, 0); PG8_STAGE(PG8_SA(1, 1), a1 + hstep, voffA);
            PG8_WAIT_V(8); PG8_WAIT_L(0); PG8_BAR; PG8_MMA(0, 0, At, B0); PG8_MMA(0, 1, At, B1); PG8_BAR; PG8_SCHED;
            PG8_LDA(At, 0, 1); PG8_STAGE(PG8_SB(0, 0), b2, voffB); PG8_STAGE(PG8_SB(0, 1), b2 + hstep, voffB); PG8_STAGE(PG8_SA(0, 0), a2, voffA);
            PG8_WAIT_V(8); PG8_WAIT_L(0); PG8_BAR; PG8_MMA(1, 0, At, B0); PG8_MMA(1, 1, At, B1); PG8_BAR; PG8_SCHED;
            PG8_LDB(B0, 1, 0); PG8_LDB(B1, 1, 1); PG8_SCHED; PG8_LDA(At, 1, 0); PG8_STAGE(PG8_SA(0, 1), a2 + hstep, voffA);
            PG8_WAIT_V(8); PG8_WAIT_L(0); PG8_BAR; PG8_MMA(0, 0, At, B0); PG8_MMA(0, 1, At, B1); PG8_BAR; PG8_SCHED;
            PG8_LDA(At, 1, 1); PG8_STAGE(PG8_SB(1, 0), b3, voffB); PG8_STAGE(PG8_SB(1, 1), b3 + hstep, voffB); PG8_STAGE(PG8_SA(1, 0), a3, voffA);
            PG8_WAIT_V(8); PG8_WAIT_L(0); PG8_BAR; PG8_MMA(1, 0, At, B0); PG8_MMA(1, 1, At, B1); PG8_BAR; PG8_SCHED;
            } else {
            PG8_LDB(B0, 0, 0); PG8_SCHED; PG8_LDA(At, 0, 0); PG8_STAGE(PG8_SA(1, 1), a1 + hstep, voffA);
            PG8_WAIT_L(8); PG8_BAR; PG8_WAIT_L(0); PG8_MMA(0, 0, At, B0); PG8_BAR; PG8_SCHED;
            PG8_LDB(B1, 0, 1); PG8_STAGE(PG8_SB(0, 0), b2, voffB);
            PG8_BAR; PG8_WAIT_L(0); PG8_MMA(0, 1, At, B1); PG8_BAR;
            PG8_LDA(At, 0, 1); PG8_STAGE(PG8_SA(0, 0), a2, voffA);
            PG8_BAR; PG8_WAIT_L(0); PG8_MMA(1, 0, At, B0); PG8_BAR; PG8_SCHED;
            PG8_STAGE(PG8_SB(0, 1), b2 + hstep, voffB);
            PG8_WAIT_V(6); PG8_BAR; PG8_MMA(1, 1, At, B1); PG8_BAR;
            PG8_LDB(B0, 1, 0); PG8_SCHED; PG8_LDA(At, 1, 0); PG8_STAGE(PG8_SA(0, 1), a2 + hstep, voffA);
            PG8_WAIT_L(8); PG8_BAR; PG8_WAIT_L(0); PG8_MMA(0, 0, At, B0); PG8_BAR; PG8_SCHED;
            PG8_LDB(B1, 1, 1); PG8_STAGE(PG8_SB(1, 0), b3, voffB);
            PG8_BAR; PG8_WAIT_L(0); PG8_MMA(0, 1, At, B1); PG8_BAR;
            PG8_LDA(At, 1, 1); PG8_STAGE(PG8_SA(1, 0), a3, voffA);
            PG8_BAR; PG8_WAIT_L(0); PG8_MMA(1, 0, At, B0); PG8_BAR; PG8_SCHED;
            PG8_STAGE(PG8_SB(1, 1), b3 + hstep, voffB);
            PG8_WAIT_V(6); PG8_BAR; PG8_MMA(1, 1, At, B1); PG8_BAR;
            }
        }
        if constexpr (ALIGN_EPI) { if (wr == 0) PG8_BAR; }
        if constexpr (!Epi::AFTER_DRAIN) { E(acc, cur, wr, wc, fr, fq); S.done(cur); }
        if (!has_next) break;
#pragma unroll
        for (int a = 0; a < 2; ++a)
#pragma unroll
            for (int b = 0; b < 2; ++b)
#pragma unroll
                for (int m = 0; m < 4; ++m)
#pragma unroll
                    for (int n = 0; n < 2; ++n) acc[a][b][m][n] = (f32x4){0.f, 0.f, 0.f, 0.f};
        cur = nxt; cA = nA; cB = nB; ++ui;
        if constexpr (ALIGN_EPI) { if (wr == 1) PG8_BAR; }
    }
    PG8_WAIT_V(0);
    if constexpr (!ALIGN_EPI) { if (wr == 0) PG8_BAR; }
    PG8_BAR;
    if constexpr (Epi::AFTER_DRAIN) { E.fused(acc, cur, wr, wc, fr, fq, lds, wid, lane); S.done(cur); }
#undef PG8_SA
#undef PG8_SB
#undef PG8_STAGE
#undef PG8_LDA
#undef PG8_LDB
#undef PG8_MMA
#undef PG8_WAIT_V
#undef PG8_WAIT_L
#undef PG8_BAR
#undef PG8_SCHED
}
}

#ifndef PG8_SP2
#define PG8_SP2 true
#endif
#ifndef PG8_ALIGN
#define PG8_ALIGN true
#endif
#define LAS __attribute__((address_space(3)))
typedef unsigned short bf16_t;
typedef short bf16x8 __attribute__((ext_vector_type(8)));
typedef float f32x4 __attribute__((ext_vector_type(4)));
typedef float f32x16 __attribute__((ext_vector_type(16)));
typedef unsigned u32x4 __attribute__((ext_vector_type(4)));
typedef unsigned u32x2 __attribute__((ext_vector_type(2)));
using pg8::Unit;

constexpr int NTOK = 32768, NPROMPT = 16384, DM = 1024, DFF = 4096;
constexpr int NZA = 1536;
constexpr float EPS = 1e-5f;
constexpr float C2 = 0.125f * 1.4426950408889634f;
constexpr float LAM_INIT = 0.2f;
constexpr size_t MiB = 1u << 20;
constexpr size_t WS_SUMSQ = 0;
constexpr size_t WS_WIN = 1 * MiB, WS_WOUT = 6 * MiB, WS_W1 = 8 * MiB, WS_W2 = 24 * MiB, WS_CIN = 40 * MiB, WS_COUT = 46 * MiB, WS_ROPE = 48 * MiB;
constexpr size_t WS_HB = 49 * MiB;
constexpr size_t WS_BIG = 113 * MiB;
constexpr size_t WS_END = 241 * MiB;
constexpr int LDS_BYTES = 147456;

struct Params { const float* in[20]; float* out; unsigned char* ws; };

__device__ __forceinline__ unsigned cvtpk(float lo, float hi) { return pg8::cvt_pk_bf16(lo, hi); }
__device__ __forceinline__ u32x4 pack8(f32x4 a, f32x4 b) { u32x4 w; w.x = cvtpk(a[0], a[1]); w.y = cvtpk(a[2], a[3]); w.z = cvtpk(b[0], b[1]); w.w = cvtpk(b[2], b[3]); return w; }
__device__ __forceinline__ float bflo(unsigned x) { return __uint_as_float(x << 16); }
__device__ __forceinline__ float bfhi(unsigned x) { return __uint_as_float(x & 0xffff0000u); }
__device__ __forceinline__ void unpack8(u32x4 w, f32x4& a, f32x4& b) { a = (f32x4){bflo(w.x), bfhi(w.x), bflo(w.y), bfhi(w.y)}; b = (f32x4){bflo(w.z), bfhi(w.z), bflo(w.w), bfhi(w.w)}; }
__device__ __forceinline__ float gelu_tanh(float x) { const float t = x * (1.0f + 0.044715f * x * x); const float e = __builtin_amdgcn_exp2f(-2.302208198f * t); return x * __builtin_amdgcn_rcpf(1.0f + e); }
__device__ __forceinline__ f32x4 gelu4(f32x4 v) { return (f32x4){gelu_tanh(v[0]), gelu_tanh(v[1]), gelu_tanh(v[2]), gelu_tanh(v[3])}; }
__device__ __forceinline__ float wave_sum(float v) {
#pragma unroll
    for (int o = 1; o < 64; o <<= 1) v += __shfl_xor(v, o);
    return v;
}
__device__ __forceinline__ int seqpos(int row) { return row < NPROMPT ? (row & 4095) : (row & 8191); }

struct EpiA {
    static constexpr bool PERM = true, AFTER_DRAIN = false;
    bf16_t* ZA; const float* rope;
    __device__ __forceinline__ void operator()(const f32x4 (&acc)[2][2][4][2], const Unit& u, int wr, int wc, int fr, int fq) const {
        const int row0 = u.pm * 256 + wr * 64 + fr, kind = u.pn >> 1, col0 = u.pn * 256 + wc * 32 + 8 * fq;
        const bool ropew = (kind != 0) && ((wc & 1) == 0);
        const float sgn = (fq == 0) ? -1.f : 1.f, sc = (kind == 1) ? C2 : 1.f;
#pragma unroll
        for (int ai = 0; ai < 2; ++ai)
#pragma unroll
            for (int m = 0; m < 4; ++m) {
                const int row = row0 + ai * 128 + m * 16;
                f32x4 c0 = {1.f, 1.f, 1.f, 1.f}, c1 = c0, s0 = {0.f, 0.f, 0.f, 0.f}, s1 = s0;
                if (ropew) { const float* rp = rope + seqpos(row) * 16; c0 = *(const f32x4*)rp; c1 = *(const f32x4*)(rp + 4); s0 = *(const f32x4*)(rp + 8); s1 = *(const f32x4*)(rp + 12); }
                bf16_t* op = ZA + (size_t)row * NZA + col0;
#pragma unroll
                for (int bj = 0; bj < 2; ++bj) {
                    f32x4 v0 = acc[ai][bj][m][0], v1 = acc[ai][bj][m][1];
                    if (kind == 0) { v0 = gelu4(v0); v1 = gelu4(v1); }
                    else {
                        if (ropew) {
                            f32x4 p0, p1;
#pragma unroll
                            for (int e = 0; e < 4; ++e) { p0[e] = __shfl_xor(v0[e], 16); p1[e] = __shfl_xor(v1[e], 16); }
                            if (fq < 2) { v0 = v0 * c0 + (p0 * s0) * sgn; v1 = v1 * c1 + (p1 * s1) * sgn; }
                        }
                        v0 = v0 * sc; v1 = v1 * sc;
                    }
                    *(u32x4*)(op + bj * 128) = pack8(v0, v1);
                }
                asm volatile("" ::: "memory");
            }
    }
};
struct EpiB {
    static constexpr bool PERM = true, AFTER_DRAIN = false;
    bf16_t* ZT;
    __device__ __forceinline__ void operator()(const f32x4 (&acc)[2][2][4][2], const Unit& u, int wr, int wc, int fr, int fq) const {
        const int row0 = u.pm * 256 + wr * 64 + fr, col0 = u.pn * 256 + wc * 32 + 8 * fq; const bool act = u.pm < 2;
#pragma unroll
        for (int ai = 0; ai < 2; ++ai)
#pragma unroll
            for (int m = 0; m < 4; ++m) {
                bf16_t* op = ZT + (size_t)(row0 + ai * 128 + m * 16) * NTOK + col0;
#pragma unroll
                for (int bj = 0; bj < 2; ++bj) {
                    f32x4 v0 = acc[ai][bj][m][0], v1 = acc[ai][bj][m][1];
                    if (act) { v0 = gelu4(v0); v1 = gelu4(v1); }
                    *(u32x4*)(op + bj * 128) = pack8(v0, v1);
                }
            }
    }
};
template <bool WB> struct EpiRes {
    static constexpr bool PERM = true, AFTER_DRAIN = false;
    const float* res0; const float* res1; float* H; bf16_t* HB; float* sumsq; int rowbase;
    __device__ __forceinline__ void operator()(const f32x4 (&acc)[2][2][4][2], const Unit& u, int wr, int wc, int fr, int fq) const {
        const int row0 = rowbase + u.pm * 256 + wr * 64 + fr, col0 = u.pn * 256 + wc * 32 + 8 * fq;
#pragma unroll
        for (int ai = 0; ai < 2; ++ai)
#pragma unroll
            for (int m = 0; m < 4; ++m) {
                const int row = row0 + ai * 128 + m * 16;
                const float* rp = (row < NPROMPT ? res0 : res1) + (size_t)row * DM + col0;
                float* hp = H + (size_t)row * DM + col0; float ss = 0.f;
#pragma unroll
                for (int bj = 0; bj < 2; ++bj) {
                    const f32x4 r0 = *(const f32x4*)(rp + bj * 128), r1 = *(const f32x4*)(rp + bj * 128 + 4);
                    const f32x4 v0 = acc[ai][bj][m][0] + r0, v1 = acc[ai][bj][m][1] + r1;
                    *(f32x4*)(hp + bj * 128) = v0; *(f32x4*)(hp + bj * 128 + 4) = v1;
                    if (WB) *(u32x4*)(HB + (size_t)row * DM + col0 + bj * 128) = pack8(v0, v1);
                    ss += (v0[0] * v0[0] + v0[1] * v0[1]) + (v0[2] * v0[2] + v0[3] * v0[3]) + (v1[0] * v1[0] + v1[1] * v1[1]) + (v1[2] * v1[2] + v1[3] * v1[3]);
                }
                ss += __shfl_xor(ss, 16); ss += __shfl_xor(ss, 32);
                if (fq == 0) __hip_atomic_fetch_add(sumsq + row, ss, __ATOMIC_RELAXED, __HIP_MEMORY_SCOPE_AGENT);
                asm volatile("" ::: "memory");
            }
    }
};
struct EpiFfn1 {
    static constexpr bool PERM = true, AFTER_DRAIN = false;
    bf16_t* HID; const float* sumsq; int rowbase;
    __device__ __forceinline__ void operator()(const f32x4 (&acc)[2][2][4][2], const Unit& u, int wr, int wc, int fr, int fq) const {
        const int lrow0 = u.pm * 256 + wr * 64 + fr, col0 = u.pn * 256 + wc * 32 + 8 * fq;
#pragma unroll
        for (int ai = 0; ai < 2; ++ai)
#pragma unroll
            for (int m = 0; m < 4; ++m) {
                const int lrow = lrow0 + ai * 128 + m * 16;
                const float rs = __builtin_amdgcn_rsqf(sumsq[rowbase + lrow] * (1.0f / DM) + EPS);
                bf16_t* op = HID + (size_t)lrow * DFF + col0;
#pragma unroll
                for (int bj = 0; bj < 2; ++bj) {
                    f32x4 v0 = acc[ai][bj][m][0] * rs, v1 = acc[ai][bj][m][1] * rs;
#pragma unroll
                    for (int e = 0; e < 4; ++e) { const float a = fmaxf(v0[e], 0.f), b = fmaxf(v1[e], 0.f); v0[e] = a * a; v1[e] = b * b; }
                    *(u32x4*)(op + bj * 128) = pack8(v0, v1);
                }
                asm volatile("" ::: "memory");
            }
    }
};
struct EpiConvT {
    static constexpr bool PERM = true, AFTER_DRAIN = false;
    bf16_t* T; const float* sumsq;
    __device__ __forceinline__ void operator()(const f32x4 (&acc)[2][2][4][2], const Unit& u, int wr, int wc, int fr, int fq) const {
        const int row0 = u.pm * 256 + wr * 64 + fr, ch0 = u.pn * 128 + wc * 32 + 8 * fq;
#pragma unroll
        for (int ai = 0; ai < 2; ++ai)
#pragma unroll
            for (int m = 0; m < 4; ++m) {
                const int row = row0 + ai * 128 + m * 16;
                const float rs = __builtin_amdgcn_rsqf(sumsq[row] * (1.0f / DM) + EPS), rs2 = rs * rs;
                const f32x4 v0 = acc[ai][0][m][0] * acc[ai][1][m][0] * rs2, v1 = acc[ai][0][m][1] * acc[ai][1][m][1] * rs2;
                *(u32x4*)(T + (size_t)row * DM + ch0) = pack8(v0, v1);
                asm volatile("" ::: "memory");
            }
    }
};
struct EpiConvU {
    static constexpr bool PERM = true, AFTER_DRAIN = false;
    bf16_t* U; const bf16_t* T; const float* sumsq; const float* cw;
    __device__ __forceinline__ void operator()(const f32x4 (&acc)[2][2][4][2], const Unit& u, int wr, int wc, int fr, int fq) const {
        const int row0 = u.pm * 256 + wr * 64 + fr;
#pragma unroll
        for (int bj = 0; bj < 2; ++bj) {
            const int ch0 = u.pn * 256 + bj * 128 + wc * 32 + 8 * fq;
            const f32x4 w0a = *(const f32x4*)(cw + ch0), w0b = *(const f32x4*)(cw + ch0 + 4), w1a = *(const f32x4*)(cw + DM + ch0), w1b = *(const f32x4*)(cw + DM + ch0 + 4),
                        w2a = *(const f32x4*)(cw + 2 * DM + ch0), w2b = *(const f32x4*)(cw + 2 * DM + ch0 + 4);
#pragma unroll
            for (int ai = 0; ai < 2; ++ai)
#pragma unroll
                for (int m = 0; m < 4; ++m) {
                    const int row = row0 + ai * 128 + m * 16, pos = seqpos(row), slen = row < NPROMPT ? 4096 : 8192;
                    const float rs = __builtin_amdgcn_rsqf(sumsq[row] * (1.0f / DM) + EPS);
                    const bf16_t* tp = T + (size_t)row * DM + ch0;
                    const u32x4 z = {0u, 0u, 0u, 0u};
                    const u32x4 tc = *(const u32x4*)tp;
                    const u32x4 tl = (pos > 0) ? *(const u32x4*)(tp - DM) : z;
                    const u32x4 tn = (pos < slen - 1) ? *(const u32x4*)(tp + DM) : z;
                    f32x4 ca, cb, la, lb, na, nb; unpack8(tc, ca, cb); unpack8(tl, la, lb); unpack8(tn, na, nb);
                    const f32x4 ya = w0a * la + w1a * ca + w2a * na, yb = w0b * lb + w1b * cb + w2b * nb;
                    const f32x4 v0 = acc[ai][bj][m][0] * rs * ya, v1 = acc[ai][bj][m][1] * rs * yb;
                    *(u32x4*)(U + (size_t)row * DM + ch0) = pack8(v0, v1);
                    asm volatile("" ::: "memory");
                }
        }
    }
};

template <int MAP> __device__ __forceinline__ int orow_map(int n) {
    if (MAP == 1) { const int b = n >> 9; const int ob = (b == 0) ? 0 : (b == 1) ? 3 : (b == 2) ? 1 : (b == 3) ? 2 : 4; return ob * 512 + (n & 511); }
    if (MAP == 2) { if (n < 1024) return 2048 + n; const int hs = (n >= 2048) ? 1 : 0; const int ch = n - 1024 - hs * 1024; return (ch >> 7) * 256 + hs * 128 + (ch & 127); }
    return n;
}
template <int MAP> __device__ __forceinline__ void transpose_item(const float* W, int K, int N, bf16_t* WT, const float* gk, LAS float* scr, int item, int lane) {
    const int nblk = N / 32, kb = item / nblk, nb = item % nblk, k0 = 64 * kb, n0 = 32 * nb;
#pragma unroll 8
    for (int i = 0; i < 32; ++i) { const int kk = 2 * i + (lane >> 5); float v = W[(size_t)(k0 + kk) * N + n0 + (lane & 31)]; if (gk) v *= gk[k0 + kk]; scr[kk * 33 + (lane & 31)] = v; }
    asm volatile("s_waitcnt lgkmcnt(0)" ::: "memory");
    const int c = lane & 7; const int or0 = orow_map<MAP>(n0);
#pragma unroll
    for (int j = 0; j < 4; ++j) { const int n = (lane >> 3) + 8 * j; const LAS float* s = scr + (8 * c) * 33 + n;
        u32x4 o; o.x = cvtpk(s[0 * 33], s[1 * 33]); o.y = cvtpk(s[2 * 33], s[3 * 33]); o.z = cvtpk(s[4 * 33], s[5 * 33]); o.w = cvtpk(s[6 * 33], s[7 * 33]);
        *(u32x4*)(WT + (size_t)(or0 + n) * K + k0 + 8 * c) = o; }
    asm volatile("s_waitcnt lgkmcnt(0)" ::: "memory");
}
__device__ __forceinline__ void rms_row_to_bf16(const float* xrow, const float* g, bf16_t* orow, int lane) {
    const f32x4* xr = (const f32x4*)xrow + lane; const f32x4* gr = (const f32x4*)g + lane;
    f32x4 v[4]; float s = 0.f;
#pragma unroll
    for (int j = 0; j < 4; ++j) { v[j] = xr[64 * j]; s += (v[j][0] * v[j][0] + v[j][1] * v[j][1]) + (v[j][2] * v[j][2] + v[j][3] * v[j][3]); }
    const float rstd = 1.0f / sqrtf(wave_sum(s) * (1.0f / DM) + EPS);
    u32x2* o8 = (u32x2*)orow + lane;
#pragma unroll
    for (int j = 0; j < 4; ++j) { const f32x4 gg = gr[64 * j]; const f32x4 y = v[j] * rstd * gg; u32x2 w; w.x = cvtpk(y[0], y[1]); w.y = cvtpk(y[2], y[3]); o8[64 * j] = w; }
}

__device__ __forceinline__ int swap23(int x) { return (x & ~12) | ((x & 4) << 1) | ((x & 8) >> 1); }
__device__ __forceinline__ float half_swap_max(float v) { auto rr = __builtin_amdgcn_permlane32_swap(__float_as_uint(v), __float_as_uint(v), false, false); return fmaxf(__uint_as_float(rr[0]), __uint_as_float(rr[1])); }
__device__ __forceinline__ float half_swap_sum(float v) { auto rr = __builtin_amdgcn_permlane32_swap(__float_as_uint(v), __float_as_uint(v), false, false); return __uint_as_float(rr[0]) + __uint_as_float(rr[1]); }

__device__ __forceinline__ void attn_unit(LAS unsigned char* lds, const bf16_t* __restrict__ ZA, const bf16_t* __restrict__ ZT, bf16_t* __restrict__ CAT, const float* __restrict__ subg,
                                          float lam, int seqrow0, int slen, int h, int qb) {
    int tid_ = threadIdx.x; asm volatile("" : "+v"(tid_));
    const int tid = tid_, lane = tid & 63, r32 = lane & 31, hi = lane >> 5;
    const int wid = __builtin_amdgcn_readfirstlane(tid >> 6), j = wid >> 2, sub = wid & 3;
    const int qrow = seqrow0 + qb * 128 + sub * 32 + r32;
    bf16x8 qr[4];
#pragma unroll
    for (int d0 = 0; d0 < 4; ++d0) qr[d0] = *(const bf16x8*)(ZA + (size_t)qrow * NZA + 512 + h * 128 + j * 64 + d0 * 16 + hi * 8);
    const bf16_t* ksrc[2]; const bf16_t* vsrc[2]; int kdst[2], vdst[2];
#pragma unroll
    for (int i = 0; i < 2; ++i) {
        const int kv = (tid >> 4) + 32 * i, ch = tid & 15, jj = ch >> 3, dch = ch & 7, rho = (kv & ~15) | swap23(kv & 15);
        ksrc[i] = ZA + (size_t)(seqrow0 + kv) * NZA + 1024 + h * 128 + ch * 8;
        kdst[i] = jj * 8192 + rho * 128 + ((dch ^ ((rho >> 1) & 7)) * 16);
        const int d = (tid >> 3) + 64 * i, vch = tid & 7;
        vsrc[i] = ZT + (size_t)(512 + h * 128 + d) * NTOK + seqrow0 + vch * 8;
        vdst[i] = 16384 + d * 128 + ((vch ^ ((d >> 1) & 7)) * 16);
    }
    const int NT = slen / 64;
    u32x4 sk[2], sv[2];
#pragma unroll
    for (int i = 0; i < 2; ++i) { sk[i] = *(const u32x4*)ksrc[i]; sv[i] = *(const u32x4*)vsrc[i]; }
#pragma unroll
    for (int i = 0; i < 2; ++i) { *(LAS u32x4*)(lds + kdst[i]) = sk[i]; *(LAS u32x4*)(lds + vdst[i]) = sv[i]; }
    __syncthreads();
    f32x16 o[4];
#pragma unroll
    for (int b = 0; b < 4; ++b)
#pragma unroll
        for (int r = 0; r < 16; ++r) o[b][r] = 0.f;
    float mrun = -INFINITY, lsum = 0.f;
    const int swz = (r32 >> 1) & 7;
    for (int t = 0; t < NT; ++t) {
        const int cur = (t & 1) * 32768, nxt = 32768 - cur;
        const bool more = (t + 1 < NT);
        if (more) {
#pragma unroll
            for (int i = 0; i < 2; ++i) { sk[i] = *(const u32x4*)(ksrc[i] + (size_t)(t + 1) * 64 * NZA); sv[i] = *(const u32x4*)(vsrc[i] + (t + 1) * 64); }
        }
        f32x16 p0, p1;
#pragma unroll
        for (int r = 0; r < 16; ++r) { p0[r] = 0.f; p1[r] = 0.f; }
        const LAS unsigned char* kb = lds + cur + j * 8192 + r32 * 128;
#pragma unroll
        for (int d0 = 0; d0 < 4; ++d0) {
            const int off = ((2 * d0 + hi) ^ swz) * 16;
            const bf16x8 a0 = *(const LAS bf16x8*)(kb + off), a1 = *(const LAS bf16x8*)(kb + 4096 + off);
            p0 = __builtin_amdgcn_mfma_f32_32x32x16_bf16(a0, qr[d0], p0, 0, 0, 0);
            p1 = __builtin_amdgcn_mfma_f32_32x32x16_bf16(a1, qr[d0], p1, 0, 0, 0);
        }
        float rm = fmaxf(p0[0], p1[0]);
#pragma unroll
        for (int r = 1; r < 16; ++r) rm = fmaxf(rm, fmaxf(p0[r], p1[r]));
        rm = half_swap_max(rm);
        if (__any(rm > mrun)) {
            const float mnew = fmaxf(mrun, rm), alpha = __builtin_amdgcn_exp2f(mrun - mnew);
            lsum *= alpha;
#pragma unroll
            for (int b = 0; b < 4; ++b)
#pragma unroll
                for (int r = 0; r < 16; ++r) o[b][r] *= alpha;
            mrun = mnew;
        }
        float ps = 0.f;
#pragma unroll
        for (int r = 0; r < 16; ++r) { p0[r] = __builtin_amdgcn_exp2f(p0[r] - mrun); p1[r] = __builtin_amdgcn_exp2f(p1[r] - mrun); ps += p0[r] + p1[r]; }
        lsum += ps;
        bf16x8 pb[4];
        { u32x4 w;
          w.x = cvtpk(p0[0], p0[1]); w.y = cvtpk(p0[2], p0[3]); w.z = cvtpk(p0[4], p0[5]); w.w = cvtpk(p0[6], p0[7]); pb[0] = __builtin_bit_cast(bf16x8, w);
          w.x = cvtpk(p0[8], p0[9]); w.y = cvtpk(p0[10], p0[11]); w.z = cvtpk(p0[12], p0[13]); w.w = cvtpk(p0[14], p0[15]); pb[1] = __builtin_bit_cast(bf16x8, w);
          w.x = cvtpk(p1[0], p1[1]); w.y = cvtpk(p1[2], p1[3]); w.z = cvtpk(p1[4], p1[5]); w.w = cvtpk(p1[6], p1[7]); pb[2] = __builtin_bit_cast(bf16x8, w);
          w.x = cvtpk(p1[8], p1[9]); w.y = cvtpk(p1[10], p1[11]); w.z = cvtpk(p1[12], p1[13]); w.w = cvtpk(p1[14], p1[15]); pb[3] = __builtin_bit_cast(bf16x8, w); }
        const LAS unsigned char* vb = lds + cur + 16384 + r32 * 128;
#pragma unroll
        for (int b = 0; b < 4; ++b)
#pragma unroll
            for (int jj = 0; jj < 4; ++jj) {
                const bf16x8 a = *(const LAS bf16x8*)(vb + b * 4096 + (((2 * jj + hi) ^ swz) * 16));
                o[b] = __builtin_amdgcn_mfma_f32_32x32x16_bf16(a, pb[jj], o[b], 0, 0, 0);
            }
        if (more) {
#pragma unroll
            for (int i = 0; i < 2; ++i) { *(LAS u32x4*)(lds + nxt + kdst[i]) = sk[i]; *(LAS u32x4*)(lds + nxt + vdst[i]) = sv[i]; }
        }
        __syncthreads();
    }
    const float inv = 1.0f / half_swap_sum(lsum);
    LAS float* X = (LAS float*)lds + sub * 4096 + lane;
    if (j == 1) {
        const float f = inv * lam;
#pragma unroll
        for (int b = 0; b < 4; ++b)
#pragma unroll
            for (int r = 0; r < 16; ++r) X[(b * 16 + r) * 64] = o[b][r] * f;
    }
    __syncthreads();
    if (j == 0) {
        float ss = 0.f;
#pragma unroll
        for (int b = 0; b < 4; ++b)
#pragma unroll
            for (int r = 0; r < 16; ++r) { const float v = o[b][r] * inv - X[(b * 16 + r) * 64]; o[b][r] = v; ss += v * v; }
        ss = half_swap_sum(ss);
        const float rs = __builtin_amdgcn_rsqf(ss * (1.0f / 128.0f) + EPS) * (1.0f - LAM_INIT);
        bf16_t* op = CAT + (size_t)qrow * DM + 512 + h * 128;
#pragma unroll
        for (int b = 0; b < 4; ++b)
#pragma unroll
            for (int a = 0; a < 4; ++a) {
                const int d0 = 32 * b + 8 * a + 4 * hi; const f32x4 g = *(const f32x4*)(subg + d0);
                u32x2 w; w.x = cvtpk(o[b][4 * a] * rs * g[0], o[b][4 * a + 1] * rs * g[1]); w.y = cvtpk(o[b][4 * a + 2] * rs * g[2], o[b][4 * a + 3] * rs * g[3]);
                *(u32x2*)(op + d0) = w;
            }
    }
    __syncthreads();
}

__device__ __forceinline__ void gmlp_item(LAS unsigned char* lds, const bf16_t* __restrict__ ZA, const bf16_t* __restrict__ ZT, bf16_t* __restrict__ CAT, const float* __restrict__ Wsg,
                                          const float* __restrict__ vng, const float* __restrict__ bsg, int ck, int g) {
    int tid_ = threadIdx.x; asm volatile("" : "+v"(tid_));
    const int tid = tid_, lane = tid & 63, r32 = lane & 31, hi = lane >> 5;
    const int wid = __builtin_amdgcn_readfirstlane(tid >> 6);
    const int R0 = ck * 128;
    LAS float* red = (LAS float*)(lds + 32768); LAS float* rstd = (LAS float*)(lds + 32768 + 2048);
#pragma unroll
    for (int i = 0; i < 4; ++i) {
        const int c = tid + 512 * i, e = c >> 4, ch = c & 15;
        const u32x4 v = *(const u32x4*)(ZT + (size_t)(g * 128 + e) * NTOK + R0 + ch * 8);
        *(LAS u32x4*)(lds + e * 256 + ((ch ^ (e & 15)) * 16)) = v;
    }
    __syncthreads();
    { const int q = tid & 127, part = tid >> 7; float s = 0.f;
#pragma unroll 8
      for (int ee = 0; ee < 32; ++ee) { const int e = part * 32 + ee; const unsigned short b = *(const LAS unsigned short*)(lds + e * 256 + (((q >> 3) ^ (e & 15)) * 16) + (q & 7) * 2); const float v = __uint_as_float((unsigned)b << 16); s += v * v; }
      red[part * 128 + q] = s; }
    __syncthreads();
    if (tid < 128) rstd[tid] = __builtin_amdgcn_rsqf((red[tid] + red[128 + tid] + red[256 + tid] + red[384 + tid]) * (1.0f / 128.0f) + EPS);
    __syncthreads();
    const int eblk = wid & 3, pb0 = 2 * (wid >> 2);
    f32x16 acc[2];
#pragma unroll
    for (int r = 0; r < 16; ++r) { acc[0][r] = 0.f; acc[1][r] = 0.f; }
#pragma unroll
    for (int kk = 0; kk < 8; ++kk) {
        const bf16x8 a = *(const LAS bf16x8*)(lds + (32 * eblk + r32) * 256 + (((2 * kk + hi) ^ (r32 & 15)) * 16));
        const f32x4 ra = *(const LAS f32x4*)(rstd + 16 * kk + 8 * hi), rb = *(const LAS f32x4*)(rstd + 16 * kk + 8 * hi + 4);
#pragma unroll
        for (int pp = 0; pp < 2; ++pp) {
            const float* wp = Wsg + (size_t)(32 * (pb0 + pp) + r32) * 128 + 16 * kk + 8 * hi;
            const f32x4 wa = *(const f32x4*)wp * ra, wb = *(const f32x4*)(wp + 4) * rb;
            const bf16x8 b = __builtin_bit_cast(bf16x8, pack8(wa, wb));
            acc[pp] = __builtin_amdgcn_mfma_f32_32x32x16_bf16(a, b, acc[pp], 0, 0, 0);
        }
    }
#pragma unroll
    for (int pp = 0; pp < 2; ++pp) {
        const int p = 32 * (pb0 + pp) + r32, row = R0 + p; const float bs = bsg[p];
#pragma unroll
        for (int a4 = 0; a4 < 4; ++a4) {
            const int e0 = 32 * eblk + 8 * a4 + 4 * hi; const f32x4 gv = *(const f32x4*)(vng + e0);
            const u32x2 uu = *(const u32x2*)(ZA + (size_t)row * NZA + g * 128 + e0);
            const float o0 = bflo(uu.x) * (gv[0] * acc[pp][4 * a4] + bs), o1 = bfhi(uu.x) * (gv[1] * acc[pp][4 * a4 + 1] + bs),
                        o2 = bflo(uu.y) * (gv[2] * acc[pp][4 * a4 + 2] + bs), o3 = bfhi(uu.y) * (gv[3] * acc[pp][4 * a4 + 3] + bs);
            u32x2 w; w.x = cvtpk(o0, o1); w.y = cvtpk(o2, o3);
            *(u32x2*)(CAT + (size_t)row * DM + g * 128 + e0) = w;
        }
    }
    __syncthreads();
}

#define GEMM_RUN(EPI, g, E) do { pg8::StaticOrder S_; S_.init((g).M, (g).N, G, (int)blockIdx.x); pg8::gemm_phase<EPI, pg8::StaticOrder, PG8_ALIGN, PG8_SP2>(lds, (g), S_, (E)); } while (0)
#define GRID_SYNC() grid.sync()
#ifndef PHMASK
#define PHMASK 0xffff
#endif
#define PH(n) (((PHMASK) >> (n)) & 1)

__global__ void __launch_bounds__(512) mega_fwd(Params P) {
    extern __shared__ __attribute__((aligned(16))) unsigned char lds_raw[];
    LAS unsigned char* lds = (LAS unsigned char*)lds_raw;
    cg::grid_group grid = cg::this_grid();
    const int tid = threadIdx.x, lane = tid & 63, wave = __builtin_amdgcn_readfirstlane(tid >> 6);
    const int G = gridDim.x, bx = blockIdx.x;
    const int vcu = (G % 8 == 0) ? (bx % 8) * (G / 8) + bx / 8 : bx;
    unsigned char* ws = P.ws;
    const float* x_prompt = P.in[0]; const float* x_sample = P.in[1];
    float* sumsq = (float*)(ws + WS_SUMSQ);
    bf16_t* WinT = (bf16_t*)(ws + WS_WIN); bf16_t* WoutT = (bf16_t*)(ws + WS_WOUT); bf16_t* W1T = (bf16_t*)(ws + WS_W1); bf16_t* W2T = (bf16_t*)(ws + WS_W2);
    bf16_t* CinT = (bf16_t*)(ws + WS_CIN); bf16_t* CoutT = (bf16_t*)(ws + WS_COUT); float* rope = (float*)(ws + WS_ROPE);
    bf16_t* ZT = (bf16_t*)(ws + WS_HB); bf16_t* HB = (bf16_t*)(ws + WS_HB);
    bf16_t* XN = (bf16_t*)(ws + WS_BIG); bf16_t* CAT = (bf16_t*)(ws + WS_BIG); bf16_t* HID = (bf16_t*)(ws + WS_BIG);
    bf16_t* TB = (bf16_t*)(ws + WS_BIG); bf16_t* UB = (bf16_t*)(ws + WS_BIG + 64 * MiB);
    bf16_t* ZA = (bf16_t*)P.out; float* H = P.out;

    if (PH(0)) {
        LAS float* scr = (LAS float*)(lds + wave * 16384);
        const int gw = vcu * 8 + wave, NGW = G * 8;
        constexpr int I_EIN = 16 * 80, I_EOUT = 16 * 32, I_W1 = 16 * 128, I_W2 = 64 * 32, I_CIN = 16 * 96, I_COUT = 16 * 32;
        constexpr int NITEMS = I_EIN + I_EOUT + 2 * I_W1 + 2 * I_W2 + I_CIN + I_COUT;
        for (int it = gw; it < NITEMS; it += NGW) {
            int r = it;
            if (r < I_EIN) { transpose_item<1>(P.in[6], DM, 2560, WinT, nullptr, scr, r, lane); continue; } r -= I_EIN;
            if (r < I_EOUT) { transpose_item<0>(P.in[7], DM, DM, WoutT, nullptr, scr, r, lane); continue; } r -= I_EOUT;
            if (r < I_W1) { transpose_item<0>(P.in[4], DM, DFF, W1T, P.in[3], scr, r, lane); continue; } r -= I_W1;
            if (r < I_W1) { transpose_item<0>(P.in[4] + (size_t)DM * DFF, DM, DFF, W1T + (size_t)DM * DFF, P.in[3] + DM, scr, r, lane); continue; } r -= I_W1;
            if (r < I_W2) { transpose_item<0>(P.in[5], DFF, DM, W2T, nullptr, scr, r, lane); continue; } r -= I_W2;
            if (r < I_W2) { transpose_item<0>(P.in[5] + (size_t)DM * DFF, DFF, DM, W2T + (size_t)DM * DFF, nullptr, scr, r, lane); continue; } r -= I_W2;
            if (r < I_CIN) { transpose_item<2>(P.in[16], DM, 3072, CinT, P.in[2] + DM, scr, r, lane); continue; } r -= I_CIN;
            transpose_item<0>(P.in[18], DM, DM, CoutT, nullptr, scr, r, lane);
        }
        for (int m = gw; m < NTOK; m += NGW) {
            const float* xr = (m < NPROMPT) ? x_prompt + (size_t)m * DM : x_sample + (size_t)(m - NPROMPT) * DM;
            rms_row_to_bf16(xr, P.in[2], XN + (size_t)m * DM, lane);
        }
        const int gt = vcu * 512 + tid, NGT = G * 512;
        for (int i = gt; i < 4 * NTOK; i += NGT) sumsq[i] = 0.f;
        for (int i = gt; i < 8192 * 8; i += NGT) {
            const int pos = i >> 3, fi = i & 7;
            const float inv = exp2f(-(float)fi * 0.125f * 18.931568569324174f);
            const float ang = (float)pos * inv;
            const double ad = (double)ang; const double kq = rint(ad * 0.15915494309189535); const float rr = (float)(ad - kq * 6.283185307179586);
            rope[pos * 16 + fi] = __cosf(rr); rope[pos * 16 + 8 + fi] = __sinf(rr);
        }
    }
    GRID_SYNC();

    if (PH(1)) {
        pg8::Gemm ga{XN, WinT, NTOK, 1536, DM}; EpiA ea{ZA, rope};
        GEMM_RUN(EpiA, ga, ea);
        pg8::Gemm gb{WinT + (size_t)1536 * DM, XN, 1024, NTOK, DM}; EpiB eb{ZT};
        GEMM_RUN(EpiB, gb, eb);
    }
    GRID_SYNC();

    if (PH(2)) {
        float s1 = 0.f, s2 = 0.f;
        for (int i = 0; i < 64; ++i) { s1 += P.in[11][i] * P.in[12][i]; s2 += P.in[13][i] * P.in[14][i]; }
        const float lam = __expf(s1) - __expf(s2) + LAM_INIT;
        for (int k = vcu; k < 256; k += G) {
#pragma unroll 1
            for (int w = 0; w < 2; ++w) { const int idx = 2 * k + w, bh = idx >> 6, qb = idx & 63; attn_unit(lds, ZA, ZT, CAT, P.in[15], lam, NPROMPT + (bh >> 2) * 8192, 8192, bh & 3, qb); }
#pragma unroll 1
            for (int w = 0; w < 2; ++w) { const int idx = 2 * k + w, bh = idx >> 5, qb = idx & 31; attn_unit(lds, ZA, ZT, CAT, P.in[15], lam, (bh >> 2) * 4096, 4096, bh & 3, qb); }
        }
        for (int it = vcu; it < 1024; it += G) { const int ck = it >> 2, g = it & 3; gmlp_item(lds, ZA, ZT, CAT, P.in[9] + (size_t)g * 16384, P.in[8] + g * 128, P.in[10] + g * 128, ck, g); }
    }
    GRID_SYNC();

    if (PH(3)) {
        pg8::Gemm g{CAT, WoutT, NTOK, DM, DM}; EpiRes<true> e{x_prompt, x_sample - (size_t)NPROMPT * DM, H, HB, sumsq, 0};
        GEMM_RUN(EpiRes<true>, g, e);
    }
    GRID_SYNC();

#pragma unroll 1
    for (int hf = 0; hf < 2 && PH(4); ++hf) {
        if (PH(10)) { pg8::Gemm g{HB + (size_t)hf * 16384 * DM, W1T, 16384, DFF, DM}; EpiFfn1 e{HID, sumsq, hf * 16384}; GEMM_RUN(EpiFfn1, g, e); }
        GRID_SYNC();
        if (PH(11)) { pg8::Gemm g{HID, W2T, 16384, DM, DFF}; EpiRes<true> e{H, H, H, HB, sumsq + NTOK, hf * 16384}; GEMM_RUN(EpiRes<true>, g, e); }
        GRID_SYNC();
    }

    if (PH(5)) { pg8::Gemm g{HB, CinT, NTOK, 2048, DM}; EpiConvT e{TB, sumsq + NTOK}; GEMM_RUN(EpiConvT, g, e); }
    GRID_SYNC();
    if (PH(6)) { pg8::Gemm g{HB, CinT + (size_t)2048 * DM, NTOK, DM, DM}; EpiConvU e{UB, TB, sumsq + NTOK, P.in[17]}; GEMM_RUN(EpiConvU, g, e); }
    GRID_SYNC();
    if (PH(7)) { pg8::Gemm g{UB, CoutT, NTOK, DM, DM}; EpiRes<true> e{H, H, H, HB, sumsq + 2 * NTOK, 0}; GEMM_RUN(EpiRes<true>, g, e); }
    GRID_SYNC();

#pragma unroll 1
    for (int hf = 0; hf < 2 && PH(8); ++hf) {
        { pg8::Gemm g{HB + (size_t)hf * 16384 * DM, W1T + (size_t)DM * DFF, 16384, DFF, DM}; EpiFfn1 e{HID, sumsq + 2 * NTOK, hf * 16384}; GEMM_RUN(EpiFfn1, g, e); }
        GRID_SYNC();
        { pg8::Gemm g{HID, W2T + (size_t)DM * DFF, 16384, DM, DFF}; EpiRes<false> e{H, H, H, nullptr, sumsq + 3 * NTOK, hf * 16384}; GEMM_RUN(EpiRes<false>, g, e); }
        GRID_SYNC();
    }

    if (PH(9)) {
        const int gw = vcu * 8 + wave, NGW = G * 8; const float* fg = P.in[19];
        for (int m = gw; m < NTOK; m += NGW) {
            const float rs = 1.0f / sqrtf(sumsq[3 * NTOK + m] * (1.0f / DM) + EPS);
            f32x4* hr = (f32x4*)(H + (size_t)m * DM) + lane; const f32x4* gr = (const f32x4*)fg + lane;
#pragma unroll
            for (int jx = 0; jx < 4; ++jx) hr[64 * jx] = hr[64 * jx] * rs * gr[64 * jx];
        }
    }
}

extern "C" void kernel_launch(void* const* d_in, const int* in_sizes, int n_in, void* d_out, int out_size, void* d_ws, size_t ws_size, hipStream_t stream) {
    static int grid = 0;
    if (grid == 0) {
        if (n_in != 20 || out_size != NTOK * DM || ws_size < WS_END) { fprintf(stderr, "kernel_launch: unexpected shapes (n_in %d out %d ws %zu)\n", n_in, out_size, ws_size); grid = -1; return; }
        int dev = 0, cus = 0, per_cu = 0;
        hipGetDevice(&dev); hipDeviceGetAttribute(&cus, hipDeviceAttributeMultiprocessorCount, dev);
        if (hipFuncSetAttribute((const void*)mega_fwd, hipFuncAttributeMaxDynamicSharedMemorySize, LDS_BYTES) != hipSuccess) { fprintf(stderr, "kernel_launch: hipFuncSetAttribute failed\n"); grid = -1; return; }
        if (hipOccupancyMaxActiveBlocksPerMultiprocessor(&per_cu, (const void*)mega_fwd, 512, LDS_BYTES) != hipSuccess || per_cu < 1) { fprintf(stderr, "kernel_launch: occupancy query says %d\n", per_cu); per_cu = 1; }
        (void)hipGetLastError();
        grid = cus * per_cu;
    }
    if (grid < 0) return;
    Params p{};
    for (int i = 0; i < 20; ++i) p.in[i] = (const float*)d_in[i];
    p.out = (float*)d_out; p.ws = (unsigned char*)d_ws;
    void* args[] = {&p};
    hipError_t e = hipLaunchCooperativeKernel((const void*)mega_fwd, dim3(grid), dim3(512), args, LDS_BYTES, stream);
    if (e != hipSuccess) fprintf(stderr, "kernel_launch: cooperative launch failed: %s (grid %d)\n", hipGetErrorString(e), grid);
}
```

```cpp
#include <hip/hip_runtime.h>
#include <hip/hip_cooperative_groups.h>
#include <cstdio>
#include <cstdint>
namespace cg = cooperative_groups;
namespace pg8 {
#define PG8_LAS __attribute__((address_space(3)))
typedef unsigned short bf16_t;
typedef short bf16x8 __attribute__((ext_vector_type(8)));
typedef float f32x4 __attribute__((ext_vector_type(4)));
typedef unsigned u32x4 __attribute__((ext_vector_type(4)));
constexpr int BM = 256, BK = 64, HALF = 128, HTB = HALF * BK * 2  , STAGE_BYTES = 8 * HTB, NXCD = 8, WGM = 8;

__host__ __device__ __forceinline__ int lds_byte(int r, int c) { const int st = (r >> 4) * 2 + (c >> 5), rr = r & 15, cc = c & 31, ob = rr * 64 + cc * 2; return st * 1024 + (ob ^ (((ob >> 9) & 1) << 5)); }
__host__ __device__ __forceinline__ void stage_rc(int b, int& R, int& C) { const int st = b / 1024, sb = b % 1024, swz = sb ^ (((sb >> 9) & 1) << 5); R = (st >> 1) * 16 + swz / 64; C = (st & 1) * 32 + (swz % 64) / 2; }
__host__ __device__ __forceinline__ int perm32(int rho) { const int n = rho >> 4, i = rho & 15; return 8 * (i >> 2) + 4 * n + (i & 3); }

struct Unit { int pm, pn; };
struct Gemm { const bf16_t* A; const bf16_t* Bt; int M, N, K; };

struct StaticOrder {
    int nM, nN, nwg, G, c;
    __host__ __device__ void init(int M, int N, int G_, int c_) { nM = M / BM; nN = N / BM; nwg = nM * nN; G = G_; c = c_; }
    __host__ __device__ bool next(int i, Unit& u) const {
        const long L = (long)i * G + c; if (L >= nwg) return false;
        int wgid = (int)L; { const int q = nwg / NXCD, r = nwg % NXCD, xcd = wgid % NXCD, off = wgid / NXCD; wgid = (xcd < r ? xcd * (q + 1) : r * (q + 1) + (xcd - r) * q) + off; }
        const int nig = WGM * nN, gid = wgid / nig, fm = gid * WGM, gsz = (nM - fm) < WGM ? (nM - fm) : WGM;
        u.pm = fm + ((wgid % nig) % gsz); u.pn = (wgid % nig) / gsz; return true;
    }
    __device__ __forceinline__ void a_ready(const Unit&) const {}
    __device__ __forceinline__ void done(const Unit&) const {}
};

__device__ __forceinline__ unsigned cvt_pk_bf16(float lo, float hi) { unsigned r; asm volatile("v_cvt_pk_bf16_f32 %0, %1, %2" : "=v"(r) : "v"(lo), "v"(hi)); return r; }
typedef float f32x2 __attribute__((ext_vector_type(2)));
__device__ __forceinline__ f32x2 gelu_pk(f32x2 v) {
    const f32x2 av = __builtin_elementwise_abs(v), d = av * 0.2316418882f + 1.0f;
    f32x2 t; t.x = __builtin_amdgcn_rcpf(d.x); t.y = __builtin_amdgcn_rcpf(d.y);
    f32x2 q = t * 0.5307027145f + (-0.7265760135f); q = q * t + 0.7107068705f; q = q * t + (-0.142248368f); q = q * t + 0.127414796f; q = q * t;
    const f32x2 s = (v * v) * (-0.72134752044f);
    f32x2 e; e.x = __builtin_amdgcn_exp2f(s.x); e.y = __builtin_amdgcn_exp2f(s.y);
    const f32x2 m = v * (q * e), r = v - m;
    f32x2 o; o.x = v.x < 0.f ? m.x : r.x; o.y = v.y < 0.f ? m.y : r.y; return o;
}

template <class Epi, class Sched, bool ALIGN_EPI = false, bool SP2 = false>
__device__ __forceinline__ void gemm_phase(PG8_LAS unsigned char* lds, const Gemm g, const Sched& S, const Epi& E) {
    int tid_ = threadIdx.x; asm volatile("" : "+v"(tid_));
    const int tid = tid_, wid = __builtin_amdgcn_readfirstlane(tid >> 6), lane = tid & 63, wr = wid >> 2, wc = wid & 3, fr = lane & 15, fq = lane >> 4;
    const int K = g.K, nt = K / BK;
    unsigned voffA[2], voffB[2];
#pragma unroll
    for (int i = 0; i < 2; ++i) { int R, C; stage_rc(tid * 16 + i * 8192, R, C); const int Rb = Epi::PERM ? ((R & ~31) + perm32(R & 31)) : R;
        voffA[i] = (unsigned)(R * K + C) * 2u; voffB[i] = (unsigned)(Rb * K + C) * 2u; }
    const size_t kstep = (size_t)(BK * 2);
    const size_t hstep = (size_t)HALF * K * 2;
    const size_t tstep = 2 * hstep;
    const unsigned ldsw = (unsigned)wid * 1024u;
    const int aoff = lds_byte(wr * 64 + fr, fq * 8), boff = lds_byte(wc * 32 + fr, fq * 8);
#define PG8_SA(b, h) (((b) * 2 + (h)) * HTB)
#define PG8_SB(b, h) ((4 + (b) * 2 + (h)) * HTB)
#define PG8_STAGE(bufoff, gbase, voff) do { _Pragma("unroll") for (int _i = 0; _i < 2; ++_i) \
        __builtin_amdgcn_global_load_lds((const unsigned*)((const char*)(gbase) + (voff)[_i]), (PG8_LAS unsigned*)(lds + (bufoff) + ldsw + _i * 8192), 16, 0, 0); } while (0)
#define PG8_LDA(dst, b, h) do { _Pragma("unroll") for (int m = 0; m < 4; ++m) _Pragma("unroll") for (int k = 0; k < 2; ++k) dst[m][k] = *(const PG8_LAS bf16x8*)(lds + PG8_SA(b, h) + aoff + m * 2048 + k * 1024); } while (0)
#define PG8_LDB(dst, b, h) do { _Pragma("unroll") for (int n = 0; n < 2; ++n) _Pragma("unroll") for (int k = 0; k < 2; ++k) dst[n][k] = *(const PG8_LAS bf16x8*)(lds + PG8_SB(b, h) + boff + n * 2048 + k * 1024); } while (0)
#define PG8_MMA(ai, bj, At, Bt) do { __builtin_amdgcn_s_setprio(1); _Pragma("unroll") for (int m = 0; m < 4; ++m) _Pragma("unroll") for (int n = 0; n < 2; ++n) _Pragma("unroll") for (int k = 0; k < 2; ++k) \
        acc[ai][bj][m][n] = __builtin_amdgcn_mfma_f32_16x16x32_bf16(Bt[n][k], At[m][k], acc[ai][bj][m][n], 0, 0, 0); __builtin_amdgcn_s_setprio(0); } while (0)
#define PG8_WAIT_V(n) asm volatile("s_waitcnt vmcnt(" #n ")" ::: "memory")
#define PG8_WAIT_L(n) asm volatile("s_waitcnt lgkmcnt(" #n ")" ::: "memory")
#define PG8_BAR __builtin_amdgcn_s_barrier()
#define PG8_SCHED __builtin_amdgcn_sched_barrier(0)
    Unit cur, nxt; int ui = 0;
    if (!S.next(0, cur)) return;
    f32x4 acc[2][2][4][2];
#pragma unroll
    for (int a = 0; a < 2; ++a)
#pragma unroll
        for (int b = 0; b < 2; ++b)
#pragma unroll
            for (int m = 0; m < 4; ++m)
#pragma unroll
                for (int n = 0; n < 2; ++n) acc[a][b][m][n] = (f32x4){0.f, 0.f, 0.f, 0.f};
    bf16x8 At[4][2], B0[2][2], B1[2][2];
    const char* cA = (const char*)g.A + (size_t)cur.pm * tstep; const char* cB = (const char*)g.Bt + (size_t)cur.pn * tstep;
    S.a_ready(cur);
    if constexpr (SP2) {
        PG8_STAGE(PG8_SB(0, 0), cB, voffB); PG8_STAGE(PG8_SB(0, 1), cB + hstep, voffB); PG8_STAGE(PG8_SA(0, 0), cA, voffA); PG8_STAGE(PG8_SA(0, 1), cA + hstep, voffA);
        if (wr == 1) PG8_BAR;
        PG8_WAIT_V(2); PG8_BAR;
        PG8_STAGE(PG8_SB(1, 0), cB + kstep, voffB); PG8_STAGE(PG8_SA(1, 0), cA + kstep, voffA); PG8_STAGE(PG8_SB(1, 1), cB + hstep + kstep, voffB);
        PG8_WAIT_V(6); PG8_BAR;
    } else {
        PG8_STAGE(PG8_SB(0, 0), cB, voffB); PG8_STAGE(PG8_SA(0, 0), cA, voffA); PG8_STAGE(PG8_SB(0, 1), cB + hstep, voffB); PG8_STAGE(PG8_SA(0, 1), cA + hstep, voffA);
        if (wr == 1) PG8_BAR;
        PG8_WAIT_V(4); PG8_BAR;
        PG8_STAGE(PG8_SB(1, 0), cB + kstep, voffB); PG8_STAGE(PG8_SA(1, 0), cA + kstep, voffA); PG8_STAGE(PG8_SB(1, 1), cB + hstep + kstep, voffB);
        PG8_WAIT_V(6); PG8_BAR;
    }
    for (;;) {
        const bool has_next = S.next(ui + 1, nxt);
        const char* nA = has_next ? (const char*)g.A + (size_t)nxt.pm * tstep : cA; const char* nB = has_next ? (const char*)g.Bt + (size_t)nxt.pn * tstep : cB;
        for (int t = 0; t < nt; t += 2) {
            const bool last = (t == nt - 2);
            const char* a1 = cA + (size_t)(t + 1) * kstep;
            const char* a2 = last ? nA : cA + (size_t)(t + 2) * kstep; const char* b2 = last ? nB : cB + (size_t)(t + 2) * kstep;
            const char* a3 = a2 + kstep; const char* b3 = b2 + kstep;
            if (last && has_next) S.a_ready(nxt);
            if constexpr (SP2) {
            PG8_LDB(B0, 0, 0); PG8_LDB(B1, 0, 1); PG8_SCHED; PG8_LDA(At, 0, 0); PG8_STAGE(PG8_SA(1, 1), a1 + hstep, voffA);
            PG8_WAIT_V(8); PG8_WAIT_L(0); PG8_BAR; PG8_MMA(0, 0, At, B0); PG8_MMA(0, 1, At, B1); PG8_BAR; PG8_SCHED;
            PG8_LDA(At, 0, 1); PG8_STAGE(PG8_SB(0, 0), b2, voffB); PG8_STAGE(PG8_SB(0, 1), b2 + hstep, voffB); PG8_STAGE(PG8_SA(0, 0), a2, voffA);
            PG8_WAIT_V(8); PG8_WAIT_L(0); PG8_BAR; PG8_MMA(1, 0, At, B0); PG8_MMA(1, 1, At, B1); PG8_BAR; PG8_SCHED;
            PG8_LDB(B0, 1, 0); PG8_LDB(B1, 1, 1); PG8_SCHED; PG8_LDA(At, 1, 0); PG8_STAGE(PG8_SA(0, 1), a2 + hstep, voffA);
            PG8_WAIT_V(8); PG8_WAIT_L(0); PG8_BAR; PG8_MMA(0, 0, At, B0); PG8_MMA(0, 1, At, B1); PG8_BAR; PG8_SCHED;
            PG8_LDA(At, 1, 1); PG8_STAGE(PG8_SB(1, 0), b3, voffB); PG8_STAGE(PG8_SB(1, 1), b3 + hstep, voffB); PG8_STAGE(PG8_SA(1, 0), a3, voffA);
            PG8_WAIT_V(8); PG8_WAIT_L(0); PG8_BAR; PG8_MMA(1, 0, At, B0); PG8_MMA(1, 1, At, B1); PG8_BAR; PG8_SCHED;
            } else {
            PG8_LDB(B0, 0, 0); PG8_SCHED; PG8_LDA(At, 0, 0); PG8_STAGE(PG8_SA(1, 1), a1 + hstep, voffA);
            PG8_WAIT_L(8); PG8_BAR; PG8_WAIT_L(0); PG8_MMA(0, 0, At, B0); PG8_BAR; PG8_SCHED;
            PG8_LDB(B1, 0, 1); PG8_STAGE(PG8_SB(0, 0), b2, voffB);
            PG8_BAR; PG8_WAIT_L(0); PG8_MMA(0, 1, At, B1); PG8_BAR;
            PG8_LDA(At, 0, 1); PG8_STAGE(PG8_SA(0, 0), a2, voffA);
            PG8_BAR; PG8_WAIT_L(0); PG8_MMA(1, 0, At, B0); PG8_BAR; PG8_SCHED;
            PG8_STAGE(PG8_SB(0, 1), b2 + hstep, voffB);
            PG8_WAIT_V(6); PG8_BAR; PG8_MMA(1, 1, At, B1); PG8_BAR;
            PG8_LDB(B0, 1, 0); PG8_SCHED; PG8_LDA(At, 1, 0); PG8_STAGE(PG8_SA(0, 1), a2 + hstep, voffA);
            PG8_WAIT_L(8); PG8_BAR; PG8_WAIT_L(0); PG8_MMA(0, 0, At, B0); PG8_BAR; PG8_SCHED;
            PG8_LDB(B1, 1, 1); PG8_STAGE(PG8_SB(1, 0), b3, voffB);
            PG8_BAR; PG8_WAIT_L(0); PG8_MMA(0, 1, At, B1); PG8_BAR;
            PG8_LDA(At, 1, 1); PG8_STAGE(PG8_SA(1, 0), a3, voffA);
            PG8_BAR; PG8_WAIT_L(0); PG8_MMA(1, 0, At, B0); PG8_BAR; PG8_SCHED;
            PG8_STAGE(PG8_SB(1, 1), b3 + hstep, voffB);
            PG8_WAIT_V(6); PG8_BAR; PG8_MMA(1, 1, At, B1); PG8_BAR;
            }
        }
        if constexpr (ALIGN_EPI) { if (wr == 0) PG8_BAR; }
        if constexpr (!Epi::AFTER_DRAIN) { E(acc, cur, wr, wc, fr, fq); S.done(cur); }
        if (!has_next) break;
#pragma unroll
        for (int a = 0; a < 2; ++a)
#pragma unroll
            for (int b = 0; b < 2; ++b)
#pragma unroll
                for (int m = 0; m < 4; ++m)
#pragma unroll
                    for (int n = 0; n < 2; ++n) acc[a][b][m][n] = (f32x4){0.f, 0.f, 0.f, 0.f};
        cur = nxt; cA = nA; cB = nB; ++ui;
        if constexpr (ALIGN_EPI) { if (wr == 1) PG8_BAR; }
    }
    PG8_WAIT_V(0);
    if constexpr (!ALIGN_EPI) { if (wr == 0) PG8_BAR; }
    PG8_BAR;
    if constexpr (Epi::AFTER_DRAIN) { E.fused(acc, cur, wr, wc, fr, fq, lds, wid, lane); S.done(cur); }
#undef PG8_SA
#undef PG8_SB
#undef PG8_STAGE
#undef PG8_LDA
#undef PG8_LDB
#undef PG8_MMA
#undef PG8_WAIT_V
#undef PG8_WAIT_L
#undef PG8_BAR
#undef PG8_SCHED
}
}

#ifndef PG8_SP2
#define PG8_SP2 true
#endif
#ifndef PG8_ALIGN
#define PG8_ALIGN true
#endif
#define LAS __attribute__((address_space(3)))
typedef unsigned short bf16_t;
typedef short bf16x8 __attribute__((ext_vector_type(8)));
typedef float f32x4 __attribute__((ext_vector_type(4)));
typedef float f32x16 __attribute__((ext_vector_type(16)));
typedef unsigned u32x4 __attribute__((ext_vector_type(4)));
typedef unsigned u32x2 __attribute__((ext_vector_type(2)));
using pg8::Unit;

constexpr int NTOK = 32768, NPROMPT = 16384, DM = 1024, DFF = 4096;
constexpr int NZA = 1536;
constexpr float EPS = 1e-5f;
constexpr float C2 = 0.125f * 1.4426950408889634f;
constexpr float LAM_INIT = 0.2f;
constexpr size_t MiB = 1u << 20;
constexpr size_t WS_SUMSQ = 0;
constexpr size_t WS_BAR = 512 * 1024, BAR_BYTES = 16384;
constexpr size_t WS_WIN = 1 * MiB, WS_WOUT = 6 * MiB, WS_W1 = 8 * MiB, WS_W2 = 24 * MiB, WS_CIN = 40 * MiB, WS_COUT = 46 * MiB, WS_ROPE = 48 * MiB;
constexpr size_t WS_HB = 49 * MiB;
constexpr size_t WS_BIG = 113 * MiB;
constexpr size_t WS_END = 241 * MiB;
constexpr int LDS_BYTES = 147456;

struct Params { const float* in[20]; float* out; unsigned char* ws; };

__device__ __forceinline__ unsigned cvtpk(float lo, float hi) { return pg8::cvt_pk_bf16(lo, hi); }
__device__ __forceinline__ u32x4 pack8(f32x4 a, f32x4 b) { u32x4 w; w.x = cvtpk(a[0], a[1]); w.y = cvtpk(a[2], a[3]); w.z = cvtpk(b[0], b[1]); w.w = cvtpk(b[2], b[3]); return w; }
__device__ __forceinline__ float bflo(unsigned x) { return __uint_as_float(x << 16); }
__device__ __forceinline__ float bfhi(unsigned x) { return __uint_as_float(x & 0xffff0000u); }
__device__ __forceinline__ void unpack8(u32x4 w, f32x4& a, f32x4& b) { a = (f32x4){bflo(w.x), bfhi(w.x), bflo(w.y), bfhi(w.y)}; b = (f32x4){bflo(w.z), bfhi(w.z), bflo(w.w), bfhi(w.w)}; }
__device__ __forceinline__ float gelu_tanh(float x) { const float t = x * (1.0f + 0.044715f * x * x); const float e = __builtin_amdgcn_exp2f(-2.302208198f * t); return x * __builtin_amdgcn_rcpf(1.0f + e); }
__device__ __forceinline__ f32x4 gelu4(f32x4 v) { return (f32x4){gelu_tanh(v[0]), gelu_tanh(v[1]), gelu_tanh(v[2]), gelu_tanh(v[3])}; }
__device__ __forceinline__ float wave_sum(float v) {
#pragma unroll
    for (int o = 1; o < 64; o <<= 1) v += __shfl_xor(v, o);
    return v;
}
__device__ __forceinline__ int seqpos(int row) { return row < NPROMPT ? (row & 4095) : (row & 8191); }

struct EpiA {
    static constexpr bool PERM = true, AFTER_DRAIN = false;
    bf16_t* ZA; const float* rope;
    __device__ __forceinline__ void operator()(const f32x4 (&acc)[2][2][4][2], const Unit& u, int wr, int wc, int fr, int fq) const {
        const int row0 = u.pm * 256 + wr * 64 + fr, kind = u.pn >> 1, col0 = u.pn * 256 + wc * 32 + 8 * fq;
        const bool ropew = (kind != 0) && ((wc & 1) == 0);
        const float sgn = (fq == 0) ? -1.f : 1.f, sc = (kind == 1) ? C2 : 1.f;
#pragma unroll
        for (int ai = 0; ai < 2; ++ai)
#pragma unroll
            for (int m = 0; m < 4; ++m) {
                const int row = row0 + ai * 128 + m * 16;
                f32x4 c0 = {1.f, 1.f, 1.f, 1.f}, c1 = c0, s0 = {0.f, 0.f, 0.f, 0.f}, s1 = s0;
                if (ropew) { const float* rp = rope + seqpos(row) * 16; c0 = *(const f32x4*)rp; c1 = *(const f32x4*)(rp + 4); s0 = *(const f32x4*)(rp + 8); s1 = *(const f32x4*)(rp + 12); }
                bf16_t* op = ZA + (size_t)row * NZA + col0;
#pragma unroll
                for (int bj = 0; bj < 2; ++bj) {
                    f32x4 v0 = acc[ai][bj][m][0], v1 = acc[ai][bj][m][1];
                    if (kind == 0) { v0 = gelu4(v0); v1 = gelu4(v1); }
                    else {
                        if (ropew) {
                            f32x4 p0, p1;
#pragma unroll
                            for (int e = 0; e < 4; ++e) { p0[e] = __shfl_xor(v0[e], 16); p1[e] = __shfl_xor(v1[e], 16); }
                            if (fq < 2) { v0 = v0 * c0 + (p0 * s0) * sgn; v1 = v1 * c1 + (p1 * s1) * sgn; }
                        }
                        v0 = v0 * sc; v1 = v1 * sc;
                    }
                    *(u32x4*)(op + bj * 128) = pack8(v0, v1);
                }
                asm volatile("" ::: "memory");
            }
    }
};
struct EpiB {
    static constexpr bool PERM = true, AFTER_DRAIN = false;
    bf16_t* ZT;
    __device__ __forceinline__ void operator()(const f32x4 (&acc)[2][2][4][2], const Unit& u, int wr, int wc, int fr, int fq) const {
        const int row0 = u.pm * 256 + wr * 64 + fr, col0 = u.pn * 256 + wc * 32 + 8 * fq; const bool act = u.pm < 2;
#pragma unroll
        for (int ai = 0; ai < 2; ++ai)
#pragma unroll
            for (int m = 0; m < 4; ++m) {
                bf16_t* op = ZT + (size_t)(row0 + ai * 128 + m * 16) * NTOK + col0;
#pragma unroll
                for (int bj = 0; bj < 2; ++bj) {
                    f32x4 v0 = acc[ai][bj][m][0], v1 = acc[ai][bj][m][1];
                    if (act) { v0 = gelu4(v0); v1 = gelu4(v1); }
                    *(u32x4*)(op + bj * 128) = pack8(v0, v1);
                }
            }
    }
};
template <int MODE> struct EpiRes {
    static constexpr bool PERM = true, AFTER_DRAIN = false;
    const float* res0; const float* res1; float* H; bf16_t* HB; float* sumsq; int rowbase;
    __device__ __forceinline__ void operator()(const f32x4 (&acc)[2][2][4][2], const Unit& u, int wr, int wc, int fr, int fq) const {
        const int row0 = rowbase + u.pm * 256 + wr * 64 + fr, col0 = u.pn * 256 + wc * 32 + 8 * fq;
#pragma unroll
        for (int ai = 0; ai < 2; ++ai)
#pragma unroll
            for (int m = 0; m < 4; ++m) {
                const int row = row0 + ai * 128 + m * 16;
                const size_t off = (size_t)row * DM + col0; float ss = 0.f;
#pragma unroll
                for (int bj = 0; bj < 2; ++bj) {
                    f32x4 r0, r1;
                    if (MODE == 0) { const float* rp = (row < NPROMPT ? res0 : res1) + off + bj * 128; r0 = *(const f32x4*)rp; r1 = *(const f32x4*)(rp + 4); }
                    else unpack8(*(const u32x4*)(HB + off + bj * 128), r0, r1);
                    const f32x4 v0 = acc[ai][bj][m][0] + r0, v1 = acc[ai][bj][m][1] + r1;
                    if (MODE == 2) { *(f32x4*)(H + off + bj * 128) = v0; *(f32x4*)(H + off + bj * 128 + 4) = v1; }
                    else *(u32x4*)(HB + off + bj * 128) = pack8(v0, v1);
                    ss += (v0[0] * v0[0] + v0[1] * v0[1]) + (v0[2] * v0[2] + v0[3] * v0[3]) + (v1[0] * v1[0] + v1[1] * v1[1]) + (v1[2] * v1[2] + v1[3] * v1[3]);
                }
                ss += __shfl_xor(ss, 16); ss += __shfl_xor(ss, 32);
                if (fq == 0) __hip_atomic_fetch_add(sumsq + row, ss, __ATOMIC_RELAXED, __HIP_MEMORY_SCOPE_AGENT);
                asm volatile("" ::: "memory");
            }
    }
};
struct EpiFfn1 {
    static constexpr bool PERM = true, AFTER_DRAIN = false;
    bf16_t* HID; const float* sumsq; int rowbase;
    __device__ __forceinline__ void operator()(const f32x4 (&acc)[2][2][4][2], const Unit& u, int wr, int wc, int fr, int fq) const {
        const int lrow0 = u.pm * 256 + wr * 64 + fr, col0 = u.pn * 256 + wc * 32 + 8 * fq;
#pragma unroll
        for (int ai = 0; ai < 2; ++ai)
#pragma unroll
            for (int m = 0; m < 4; ++m) {
                const int lrow = lrow0 + ai * 128 + m * 16;
                const float rs = __builtin_amdgcn_rsqf(sumsq[rowbase + lrow] * (1.0f / DM) + EPS);
                bf16_t* op = HID + (size_t)lrow * DFF + col0;
#pragma unroll
                for (int bj = 0; bj < 2; ++bj) {
                    f32x4 v0 = acc[ai][bj][m][0] * rs, v1 = acc[ai][bj][m][1] * rs;
#pragma unroll
                    for (int e = 0; e < 4; ++e) { const float a = fmaxf(v0[e], 0.f), b = fmaxf(v1[e], 0.f); v0[e] = a * a; v1[e] = b * b; }
                    *(u32x4*)(op + bj * 128) = pack8(v0, v1);
                }
                asm volatile("" ::: "memory");
            }
    }
};
struct EpiConvT {
    static constexpr bool PERM = true, AFTER_DRAIN = false;
    bf16_t* T; const float* sumsq;
    __device__ __forceinline__ void operator()(const f32x4 (&acc)[2][2][4][2], const Unit& u, int wr, int wc, int fr, int fq) const {
        const int row0 = u.pm * 256 + wr * 64 + fr, ch0 = u.pn * 128 + wc * 32 + 8 * fq;
#pragma unroll
        for (int ai = 0; ai < 2; ++ai)
#pragma unroll
            for (int m = 0; m < 4; ++m) {
                const int row = row0 + ai * 128 + m * 16;
                const float rs = __builtin_amdgcn_rsqf(sumsq[row] * (1.0f / DM) + EPS), rs2 = rs * rs;
                const f32x4 v0 = acc[ai][0][m][0] * acc[ai][1][m][0] * rs2, v1 = acc[ai][0][m][1] * acc[ai][1][m][1] * rs2;
                *(u32x4*)(T + (size_t)row * DM + ch0) = pack8(v0, v1);
                asm volatile("" ::: "memory");
            }
    }
};
struct EpiConvU {
    static constexpr bool PERM = true, AFTER_DRAIN = false;
    bf16_t* U; const bf16_t* T; const float* sumsq; const float* cw;
    __device__ __forceinline__ void operator()(const f32x4 (&acc)[2][2][4][2], const Unit& u, int wr, int wc, int fr, int fq) const {
        const int row0 = u.pm * 256 + wr * 64 + fr;
#pragma unroll
        for (int bj = 0; bj < 2; ++bj) {
            const int ch0 = u.pn * 256 + bj * 128 + wc * 32 + 8 * fq;
            const f32x4 w0a = *(const f32x4*)(cw + ch0), w0b = *(const f32x4*)(cw + ch0 + 4), w1a = *(const f32x4*)(cw + DM + ch0), w1b = *(const f32x4*)(cw + DM + ch0 + 4),
                        w2a = *(const f32x4*)(cw + 2 * DM + ch0), w2b = *(const f32x4*)(cw + 2 * DM + ch0 + 4);
#pragma unroll
            for (int ai = 0; ai < 2; ++ai)
#pragma unroll
                for (int m = 0; m < 4; ++m) {
                    const int row = row0 + ai * 128 + m * 16, pos = seqpos(row), slen = row < NPROMPT ? 4096 : 8192;
                    const float rs = __builtin_amdgcn_rsqf(sumsq[row] * (1.0f / DM) + EPS);
                    const bf16_t* tp = T + (size_t)row * DM + ch0;
                    const u32x4 z = {0u, 0u, 0u, 0u};
                    const u32x4 tc = *(const u32x4*)tp;
                    const u32x4 tl = (pos > 0) ? *(const u32x4*)(tp - DM) : z;
                    const u32x4 tn = (pos < slen - 1) ? *(const u32x4*)(tp + DM) : z;
                    f32x4 ca, cb, la, lb, na, nb; unpack8(tc, ca, cb); unpack8(tl, la, lb); unpack8(tn, na, nb);
                    const f32x4 ya = w0a * la + w1a * ca + w2a * na, yb = w0b * lb + w1b * cb + w2b * nb;
                    const f32x4 v0 = acc[ai][bj][m][0] * rs * ya, v1 = acc[ai][bj][m][1] * rs * yb;
                    *(u32x4*)(U + (size_t)row * DM + ch0) = pack8(v0, v1);
                    asm volatile("" ::: "memory");
                }
        }
    }
};

template <int MAP> __device__ __forceinline__ int orow_map(int n) {
    if (MAP == 1) { const int b = n >> 9; const int ob = (b == 0) ? 0 : (b == 1) ? 3 : (b == 2) ? 1 : (b == 3) ? 2 : 4; return ob * 512 + (n & 511); }
    if (MAP == 2) { if (n < 1024) return 2048 + n; const int hs = (n >= 2048) ? 1 : 0; const int ch = n - 1024 - hs * 1024; return (ch >> 7) * 256 + hs * 128 + (ch & 127); }
    return n;
}
template <int MAP> __device__ __forceinline__ void transpose_item(const float* W, int K, int N, bf16_t* WT, const float* gk, LAS float* scr, int item, int lane) {
    const int nblk = N / 32, kb = item / nblk, nb = item % nblk, k0 = 64 * kb, n0 = 32 * nb;
#pragma unroll 8
    for (int i = 0; i < 32; ++i) { const int kk = 2 * i + (lane >> 5); float v = W[(size_t)(k0 + kk) * N + n0 + (lane & 31)]; if (gk) v *= gk[k0 + kk]; scr[kk * 33 + (lane & 31)] = v; }
    asm volatile("s_waitcnt lgkmcnt(0)" ::: "memory");
    const int c = lane & 7; const int or0 = orow_map<MAP>(n0);
#pragma unroll
    for (int j = 0; j < 4; ++j) { const int n = (lane >> 3) + 8 * j; const LAS float* s = scr + (8 * c) * 33 + n;
        u32x4 o; o.x = cvtpk(s[0 * 33], s[1 * 33]); o.y = cvtpk(s[2 * 33], s[3 * 33]); o.z = cvtpk(s[4 * 33], s[5 * 33]); o.w = cvtpk(s[6 * 33], s[7 * 33]);
        *(u32x4*)(WT + (size_t)(or0 + n) * K + k0 + 8 * c) = o; }
    asm volatile("s_waitcnt lgkmcnt(0)" ::: "memory");
}
__device__ __forceinline__ void rms_row_to_bf16(const float* xrow, const float* g, bf16_t* orow, int lane) {
    const f32x4* xr = (const f32x4*)xrow + lane; const f32x4* gr = (const f32x4*)g + lane;
    f32x4 v[4]; float s = 0.f;
#pragma unroll
    for (int j = 0; j < 4; ++j) { v[j] = xr[64 * j]; s += (v[j][0] * v[j][0] + v[j][1] * v[j][1]) + (v[j][2] * v[j][2] + v[j][3] * v[j][3]); }
    const float rstd = 1.0f / sqrtf(wave_sum(s) * (1.0f / DM) + EPS);
    u32x2* o8 = (u32x2*)orow + lane;
#pragma unroll
    for (int j = 0; j < 4; ++j) { const f32x4 gg = gr[64 * j]; const f32x4 y = v[j] * rstd * gg; u32x2 w; w.x = cvtpk(y[0], y[1]); w.y = cvtpk(y[2], y[3]); o8[64 * j] = w; }
}

__device__ __forceinline__ int swap23(int x) { return (x & ~12) | ((x & 4) << 1) | ((x & 8) >> 1); }
__device__ __forceinline__ float half_swap_max(float v) { auto rr = __builtin_amdgcn_permlane32_swap(__float_as_uint(v), __float_as_uint(v), false, false); return fmaxf(__uint_as_float(rr[0]), __uint_as_float(rr[1])); }
__device__ __forceinline__ float half_swap_sum(float v) { auto rr = __builtin_amdgcn_permlane32_swap(__float_as_uint(v), __float_as_uint(v), false, false); return __uint_as_float(rr[0]) + __uint_as_float(rr[1]); }

__device__ __forceinline__ void attn_unit(LAS unsigned char* lds, const bf16_t* __restrict__ ZA, const bf16_t* __restrict__ ZT, bf16_t* __restrict__ CAT, const float* __restrict__ subg,
                                          float lam, int seqrow0, int slen, int h, int qb) {
    int tid_ = threadIdx.x; asm volatile("" : "+v"(tid_));
    const int tid = tid_, lane = tid & 63, r32 = lane & 31, hi = lane >> 5;
    const int wid = __builtin_amdgcn_readfirstlane(tid >> 6), j = wid >> 2, sub = wid & 3;
    const int qrow = seqrow0 + qb * 128 + sub * 32 + r32;
    bf16x8 qr[4];
#pragma unroll
    for (int d0 = 0; d0 < 4; ++d0) qr[d0] = *(const bf16x8*)(ZA + (size_t)qrow * NZA + 512 + h * 128 + j * 64 + d0 * 16 + hi * 8);
    const bf16_t* ksrc[2]; const bf16_t* vsrc[2]; int kdst[2], vdst[2];
#pragma unroll
    for (int i = 0; i < 2; ++i) {
        const int kv = (tid >> 4) + 32 * i, ch = tid & 15, jj = ch >> 3, dch = ch & 7, rho = (kv & ~15) | swap23(kv & 15);
        ksrc[i] = ZA + (size_t)(seqrow0 + kv) * NZA + 1024 + h * 128 + ch * 8;
        kdst[i] = jj * 8192 + rho * 128 + ((dch ^ ((rho >> 1) & 7)) * 16);
        const int d = (tid >> 3) + 64 * i, vch = tid & 7;
        vsrc[i] = ZT + (size_t)(512 + h * 128 + d) * NTOK + seqrow0 + vch * 8;
        vdst[i] = 16384 + d * 128 + ((vch ^ ((d >> 1) & 7)) * 16);
    }
    const int NT = slen / 64;
    u32x4 sk[2], sv[2];
#pragma unroll
    for (int i = 0; i < 2; ++i) { sk[i] = *(const u32x4*)ksrc[i]; sv[i] = *(const u32x4*)vsrc[i]; }
#pragma unroll
    for (int i = 0; i < 2; ++i) { *(LAS u32x4*)(lds + kdst[i]) = sk[i]; *(LAS u32x4*)(lds + vdst[i]) = sv[i]; }
    __syncthreads();
    f32x16 o[4];
#pragma unroll
    for (int b = 0; b < 4; ++b)
#pragma unroll
        for (int r = 0; r < 16; ++r) o[b][r] = 0.f;
    float mrun = -INFINITY, lsum = 0.f;
    const int swz = (r32 >> 1) & 7;
    for (int t = 0; t < NT; ++t) {
        const int cur = (t & 1) * 32768, nxt = 32768 - cur;
        const bool more = (t + 1 < NT);
        if (more) {
#pragma unroll
            for (int i = 0; i < 2; ++i) { sk[i] = *(const u32x4*)(ksrc[i] + (size_t)(t + 1) * 64 * NZA); sv[i] = *(const u32x4*)(vsrc[i] + (t + 1) * 64); }
        }
        f32x16 p0, p1;
#pragma unroll
        for (int r = 0; r < 16; ++r) { p0[r] = 0.f; p1[r] = 0.f; }
        const LAS unsigned char* kb = lds + cur + j * 8192 + r32 * 128;
#pragma unroll
        for (int d0 = 0; d0 < 4; ++d0) {
            const int off = ((2 * d0 + hi) ^ swz) * 16;
            const bf16x8 a0 = *(const LAS bf16x8*)(kb + off), a1 = *(const LAS bf16x8*)(kb + 4096 + off);
            p0 = __builtin_amdgcn_mfma_f32_32x32x16_bf16(a0, qr[d0], p0, 0, 0, 0);
            p1 = __builtin_amdgcn_mfma_f32_32x32x16_bf16(a1, qr[d0], p1, 0, 0, 0);
        }
        float rm = fmaxf(p0[0], p1[0]);
#pragma unroll
        for (int r = 1; r < 16; ++r) rm = fmaxf(rm, fmaxf(p0[r], p1[r]));
        rm = half_swap_max(rm);
        if (__any(rm > mrun)) {
            const float mnew = fmaxf(mrun, rm), alpha = __builtin_amdgcn_exp2f(mrun - mnew);
            lsum *= alpha;
#pragma unroll
            for (int b = 0; b < 4; ++b)
#pragma unroll
                for (int r = 0; r < 16; ++r) o[b][r] *= alpha;
            mrun = mnew;
        }
        float ps = 0.f;
#pragma unroll
        for (int r = 0; r < 16; ++r) { p0[r] = __builtin_amdgcn_exp2f(p0[r] - mrun); p1[r] = __builtin_amdgcn_exp2f(p1[r] - mrun); ps += p0[r] + p1[r]; }
        lsum += ps;
        bf16x8 pb[4];
        { u32x4 w;
          w.x = cvtpk(p0[0], p0[1]); w.y = cvtpk(p0[2], p0[3]); w.z = cvtpk(p0[4], p0[5]); w.w = cvtpk(p0[6], p0[7]); pb[0] = __builtin_bit_cast(bf16x8, w);
          w.x = cvtpk(p0[8], p0[9]); w.y = cvtpk(p0[10], p0[11]); w.z = cvtpk(p0[12], p0[13]); w.w = cvtpk(p0[14], p0[15]); pb[1] = __builtin_bit_cast(bf16x8, w);
          w.x = cvtpk(p1[0], p1[1]); w.y = cvtpk(p1[2], p1[3]); w.z = cvtpk(p1[4], p1[5]); w.w = cvtpk(p1[6], p1[7]); pb[2] = __builtin_bit_cast(bf16x8, w);
          w.x = cvtpk(p1[8], p1[9]); w.y = cvtpk(p1[10], p1[11]); w.z = cvtpk(p1[12], p1[13]); w.w = cvtpk(p1[14], p1[15]); pb[3] = __builtin_bit_cast(bf16x8, w); }
        const LAS unsigned char* vb = lds + cur + 16384 + r32 * 128;
#pragma unroll
        for (int b = 0; b < 4; ++b)
#pragma unroll
            for (int jj = 0; jj < 4; ++jj) {
                const bf16x8 a = *(const LAS bf16x8*)(vb + b * 4096 + (((2 * jj + hi) ^ swz) * 16));
                o[b] = __builtin_amdgcn_mfma_f32_32x32x16_bf16(a, pb[jj], o[b], 0, 0, 0);
            }
        if (more) {
#pragma unroll
            for (int i = 0; i < 2; ++i) { *(LAS u32x4*)(lds + nxt + kdst[i]) = sk[i]; *(LAS u32x4*)(lds + nxt + vdst[i]) = sv[i]; }
        }
        __syncthreads();
    }
    const float inv = 1.0f / half_swap_sum(lsum);
    LAS float* X = (LAS float*)lds + sub * 4096 + lane;
    if (j == 1) {
        const float f = inv * lam;
#pragma unroll
        for (int b = 0; b < 4; ++b)
#pragma unroll
            for (int r = 0; r < 16; ++r) X[(b * 16 + r) * 64] = o[b][r] * f;
    }
    __syncthreads();
    if (j == 0) {
        float ss = 0.f;
#pragma unroll
        for (int b = 0; b < 4; ++b)
#pragma unroll
            for (int r = 0; r < 16; ++r) { const float v = o[b][r] * inv - X[(b * 16 + r) * 64]; o[b][r] = v; ss += v * v; }
        ss = half_swap_sum(ss);
        const float rs = __builtin_amdgcn_rsqf(ss * (1.0f / 128.0f) + EPS) * (1.0f - LAM_INIT);
        bf16_t* op = CAT + (size_t)qrow * DM + 512 + h * 128;
#pragma unroll
        for (int b = 0; b < 4; ++b)
#pragma unroll
            for (int a = 0; a < 4; ++a) {
                const int d0 = 32 * b + 8 * a + 4 * hi; const f32x4 g = *(const f32x4*)(subg + d0);
                u32x2 w; w.x = cvtpk(o[b][4 * a] * rs * g[0], o[b][4 * a + 1] * rs * g[1]); w.y = cvtpk(o[b][4 * a + 2] * rs * g[2], o[b][4 * a + 3] * rs * g[3]);
                *(u32x2*)(op + d0) = w;
            }
    }
    __syncthreads();
}

__device__ __forceinline__ void gmlp_item(LAS unsigned char* lds, const bf16_t* __restrict__ ZA, const bf16_t* __restrict__ ZT, bf16_t* __restrict__ CAT, const float* __restrict__ Wsg,
                                          const float* __restrict__ vng, const float* __restrict__ bsg, int ck, int g) {
    int tid_ = threadIdx.x; asm volatile("" : "+v"(tid_));
    const int tid = tid_, lane = tid & 63, r32 = lane & 31, hi = lane >> 5;
    const int wid = __builtin_amdgcn_readfirstlane(tid >> 6);
    const int R0 = ck * 128;
    LAS float* red = (LAS float*)(lds + 32768); LAS float* rstd = (LAS float*)(lds + 32768 + 2048);
#pragma unroll
    for (int i = 0; i < 4; ++i) {
        const int c = tid + 512 * i, e = c >> 4, ch = c & 15;
        const u32x4 v = *(const u32x4*)(ZT + (size_t)(g * 128 + e) * NTOK + R0 + ch * 8);
        *(LAS u32x4*)(lds + e * 256 + ((ch ^ (e & 15)) * 16)) = v;
    }
    __syncthreads();
    { const int q = tid & 127, part = tid >> 7; float s = 0.f;
#pragma unroll 8
      for (int ee = 0; ee < 32; ++ee) { const int e = part * 32 + ee; const unsigned short b = *(const LAS unsigned short*)(lds + e * 256 + (((q >> 3) ^ (e & 15)) * 16) + (q & 7) * 2); const float v = __uint_as_float((unsigned)b << 16); s += v * v; }
      red[part * 128 + q] = s; }
    __syncthreads();
    if (tid < 128) rstd[tid] = __builtin_amdgcn_rsqf((red[tid] + red[128 + tid] + red[256 + tid] + red[384 + tid]) * (1.0f / 128.0f) + EPS);
    __syncthreads();
    const int eblk = wid & 3, pb0 = 2 * (wid >> 2);
    f32x16 acc[2];
#pragma unroll
    for (int r = 0; r < 16; ++r) { acc[0][r] = 0.f; acc[1][r] = 0.f; }
#pragma unroll
    for (int kk = 0; kk < 8; ++kk) {
        const bf16x8 a = *(const LAS bf16x8*)(lds + (32 * eblk + r32) * 256 + (((2 * kk + hi) ^ (r32 & 15)) * 16));
        const f32x4 ra = *(const LAS f32x4*)(rstd + 16 * kk + 8 * hi), rb = *(const LAS f32x4*)(rstd + 16 * kk + 8 * hi + 4);
#pragma unroll
        for (int pp = 0; pp < 2; ++pp) {
            const float* wp = Wsg + (size_t)(32 * (pb0 + pp) + r32) * 128 + 16 * kk + 8 * hi;
            const f32x4 wa = *(const f32x4*)wp * ra, wb = *(const f32x4*)(wp + 4) * rb;
            const bf16x8 b = __builtin_bit_cast(bf16x8, pack8(wa, wb));
            acc[pp] = __builtin_amdgcn_mfma_f32_32x32x16_bf16(a, b, acc[pp], 0, 0, 0);
        }
    }
#pragma unroll
    for (int pp = 0; pp < 2; ++pp) {
        const int p = 32 * (pb0 + pp) + r32, row = R0 + p; const float bs = bsg[p];
#pragma unroll
        for (int a4 = 0; a4 < 4; ++a4) {
            const int e0 = 32 * eblk + 8 * a4 + 4 * hi; const f32x4 gv = *(const f32x4*)(vng + e0);
            const u32x2 uu = *(const u32x2*)(ZA + (size_t)row * NZA + g * 128 + e0);
            const float o0 = bflo(uu.x) * (gv[0] * acc[pp][4 * a4] + bs), o1 = bfhi(uu.x) * (gv[1] * acc[pp][4 * a4 + 1] + bs),
                        o2 = bflo(uu.y) * (gv[2] * acc[pp][4 * a4 + 2] + bs), o3 = bfhi(uu.y) * (gv[3] * acc[pp][4 * a4 + 3] + bs);
            u32x2 w; w.x = cvtpk(o0, o1); w.y = cvtpk(o2, o3);
            *(u32x2*)(CAT + (size_t)row * DM + g * 128 + e0) = w;
        }
    }
    __syncthreads();
}

#define XB_TMO      128
#define XB_XCNT(j)  (256  + 64 * (j))
#define XB_XSUB(j)  (1280 + 64 * (j))
#define XB_XGEN(j)  (2304 + 64 * (j))
#define XB_TOP      3328
#define XB_TOPGEN   3392
#define XCD_BAR_WORDS 3456
#define XB_SPIN_CAP (1u << 18)

__device__ __forceinline__ unsigned xb_ld(unsigned* p)              { return __hip_atomic_load(p, __ATOMIC_RELAXED, __HIP_MEMORY_SCOPE_AGENT); }
__device__ __forceinline__ unsigned xb_add(unsigned* p, unsigned v) { return __hip_atomic_fetch_add(p, v, __ATOMIC_RELAXED, __HIP_MEMORY_SCOPE_AGENT); }
__device__ __forceinline__ unsigned xb_xcc_id() { return (unsigned)__builtin_amdgcn_s_getreg((3 << 11) | 20) & 0xFu; }
#define XB_SPIN(cond, bar) do { unsigned _sp = 0; while (cond) { __builtin_amdgcn_s_sleep(1); \
    if ((++_sp & 255u) == 0u) { if (xb_ld(&(bar)[XB_TMO])) break; if (_sp > XB_SPIN_CAP) { atomicAdd(&(bar)[XB_TMO], 1u); break; } } } } while (0)

struct XcdBarrier {
    unsigned* bar; unsigned x;
    volatile LAS unsigned* st;
};

__device__ __forceinline__ XcdBarrier xcd_barrier_post(unsigned* bar, volatile LAS unsigned* st) {
    XcdBarrier b; b.bar = bar; b.x = xb_xcc_id(); b.st = st;
    if (threadIdx.x == 0) (void)xb_add(&bar[XB_XCNT(b.x)], 1u);
    return b;
}
__device__ __forceinline__ void xcd_barrier_complete(unsigned* bar, unsigned x, unsigned& nloc, unsigned& nx) {
    const unsigned G = gridDim.x * gridDim.y * gridDim.z;
    unsigned sum, cnt, mine, sp = 0u;
    for (;;) {
        sum = 0u; cnt = 0u; mine = 0u;
#pragma unroll
        for (unsigned j = 0; j < 16; ++j) { const unsigned c = xb_ld(&bar[XB_XCNT(j)]); sum += c; cnt += (c > 0u) ? 1u : 0u; mine = (j == x) ? c : mine; }
        if (sum == G) break;
        __builtin_amdgcn_s_sleep(1);
        if ((++sp & 255u) == 0u) { if (xb_ld(&bar[XB_TMO])) break; if (sp > XB_SPIN_CAP) { atomicAdd(&bar[XB_TMO], 1u); break; } }
    }
    nloc = mine > 0u ? mine : 1u; nx = cnt > 0u ? cnt : 1u;
}

__device__ __forceinline__ void xcd_barrier(const XcdBarrier& b) {
    asm volatile("s_waitcnt vmcnt(0)" ::: "memory");
    __syncthreads();
    if (threadIdx.x == 0) {
        unsigned* bar = b.bar;
        __builtin_amdgcn_s_waitcnt(0);
        unsigned nloc = b.st[0], nx = b.st[1];
        if (nloc == 0u) { xcd_barrier_complete(bar, b.x, nloc, nx); b.st[0] = nloc; b.st[1] = nx; }
        const unsigned old = xb_add(&bar[XB_XSUB(b.x)], 1u);
        const unsigned gen = old / nloc;
        if (old + 1u == (gen + 1u) * nloc) {
            __builtin_amdgcn_fence(__ATOMIC_RELEASE, "agent");
            asm volatile("s_waitcnt vmcnt(0)" ::: "memory");
            const unsigned og = xb_add(&bar[XB_TOP], 1u);
            const unsigned tg = og / nx;
            if (og + 1u == (tg + 1u) * nx) xb_add(&bar[XB_TOPGEN], 1u);
            else XB_SPIN(xb_ld(&bar[XB_TOPGEN]) == tg, bar);
            __builtin_amdgcn_fence(__ATOMIC_ACQUIRE, "agent");
            xb_add(&bar[XB_XGEN(b.x)], 1u);
            asm volatile("s_waitcnt vmcnt(0)" ::: "memory");
        } else {
            XB_SPIN(xb_ld(&bar[XB_XGEN(b.x)]) == gen, bar);
            __builtin_amdgcn_fence(__ATOMIC_ACQUIRE, "agent");
            asm volatile("s_waitcnt vmcnt(0)" ::: "memory");
        }
    }
    __syncthreads();
}

#define GEMM_RUN(EPI, g, E) do { pg8::StaticOrder S_; S_.init((g).M, (g).N, G, (int)blockIdx.x); pg8::gemm_phase<EPI, pg8::StaticOrder, PG8_ALIGN, PG8_SP2>(lds, (g), S_, (E)); } while (0)
#define GRID_SYNC0() grid.sync()
#ifdef USE_CG_SYNC
#define GRID_SYNC() grid.sync()
#else
#define GRID_SYNC() xcd_barrier(bar)
#endif
#ifndef PHMASK
#define PHMASK 0xffff
#endif
#define PH(n) (((PHMASK) >> (n)) & 1)
#ifndef REP_P2
#define REP_P2 1
#endif
#ifndef REP_G
#define REP_G 1
#endif

__global__ void __launch_bounds__(512) mega_fwd(Params P) {
    extern __shared__ __attribute__((aligned(16))) unsigned char lds_raw[];
    LAS unsigned char* lds = (LAS unsigned char*)lds_raw;
    cg::grid_group grid = cg::this_grid();
    const int tid = threadIdx.x, lane = tid & 63, wave = __builtin_amdgcn_readfirstlane(tid >> 6);
    const int G = gridDim.x, bx = blockIdx.x;
    const int vcu = (G % 8 == 0) ? (bx % 8) * (G / 8) + bx / 8 : bx;
    unsigned char* ws = P.ws;
    const float* x_prompt = P.in[0]; const float* x_sample = P.in[1];
    float* sumsq = (float*)(ws + WS_SUMSQ);
    volatile LAS unsigned* MISC = (volatile LAS unsigned*)(lds + 131072 + 320);
    if (tid < 64) MISC[tid] = 0u;
    __syncthreads();
    XcdBarrier bar = xcd_barrier_post((unsigned*)(ws + WS_BAR), MISC + 8);
    bf16_t* WinT = (bf16_t*)(ws + WS_WIN); bf16_t* WoutT = (bf16_t*)(ws + WS_WOUT); bf16_t* W1T = (bf16_t*)(ws + WS_W1); bf16_t* W2T = (bf16_t*)(ws + WS_W2);
    bf16_t* CinT = (bf16_t*)(ws + WS_CIN); bf16_t* CoutT = (bf16_t*)(ws + WS_COUT); float* rope = (float*)(ws + WS_ROPE);
    bf16_t* ZT = (bf16_t*)(ws + WS_HB); bf16_t* HB = (bf16_t*)(ws + WS_HB);
    bf16_t* XN = (bf16_t*)(ws + WS_BIG); bf16_t* CAT = (bf16_t*)(ws + WS_BIG); bf16_t* HID = (bf16_t*)(ws + WS_BIG);
    bf16_t* TB = (bf16_t*)(ws + WS_BIG); bf16_t* UB = (bf16_t*)(ws + WS_BIG + 64 * MiB);
    bf16_t* ZA = (bf16_t*)P.out; float* H = P.out;

    if (PH(0)) {
        LAS float* scr = (LAS float*)(lds + wave * 16384);
        const int gw = vcu * 8 + wave, NGW = G * 8;
        constexpr int I_EIN = 16 * 80, I_EOUT = 16 * 32, I_W1 = 16 * 128, I_W2 = 64 * 32, I_CIN = 16 * 96, I_COUT = 16 * 32;
        constexpr int NITEMS = I_EIN + I_EOUT + 2 * I_W1 + 2 * I_W2 + I_CIN + I_COUT;
        for (int it = gw; it < NITEMS; it += NGW) {
            int r = it;
            if (r < I_EIN) { transpose_item<1>(P.in[6], DM, 2560, WinT, nullptr, scr, r, lane); continue; } r -= I_EIN;
            if (r < I_EOUT) { transpose_item<0>(P.in[7], DM, DM, WoutT, nullptr, scr, r, lane); continue; } r -= I_EOUT;
            if (r < I_W1) { transpose_item<0>(P.in[4], DM, DFF, W1T, P.in[3], scr, r, lane); continue; } r -= I_W1;
            if (r < I_W1) { transpose_item<0>(P.in[4] + (size_t)DM * DFF, DM, DFF, W1T + (size_t)DM * DFF, P.in[3] + DM, scr, r, lane); continue; } r -= I_W1;
            if (r < I_W2) { transpose_item<0>(P.in[5], DFF, DM, W2T, nullptr, scr, r, lane); continue; } r -= I_W2;
            if (r < I_W2) { transpose_item<0>(P.in[5] + (size_t)DM * DFF, DFF, DM, W2T + (size_t)DM * DFF, nullptr, scr, r, lane); continue; } r -= I_W2;
            if (r < I_CIN) { transpose_item<2>(P.in[16], DM, 3072, CinT, P.in[2] + DM, scr, r, lane); continue; } r -= I_CIN;
            transpose_item<0>(P.in[18], DM, DM, CoutT, nullptr, scr, r, lane);
        }
        for (int m = gw; m < NTOK; m += NGW) {
            const float* xr = (m < NPROMPT) ? x_prompt + (size_t)m * DM : x_sample + (size_t)(m - NPROMPT) * DM;
            rms_row_to_bf16(xr, P.in[2], XN + (size_t)m * DM, lane);
        }
        const int gt = vcu * 512 + tid, NGT = G * 512;
        for (int i = gt; i < 4 * NTOK; i += NGT) sumsq[i] = 0.f;
        for (int i = gt; i < 8192 * 8; i += NGT) {
            const int pos = i >> 3, fi = i & 7;
            const float inv = exp2f(-(float)fi * 0.125f * 18.931568569324174f);
            const float ang = (float)pos * inv;
            const double ad = (double)ang; const double kq = rint(ad * 0.15915494309189535); const float rr = (float)(ad - kq * 6.283185307179586);
            rope[pos * 16 + fi] = __cosf(rr); rope[pos * 16 + 8 + fi] = __sinf(rr);
        }
    }
    GRID_SYNC0();

    if (PH(1)) {
        pg8::Gemm ga{XN, WinT, NTOK, 1536, DM}; EpiA ea{ZA, rope};
        GEMM_RUN(EpiA, ga, ea);
        pg8::Gemm gb{WinT + (size_t)1536 * DM, XN, 1024, NTOK, DM}; EpiB eb{ZT};
        GEMM_RUN(EpiB, gb, eb);
    }
    GRID_SYNC();

    if (PH(2)) {
        float s1 = 0.f, s2 = 0.f;
        for (int i = 0; i < 64; ++i) { s1 += P.in[11][i] * P.in[12][i]; s2 += P.in[13][i] * P.in[14][i]; }
        const float lam = __expf(s1) - __expf(s2) + LAM_INIT;
        for (int rep_ = 0; rep_ < REP_P2; ++rep_)
        for (int k = vcu; k < 256; k += G) {
#pragma unroll 1
            for (int w = 0; w < 2; ++w) { const int idx = 2 * k + w, bh = idx >> 6, qb = idx & 63; attn_unit(lds, ZA, ZT, CAT, P.in[15], lam, NPROMPT + (bh >> 2) * 8192, 8192, bh & 3, qb); }
#pragma unroll 1
            for (int w = 0; w < 2; ++w) { const int idx = 2 * k + w, bh = idx >> 5, qb = idx & 31; attn_unit(lds, ZA, ZT, CAT, P.in[15], lam, (bh >> 2) * 4096, 4096, bh & 3, qb); }
        }
        for (int it = vcu; it < 1024; it += G) { const int ck = it >> 2, g = it & 3; gmlp_item(lds, ZA, ZT, CAT, P.in[9] + (size_t)g * 16384, P.in[8] + g * 128, P.in[10] + g * 128, ck, g); }
    }
    GRID_SYNC();

    if (PH(3)) {
        pg8::Gemm g{CAT, WoutT, NTOK, DM, DM}; EpiRes<0> e{x_prompt, x_sample - (size_t)NPROMPT * DM, H, HB, sumsq, 0};
        GEMM_RUN(EpiRes<0>, g, e);
    }
    GRID_SYNC();

#pragma unroll 1
    for (int hf = 0; hf < 2 && PH(4); ++hf) {
        if (PH(10)) { pg8::Gemm g{HB + (size_t)hf * 16384 * DM, W1T, 16384, DFF, DM}; EpiFfn1 e{HID, sumsq, hf * 16384}; GEMM_RUN(EpiFfn1, g, e); }
        GRID_SYNC();
        if (PH(11)) { pg8::Gemm g{HID, W2T, 16384, DM, DFF}; EpiRes<1> e{nullptr, nullptr, H, HB, sumsq + NTOK, hf * 16384}; GEMM_RUN(EpiRes<1>, g, e); }
        GRID_SYNC();
    }

    if (PH(5)) { pg8::Gemm g{HB, CinT, NTOK, 2048, DM}; EpiConvT e{TB, sumsq + NTOK}; GEMM_RUN(EpiConvT, g, e); }
    GRID_SYNC();
    if (PH(6)) { pg8::Gemm g{HB, CinT + (size_t)2048 * DM, NTOK, DM, DM}; EpiConvU e{UB, TB, sumsq + NTOK, P.in[17]}; GEMM_RUN(EpiConvU, g, e); }
    GRID_SYNC();
    if (PH(7)) { pg8::Gemm g{UB, CoutT, NTOK, DM, DM}; EpiRes<1> e{nullptr, nullptr, H, HB, sumsq + 2 * NTOK, 0}; GEMM_RUN(EpiRes<1>, g, e); }
    GRID_SYNC();

#pragma unroll 1
    for (int hf = 0; hf < 2 && PH(8); ++hf) {
        { pg8::Gemm g{HB + (size_t)hf * 16384 * DM, W1T + (size_t)DM * DFF, 16384, DFF, DM}; EpiFfn1 e{HID, sumsq + 2 * NTOK, hf * 16384}; GEMM_RUN(EpiFfn1, g, e); }
        GRID_SYNC();
        { pg8::Gemm g{HID, W2T + (size_t)DM * DFF, 16384, DM, DFF}; EpiRes<2> e{nullptr, nullptr, H, HB, sumsq + 3 * NTOK, hf * 16384}; GEMM_RUN(EpiRes<2>, g, e); }
        GRID_SYNC();
    }

    if (PH(9)) {
        const int gw = vcu * 8 + wave, NGW = G * 8; const float* fg = P.in[19];
        for (int m = gw; m < NTOK; m += NGW) {
            const float rs = 1.0f / sqrtf(sumsq[3 * NTOK + m] * (1.0f / DM) + EPS);
            f32x4* hr = (f32x4*)(H + (size_t)m * DM) + lane; const f32x4* gr = (const f32x4*)fg + lane;
#pragma unroll
            for (int jx = 0; jx < 4; ++jx) hr[64 * jx] = hr[64 * jx] * rs * gr[64 * jx];
        }
    }
}

extern "C" void kernel_launch(void* const* d_in, const int* in_sizes, int n_in, void* d_out, int out_size, void* d_ws, size_t ws_size, hipStream_t stream) {
    static int grid = 0;
    if (grid == 0) {
        if (n_in != 20 || out_size != NTOK * DM || ws_size < WS_END) { fprintf(stderr, "kernel_launch: unexpected shapes (n_in %d out %d ws %zu)\n", n_in, out_size, ws_size); grid = -1; return; }
        int dev = 0, cus = 0, per_cu = 0;
        hipGetDevice(&dev); hipDeviceGetAttribute(&cus, hipDeviceAttributeMultiprocessorCount, dev);
        if (hipFuncSetAttribute((const void*)mega_fwd, hipFuncAttributeMaxDynamicSharedMemorySize, LDS_BYTES) != hipSuccess) { fprintf(stderr, "kernel_launch: hipFuncSetAttribute failed\n"); grid = -1; return; }
        if (hipOccupancyMaxActiveBlocksPerMultiprocessor(&per_cu, (const void*)mega_fwd, 512, LDS_BYTES) != hipSuccess || per_cu < 1) { fprintf(stderr, "kernel_launch: occupancy query says %d\n", per_cu); per_cu = 1; }
        (void)hipGetLastError();
        grid = cus * per_cu;
    }
    if (grid < 0) return;
    if (hipMemsetAsync((char*)d_ws + WS_BAR, 0, BAR_BYTES, stream) != hipSuccess) { fprintf(stderr, "kernel_launch: memset failed\n"); return; }
    Params p{};
    for (int i = 0; i < 20; ++i) p.in[i] = (const float*)d_in[i];
    p.out = (float*)d_out; p.ws = (unsigned char*)d_ws;
    void* args[] = {&p};
    hipError_t e = hipLaunchCooperativeKernel((const void*)mega_fwd, dim3(grid), dim3(512), args, LDS_BYTES, stream);
    if (e != hipSuccess) fprintf(stderr, "kernel_launch: cooperative launch failed: %s (grid %d)\n", hipGetErrorString(e), grid);
}
```

```cpp
#include <hip/hip_runtime.h>
#include <hip/hip_cooperative_groups.h>
#include <cstdio>
#include <cstdint>
namespace cg = cooperative_groups;
namespace pg8 {
#define PG8_LAS __attribute__((address_space(3)))
typedef unsigned short bf16_t;
typedef short bf16x8 __attribute__((ext_vector_type(8)));
typedef float f32x4 __attribute__((ext_vector_type(4)));
typedef unsigned u32x4 __attribute__((ext_vector_type(4)));
constexpr int BM = 256, BK = 64, HALF = 128, HTB = HALF * BK * 2  , STAGE_BYTES = 8 * HTB, NXCD = 8, WGM = 8;

__host__ __device__ __forceinline__ int lds_byte(int r, int c) { const int st = (r >> 4) * 2 + (c >> 5), rr = r & 15, cc = c & 31, ob = rr * 64 + cc * 2; return st * 1024 + (ob ^ (((ob >> 9) & 1) << 5)); }
__host__ __device__ __forceinline__ void stage_rc(int b, int& R, int& C) { const int st = b / 1024, sb = b % 1024, swz = sb ^ (((sb >> 9) & 1) << 5); R = (st >> 1) * 16 + swz / 64; C = (st & 1) * 32 + (swz % 64) / 2; }
__host__ __device__ __forceinline__ int perm32(int rho) { const int n = rho >> 4, i = rho & 15; return 8 * (i >> 2) + 4 * n + (i & 3); }

struct Unit { int pm, pn; };
struct Gemm { const bf16_t* A; const bf16_t* Bt; int M, N, K; };

struct StaticOrder {
    int nM, nN, nwg, G, c;
    __host__ __device__ void init(int M, int N, int G_, int c_) { nM = M / BM; nN = N / BM; nwg = nM * nN; G = G_; c = c_; }
    __host__ __device__ bool next(int i, Unit& u) const {
        const long L = (long)i * G + c; if (L >= nwg) return false;
        int wgid = (int)L; { const int q = nwg / NXCD, r = nwg % NXCD, xcd = wgid % NXCD, off = wgid / NXCD; wgid = (xcd < r ? xcd * (q + 1) : r * (q + 1) + (xcd - r) * q) + off; }
        const int nig = WGM * nN, gid = wgid / nig, fm = gid * WGM, gsz = (nM - fm) < WGM ? (nM - fm) : WGM;
        u.pm = fm + ((wgid % nig) % gsz); u.pn = (wgid % nig) / gsz; return true;
    }
    __device__ __forceinline__ void a_ready(const Unit&) const {}
    __device__ __forceinline__ void done(const Unit&) const {}
};

__device__ __forceinline__ unsigned cvt_pk_bf16(float lo, float hi) { unsigned r; asm volatile("v_cvt_pk_bf16_f32 %0, %1, %2" : "=v"(r) : "v"(lo), "v"(hi)); return r; }
typedef float f32x2 __attribute__((ext_vector_type(2)));
__device__ __forceinline__ f32x2 gelu_pk(f32x2 v) {
    const f32x2 av = __builtin_elementwise_abs(v), d = av * 0.2316418882f + 1.0f;
    f32x2 t; t.x = __builtin_amdgcn_rcpf(d.x); t.y = __builtin_amdgcn_rcpf(d.y);
    f32x2 q = t * 0.5307027145f + (-0.7265760135f); q = q * t + 0.7107068705f; q = q * t + (-0.142248368f); q = q * t + 0.127414796f; q = q * t;
    const f32x2 s = (v * v) * (-0.72134752044f);
    f32x2 e; e.x = __builtin_amdgcn_exp2f(s.x); e.y = __builtin_amdgcn_exp2f(s.y);
    const f32x2 m = v * (q * e), r = v - m;
    f32x2 o; o.x = v.x < 0.f ? m.x : r.x; o.y = v.y < 0.f ? m.y : r.y; return o;
}

template <class Epi, class Sched, bool ALIGN_EPI = false, bool SP2 = false>
__device__ __forceinline__ void gemm_phase(PG8_LAS unsigned char* lds, const Gemm g, const Sched& S, const Epi& E) {
    int tid_ = threadIdx.x; asm volatile("" : "+v"(tid_));
    const int tid = tid_, wid = __builtin_amdgcn_readfirstlane(tid >> 6), lane = tid & 63, wr = wid >> 2, wc = wid & 3, fr = lane & 15, fq = lane >> 4;
    const int K = g.K, nt = K / BK;
    unsigned voffA[2], voffB[2];
#pragma unroll
    for (int i = 0; i < 2; ++i) { int R, C; stage_rc(tid * 16 + i * 8192, R, C); const int Rb = Epi::PERM ? ((R & ~31) + perm32(R & 31)) : R;
        voffA[i] = (unsigned)(R * K + C) * 2u; voffB[i] = (unsigned)(Rb * K + C) * 2u; }
    const size_t kstep = (size_t)(BK * 2);
    const size_t hstep = (size_t)HALF * K * 2;
    const size_t tstep = 2 * hstep;
    const unsigned ldsw = (unsigned)wid * 1024u;
    const int aoff = lds_byte(wr * 64 + fr, fq * 8), boff = lds_byte(wc * 32 + fr, fq * 8);
#define PG8_SA(b, h) (((b) * 2 + (h)) * HTB)
#define PG8_SB(b, h) ((4 + (b) * 2 + (h)) * HTB)
#define PG8_STAGE(bufoff, gbase, voff) do { _Pragma("unroll") for (int _i = 0; _i < 2; ++_i) \
        __builtin_amdgcn_global_load_lds((const unsigned*)((const char*)(gbase) + (voff)[_i]), (PG8_LAS unsigned*)(lds + (bufoff) + ldsw + _i * 8192), 16, 0, 0); } while (0)
#define PG8_LDA(dst, b, h) do { _Pragma("unroll") for (int m = 0; m < 4; ++m) _Pragma("unroll") for (int k = 0; k < 2; ++k) dst[m][k] = *(const PG8_LAS bf16x8*)(lds + PG8_SA(b, h) + aoff + m * 2048 + k * 1024); } while (0)
#define PG8_LDB(dst, b, h) do { _Pragma("unroll") for (int n = 0; n < 2; ++n) _Pragma("unroll") for (int k = 0; k < 2; ++k) dst[n][k] = *(const PG8_LAS bf16x8*)(lds + PG8_SB(b, h) + boff + n * 2048 + k * 1024); } while (0)
#define PG8_MMA(ai, bj, At, Bt) do { __builtin_amdgcn_s_setprio(1); _Pragma("unroll") for (int m = 0; m < 4; ++m) _Pragma("unroll") for (int n = 0; n < 2; ++n) _Pragma("unroll") for (int k = 0; k < 2; ++k) \
        acc[ai][bj][m][n] = __builtin_amdgcn_mfma_f32_16x16x32_bf16(Bt[n][k], At[m][k], acc[ai][bj][m][n], 0, 0, 0); __builtin_amdgcn_s_setprio(0); } while (0)
#define PG8_WAIT_V(n) asm volatile("s_waitcnt vmcnt(" #n ")" ::: "memory")
#define PG8_WAIT_L(n) asm volatile("s_waitcnt lgkmcnt(" #n ")" ::: "memory")
#define PG8_BAR __builtin_amdgcn_s_barrier()
#define PG8_SCHED __builtin_amdgcn_sched_barrier(0)
    Unit cur, nxt; int ui = 0;
    if (!S.next(0, cur)) return;
    f32x4 acc[2][2][4][2];
#pragma unroll
    for (int a = 0; a < 2; ++a)
#pragma unroll
        for (int b = 0; b < 2; ++b)
#pragma unroll
            for (int m = 0; m < 4; ++m)
#pragma unroll
                for (int n = 0; n < 2; ++n) acc[a][b][m][n] = (f32x4){0.f, 0.f, 0.f, 0.f};
    bf16x8 At[4][2], B0[2][2], B1[2][2];
    const char* cA = (const char*)g.A + (size_t)cur.pm * tstep; const char* cB = (const char*)g.Bt + (size_t)cur.pn * tstep;
    S.a_ready(cur);
    if constexpr (SP2) {
        PG8_STAGE(PG8_SB(0, 0), cB, voffB); PG8_STAGE(PG8_SB(0, 1), cB + hstep, voffB); PG8_STAGE(PG8_SA(0, 0), cA, voffA); PG8_STAGE(PG8_SA(0, 1), cA + hstep, voffA);
        if (wr == 1) PG8_BAR;
        PG8_WAIT_V(2); PG8_BAR;
        PG8_STAGE(PG8_SB(1, 0), cB + kstep, voffB); PG8_STAGE(PG8_SA(1, 0), cA + kstep, voffA); PG8_STAGE(PG8_SB(1, 1), cB + hstep + kstep, voffB);
        PG8_WAIT_V(6); PG8_BAR;
    } else {
        PG8_STAGE(PG8_SB(0, 0), cB, voffB); PG8_STAGE(PG8_SA(0, 0), cA, voffA); PG8_STAGE(PG8_SB(0, 1), cB + hstep, voffB); PG8_STAGE(PG8_SA(0, 1), cA + hstep, voffA);
        if (wr == 1) PG8_BAR;
        PG8_WAIT_V(4); PG8_BAR;
        PG8_STAGE(PG8_SB(1, 0), cB + kstep, voffB); PG8_STAGE(PG8_SA(1, 0), cA + kstep, voffA); PG8_STAGE(PG8_SB(1, 1), cB + hstep + kstep, voffB);
        PG8_WAIT_V(6); PG8_BAR;
    }
    for (;;) {
        const bool has_next = S.next(ui + 1, nxt);
        const char* nA = has_next ? (const char*)g.A + (size_t)nxt.pm * tstep : cA; const char* nB = has_next ? (const char*)g.Bt + (size_t)nxt.pn * tstep : cB;
        for (int t = 0; t < nt; t += 2) {
            const bool last = (t == nt - 2);
            const char* a1 = cA + (size_t)(t + 1) * kstep;
            const char* a2 = last ? nA : cA + (size_t)(t + 2) * kstep; const char* b2 = last ? nB : cB + (size_t)(t + 2) * kstep;
            const char* a3 = a2 + kstep; const char* b3 = b2 + kstep;
            if (last && has_next) S.a_ready(nxt);
            if constexpr (SP2) {
            PG8_LDB(B0, 0, 0); PG8_LDB(B1, 0, 1); PG8_SCHED; PG8_LDA(At, 0, 0); PG8_STAGE(PG8_SA(1, 1), a1 + hstep, voffA);
            PG8_WAIT_V(8); PG8_WAIT_L(0); PG8_BAR; PG8_MMA(0, 0, At, B0); PG8_MMA(0, 1, At, B1); PG8_BAR; PG8_SCHED;
            PG8_LDA(At, 0, 1); PG8_STAGE(PG8_SB(0, 0), b2, voffB); PG8_STAGE(PG8_SB(0, 1), b2 + hstep, voffB); PG8_STAGE(PG8_SA(0, 0), a2, voffA);
            PG8_WAIT_V(8); PG8_WAIT_L(0); PG8_BAR; PG8_MMA(1, 0, At, B0); PG8_MMA(1, 1, At, B1); PG8_BAR; PG8_SCHED;
            PG8_LDB(B0, 1, 0); PG8_LDB(B1, 1, 1); PG8_SCHED; PG8_LDA(At, 1, 0); PG8_STAGE(PG8_SA(0, 1), a2 + hstep, voffA);
            PG8_WAIT_V(8); PG8_WAIT_L(0); PG8_BAR; PG8_MMA(0, 0, At, B0); PG8_MMA(0, 1, At, B1); PG8_BAR; PG8_SCHED;
            PG8_LDA(At, 1, 1); PG8_STAGE(PG8_SB(1, 0), b3, voffB); PG8_STAGE(PG8_SB(1, 1), b3 + hstep, voffB); PG8_STAGE(PG8_SA(1, 0), a3, voffA);
            PG8_WAIT_V(8); PG8_WAIT_L(0); PG8_BAR; PG8_MMA(1, 0, At, B0); PG8_MMA(1, 1, At, B1); PG8_BAR; PG8_SCHED;
            } else {
            PG8_LDB(B0, 0, 0); PG8_SCHED; PG8_LDA(At, 0, 0); PG8_STAGE(PG8_SA(1, 1), a1 + hstep, voffA);
            PG8_WAIT_L(8); PG8_BAR; PG8_WAIT_L(0); PG8_MMA(0, 0, At, B0); PG8_BAR; PG8_SCHED;
            PG8_LDB(B1, 0, 1); PG8_STAGE(PG8_SB(0, 0), b2, voffB);
            PG8_BAR; PG8_WAIT_L(0); PG8_MMA(0, 1, At, B1); PG8_BAR;
            PG8_LDA(At, 0, 1); PG8_STAGE(PG8_SA(0, 0), a2, voffA);
            PG8_BAR; PG8_WAIT_L(0); PG8_MMA(1, 0, At, B0); PG8_BAR; PG8_SCHED;
            PG8_STAGE(PG8_SB(0, 1), b2 + hstep, voffB);
            PG8_WAIT_V(6); PG8_BAR; PG8_MMA(1, 1, At, B1); PG8_BAR;
            PG8_LDB(B0, 1, 0); PG8_SCHED; PG8_LDA(At, 1, 0); PG8_STAGE(PG8_SA(0, 1), a2 + hstep, voffA);
            PG8_WAIT_L(8); PG8_BAR; PG8_WAIT_L(0); PG8_MMA(0, 0, At, B0); PG8_BAR; PG8_SCHED;
            PG8_LDB(B1, 1, 1); PG8_STAGE(PG8_SB(1, 0), b3, voffB);
            PG8_BAR; PG8_WAIT_L(0); PG8_MMA(0, 1, At, B1); PG8_BAR;
            PG8_LDA(At, 1, 1); PG8_STAGE(PG8_SA(1, 0), a3, voffA);
            PG8_BAR; PG8_WAIT_L(0); PG8_MMA(1, 0, At, B0); PG8_BAR; PG8_SCHED;
            PG8_STAGE(PG8_SB(1, 1), b3 + hstep, voffB);
            PG8_WAIT_V(6); PG8_BAR; PG8_MMA(1, 1, At, B1); PG8_BAR;
            }
        }
        if constexpr (ALIGN_EPI) { if (wr == 0) PG8_BAR; }
        if constexpr (!Epi::AFTER_DRAIN) { E(acc, cur, wr, wc, fr, fq); S.done(cur); }
        if (!has_next) break;
#pragma unroll
        for (int a = 0; a < 2; ++a)
#pragma unroll
            for (int b = 0; b < 2; ++b)
#pragma unroll
                for (int m = 0; m < 4; ++m)
#pragma unroll
                    for (int n = 0; n < 2; ++n) acc[a][b][m][n] = (f32x4){0.f, 0.f, 0.f, 0.f};
        cur = nxt; cA = nA; cB = nB; ++ui;
        if constexpr (ALIGN_EPI) { if (wr == 1) PG8_BAR; }
    }
    PG8_WAIT_V(0);
    if constexpr (!ALIGN_EPI) { if (wr == 0) PG8_BAR; }
    PG8_BAR;
    if constexpr (Epi::AFTER_DRAIN) { E.fused(acc, cur, wr, wc, fr, fq, lds, wid, lane); S.done(cur); }
#undef PG8_SA
#undef PG8_SB
#undef PG8_STAGE
#undef PG8_LDA
#undef PG8_LDB
#undef PG8_MMA
#undef PG8_WAIT_V
#undef PG8_WAIT_L
#undef PG8_BAR
#undef PG8_SCHED
}
}

#ifndef PG8_SP2
#define PG8_SP2 true
#endif
#ifndef PG8_ALIGN
#define PG8_ALIGN true
#endif
#define LAS __attribute__((address_space(3)))
typedef unsigned short bf16_t;
typedef short bf16x8 __attribute__((ext_vector_type(8)));
typedef float f32x4 __attribute__((ext_vector_type(4)));
typedef float f32x16 __attribute__((ext_vector_type(16)));
typedef unsigned u32x4 __attribute__((ext_vector_type(4)));
typedef unsigned u32x2 __attribute__((ext_vector_type(2)));
using pg8::Unit;

constexpr int NTOK = 32768, NPROMPT = 16384, DM = 1024, DFF = 4096;
constexpr int NZA = 1536;
constexpr float EPS = 1e-5f;
constexpr float C2 = 0.125f * 1.4426950408889634f;
constexpr float LAM_INIT = 0.2f;
constexpr size_t MiB = 1u << 20;
constexpr size_t WS_SUMSQ = 0;
constexpr size_t WS_BAR = 512 * 1024, BAR_BYTES = 16384;
constexpr size_t WS_WIN = 1 * MiB, WS_WOUT = 6 * MiB, WS_W1 = 8 * MiB, WS_W2 = 24 * MiB, WS_CIN = 40 * MiB, WS_COUT = 46 * MiB, WS_ROPE = 48 * MiB;
constexpr size_t WS_HB = 49 * MiB;
constexpr size_t WS_BIG = 113 * MiB;
constexpr size_t WS_END = 241 * MiB;
constexpr int LDS_BYTES = 147456;

struct Params { const float* in[20]; float* out; unsigned char* ws; };

typedef float f32x2_t __attribute__((ext_vector_type(2))); typedef __bf16 bf16x2_t __attribute__((ext_vector_type(2)));
__device__ __forceinline__ unsigned cvtpk(float lo, float hi) { f32x2_t v = {lo, hi}; bf16x2_t b = __builtin_convertvector(v, bf16x2_t); return __builtin_bit_cast(unsigned, b); }
__device__ __forceinline__ u32x4 pack8(f32x4 a, f32x4 b) { u32x4 w; w.x = cvtpk(a[0], a[1]); w.y = cvtpk(a[2], a[3]); w.z = cvtpk(b[0], b[1]); w.w = cvtpk(b[2], b[3]); return w; }
__device__ __forceinline__ float bflo(unsigned x) { return __uint_as_float(x << 16); }
__device__ __forceinline__ float bfhi(unsigned x) { return __uint_as_float(x & 0xffff0000u); }
__device__ __forceinline__ void unpack8(u32x4 w, f32x4& a, f32x4& b) { a = (f32x4){bflo(w.x), bfhi(w.x), bflo(w.y), bfhi(w.y)}; b = (f32x4){bflo(w.z), bfhi(w.z), bflo(w.w), bfhi(w.w)}; }
__device__ __forceinline__ float gelu_tanh(float x) { const float t = x * (1.0f + 0.044715f * x * x); const float e = __builtin_amdgcn_exp2f(-2.302208198f * t); return x * __builtin_amdgcn_rcpf(1.0f + e); }
__device__ __forceinline__ f32x4 gelu4(f32x4 v) { return (f32x4){gelu_tanh(v[0]), gelu_tanh(v[1]), gelu_tanh(v[2]), gelu_tanh(v[3])}; }
__device__ __forceinline__ float wave_sum(float v) {
#pragma unroll
    for (int o = 1; o < 64; o <<= 1) v += __shfl_xor(v, o);
    return v;
}
__device__ __forceinline__ int seqpos(int row) { return row < NPROMPT ? (row & 4095) : (row & 8191); }

struct EpiA {
    static constexpr bool PERM = true, AFTER_DRAIN = false;
    bf16_t* ZA; const float* rope;
    __device__ __forceinline__ void operator()(const f32x4 (&acc)[2][2][4][2], const Unit& u, int wr, int wc, int fr, int fq) const {
        const int row0 = u.pm * 256 + wr * 64 + fr, kind = u.pn >> 1, col0 = u.pn * 256 + wc * 32 + 8 * fq;
        const bool ropew = (kind != 0) && ((wc & 1) == 0);
        const float sgn = (fq == 0) ? -1.f : 1.f, sc = (kind == 1) ? C2 : 1.f;
#pragma unroll
        for (int ai = 0; ai < 2; ++ai)
#pragma unroll
            for (int m = 0; m < 4; ++m) {
                const int row = row0 + ai * 128 + m * 16;
                f32x4 c0 = {1.f, 1.f, 1.f, 1.f}, c1 = c0, s0 = {0.f, 0.f, 0.f, 0.f}, s1 = s0;
                if (ropew) { const float* rp = rope + seqpos(row) * 16; c0 = *(const f32x4*)rp; c1 = *(const f32x4*)(rp + 4); s0 = *(const f32x4*)(rp + 8); s1 = *(const f32x4*)(rp + 12); }
                bf16_t* op = ZA + (size_t)row * NZA + col0;
#pragma unroll
                for (int bj = 0; bj < 2; ++bj) {
                    f32x4 v0 = acc[ai][bj][m][0], v1 = acc[ai][bj][m][1];
                    if (kind == 0) { v0 = gelu4(v0); v1 = gelu4(v1); }
                    else {
                        if (ropew) {
                            f32x4 p0, p1;
#pragma unroll
                            for (int e = 0; e < 4; ++e) { p0[e] = __shfl_xor(v0[e], 16); p1[e] = __shfl_xor(v1[e], 16); }
                            if (fq < 2) { v0 = v0 * c0 + (p0 * s0) * sgn; v1 = v1 * c1 + (p1 * s1) * sgn; }
                        }
                        v0 = v0 * sc; v1 = v1 * sc;
                    }
                    *(u32x4*)(op + bj * 128) = pack8(v0, v1);
                }
                asm volatile("" ::: "memory");
            }
    }
};
struct EpiB {
    static constexpr bool PERM = true, AFTER_DRAIN = false;
    bf16_t* ZT;
    __device__ __forceinline__ void operator()(const f32x4 (&acc)[2][2][4][2], const Unit& u, int wr, int wc, int fr, int fq) const {
        const int row0 = u.pm * 256 + wr * 64 + fr, col0 = u.pn * 256 + wc * 32 + 8 * fq; const bool act = u.pm < 2;
#pragma unroll
        for (int ai = 0; ai < 2; ++ai)
#pragma unroll
            for (int m = 0; m < 4; ++m) {
                bf16_t* op = ZT + (size_t)(row0 + ai * 128 + m * 16) * NTOK + col0;
#pragma unroll
                for (int bj = 0; bj < 2; ++bj) {
                    f32x4 v0 = acc[ai][bj][m][0], v1 = acc[ai][bj][m][1];
                    if (act) { v0 = gelu4(v0); v1 = gelu4(v1); }
                    *(u32x4*)(op + bj * 128) = pack8(v0, v1);
                }
            }
    }
};
template <int MODE> struct EpiRes {
    static constexpr bool PERM = true, AFTER_DRAIN = false;
    const float* res0; const float* res1; float* H; bf16_t* HB; float* sumsq; int rowbase;
    __device__ __forceinline__ void operator()(const f32x4 (&acc)[2][2][4][2], const Unit& u, int wr, int wc, int fr, int fq) const {
        const int row0 = rowbase + u.pm * 256 + wr * 64 + fr, col0 = u.pn * 256 + wc * 32 + 8 * fq;
#pragma unroll
        for (int ai = 0; ai < 2; ++ai)
#pragma unroll
            for (int m = 0; m < 4; ++m) {
                const int row = row0 + ai * 128 + m * 16;
                const size_t off = (size_t)row * DM + col0; float ss = 0.f;
#pragma unroll
                for (int bj = 0; bj < 2; ++bj) {
                    f32x4 r0, r1;
                    if (MODE == 0) { const float* rp = (row < NPROMPT ? res0 : res1) + off + bj * 128; r0 = *(const f32x4*)rp; r1 = *(const f32x4*)(rp + 4); }
                    else unpack8(*(const u32x4*)(HB + off + bj * 128), r0, r1);
                    const f32x4 v0 = acc[ai][bj][m][0] + r0, v1 = acc[ai][bj][m][1] + r1;
                    if (MODE == 2) { *(f32x4*)(H + off + bj * 128) = v0; *(f32x4*)(H + off + bj * 128 + 4) = v1; }
                    else *(u32x4*)(HB + off + bj * 128) = pack8(v0, v1);
                    ss += (v0[0] * v0[0] + v0[1] * v0[1]) + (v0[2] * v0[2] + v0[3] * v0[3]) + (v1[0] * v1[0] + v1[1] * v1[1]) + (v1[2] * v1[2] + v1[3] * v1[3]);
                }
                ss += __shfl_xor(ss, 16); ss += __shfl_xor(ss, 32);
                if (fq == 0) __hip_atomic_fetch_add(sumsq + row, ss, __ATOMIC_RELAXED, __HIP_MEMORY_SCOPE_AGENT);
                asm volatile("" ::: "memory");
            }
    }
};
struct EpiFfn1 {
    static constexpr bool PERM = true, AFTER_DRAIN = false;
    bf16_t* HID; const float* sumsq; int rowbase;
    __device__ __forceinline__ void operator()(const f32x4 (&acc)[2][2][4][2], const Unit& u, int wr, int wc, int fr, int fq) const {
        const int lrow0 = u.pm * 256 + wr * 64 + fr, col0 = u.pn * 256 + wc * 32 + 8 * fq;
#pragma unroll
        for (int ai = 0; ai < 2; ++ai)
#pragma unroll
            for (int m = 0; m < 4; ++m) {
                const int lrow = lrow0 + ai * 128 + m * 16;
                const float rs = __builtin_amdgcn_rsqf(sumsq[rowbase + lrow] * (1.0f / DM) + EPS);
                bf16_t* op = HID + (size_t)lrow * DFF + col0;
#pragma unroll
                for (int bj = 0; bj < 2; ++bj) {
                    f32x4 v0 = acc[ai][bj][m][0] * rs, v1 = acc[ai][bj][m][1] * rs;
#pragma unroll
                    for (int e = 0; e < 4; ++e) { const float a = fmaxf(v0[e], 0.f), b = fmaxf(v1[e], 0.f); v0[e] = a * a; v1[e] = b * b; }
                    *(u32x4*)(op + bj * 128) = pack8(v0, v1);
                }
                asm volatile("" ::: "memory");
            }
    }
};
struct EpiConvT {
    static constexpr bool PERM = true, AFTER_DRAIN = false;
    bf16_t* T; const float* sumsq;
    __device__ __forceinline__ void operator()(const f32x4 (&acc)[2][2][4][2], const Unit& u, int wr, int wc, int fr, int fq) const {
        const int row0 = u.pm * 256 + wr * 64 + fr, ch0 = u.pn * 128 + wc * 32 + 8 * fq;
#pragma unroll
        for (int ai = 0; ai < 2; ++ai)
#pragma unroll
            for (int m = 0; m < 4; ++m) {
                const int row = row0 + ai * 128 + m * 16;
                const float rs = __builtin_amdgcn_rsqf(sumsq[row] * (1.0f / DM) + EPS), rs2 = rs * rs;
                const f32x4 v0 = acc[ai][0][m][0] * acc[ai][1][m][0] * rs2, v1 = acc[ai][0][m][1] * acc[ai][1][m][1] * rs2;
                *(u32x4*)(T + (size_t)row * DM + ch0) = pack8(v0, v1);
                asm volatile("" ::: "memory");
            }
    }
};
struct EpiConvU {
    static constexpr bool PERM = true, AFTER_DRAIN = false;
    bf16_t* U; const bf16_t* T; const float* sumsq; const float* cw;
    __device__ __forceinline__ void operator()(const f32x4 (&acc)[2][2][4][2], const Unit& u, int wr, int wc, int fr, int fq) const {
        const int row0 = u.pm * 256 + wr * 64 + fr;
#pragma unroll
        for (int bj = 0; bj < 2; ++bj) {
            const int ch0 = u.pn * 256 + bj * 128 + wc * 32 + 8 * fq;
            const f32x4 w0a = *(const f32x4*)(cw + ch0), w0b = *(const f32x4*)(cw + ch0 + 4), w1a = *(const f32x4*)(cw + DM + ch0), w1b = *(const f32x4*)(cw + DM + ch0 + 4),
                        w2a = *(const f32x4*)(cw + 2 * DM + ch0), w2b = *(const f32x4*)(cw + 2 * DM + ch0 + 4);
#pragma unroll
            for (int ai = 0; ai < 2; ++ai)
#pragma unroll
                for (int m = 0; m < 4; ++m) {
                    const int row = row0 + ai * 128 + m * 16, pos = seqpos(row), slen = row < NPROMPT ? 4096 : 8192;
                    const float rs = __builtin_amdgcn_rsqf(sumsq[row] * (1.0f / DM) + EPS);
                    const bf16_t* tp = T + (size_t)row * DM + ch0;
                    const u32x4 z = {0u, 0u, 0u, 0u};
                    const u32x4 tc = *(const u32x4*)tp;
                    const u32x4 tl = (pos > 0) ? *(const u32x4*)(tp - DM) : z;
                    const u32x4 tn = (pos < slen - 1) ? *(const u32x4*)(tp + DM) : z;
                    f32x4 ca, cb, la, lb, na, nb; unpack8(tc, ca, cb); unpack8(tl, la, lb); unpack8(tn, na, nb);
                    const f32x4 ya = w0a * la + w1a * ca + w2a * na, yb = w0b * lb + w1b * cb + w2b * nb;
                    const f32x4 v0 = acc[ai][bj][m][0] * rs * ya, v1 = acc[ai][bj][m][1] * rs * yb;
                    *(u32x4*)(U + (size_t)row * DM + ch0) = pack8(v0, v1);
                    asm volatile("" ::: "memory");
                }
        }
    }
};

template <int MAP> __device__ __forceinline__ int orow_map(int n) {
    if (MAP == 1) { const int b = n >> 9; const int ob = (b == 0) ? 0 : (b == 1) ? 3 : (b == 2) ? 1 : (b == 3) ? 2 : 4; return ob * 512 + (n & 511); }
    if (MAP == 2) { if (n < 1024) return 2048 + n; const int hs = (n >= 2048) ? 1 : 0; const int ch = n - 1024 - hs * 1024; return (ch >> 7) * 256 + hs * 128 + (ch & 127); }
    return n;
}
template <int MAP> __device__ __forceinline__ void transpose_item(const float* W, int K, int N, bf16_t* WT, const float* gk, LAS float* scr, int item, int lane) {
    const int nblk = N / 32, kb = item / nblk, nb = item % nblk, k0 = 64 * kb, n0 = 32 * nb;
#pragma unroll 8
    for (int i = 0; i < 32; ++i) { const int kk = 2 * i + (lane >> 5); float v = W[(size_t)(k0 + kk) * N + n0 + (lane & 31)]; if (gk) v *= gk[k0 + kk]; scr[kk * 33 + (lane & 31)] = v; }
    asm volatile("s_waitcnt lgkmcnt(0)" ::: "memory");
    const int c = lane & 7; const int or0 = orow_map<MAP>(n0);
#pragma unroll
    for (int j = 0; j < 4; ++j) { const int n = (lane >> 3) + 8 * j; const LAS float* s = scr + (8 * c) * 33 + n;
        u32x4 o; o.x = cvtpk(s[0 * 33], s[1 * 33]); o.y = cvtpk(s[2 * 33], s[3 * 33]); o.z = cvtpk(s[4 * 33], s[5 * 33]); o.w = cvtpk(s[6 * 33], s[7 * 33]);
        *(u32x4*)(WT + (size_t)(or0 + n) * K + k0 + 8 * c) = o; }
    asm volatile("s_waitcnt lgkmcnt(0)" ::: "memory");
}
__device__ __forceinline__ void rms_row_to_bf16(const float* xrow, const float* g, bf16_t* orow, int lane) {
    const f32x4* xr = (const f32x4*)xrow + lane; const f32x4* gr = (const f32x4*)g + lane;
    f32x4 v[4]; float s = 0.f;
#pragma unroll
    for (int j = 0; j < 4; ++j) { v[j] = xr[64 * j]; s += (v[j][0] * v[j][0] + v[j][1] * v[j][1]) + (v[j][2] * v[j][2] + v[j][3] * v[j][3]); }
    const float rstd = 1.0f / sqrtf(wave_sum(s) * (1.0f / DM) + EPS);
    u32x2* o8 = (u32x2*)orow + lane;
#pragma unroll
    for (int j = 0; j < 4; ++j) { const f32x4 gg = gr[64 * j]; const f32x4 y = v[j] * rstd * gg; u32x2 w; w.x = cvtpk(y[0], y[1]); w.y = cvtpk(y[2], y[3]); o8[64 * j] = w; }
}

__device__ __forceinline__ int swap23(int x) { return (x & ~12) | ((x & 4) << 1) | ((x & 8) >> 1); }
__device__ __forceinline__ float half_swap_max(float v) { auto rr = __builtin_amdgcn_permlane32_swap(__float_as_uint(v), __float_as_uint(v), false, false); return fmaxf(__uint_as_float(rr[0]), __uint_as_float(rr[1])); }
__device__ __forceinline__ float half_swap_sum(float v) { auto rr = __builtin_amdgcn_permlane32_swap(__float_as_uint(v), __float_as_uint(v), false, false); return __uint_as_float(rr[0]) + __uint_as_float(rr[1]); }

#define SBAR() __builtin_amdgcn_sched_barrier(0)
#define MFMA32(a, b, c) __builtin_amdgcn_mfma_f32_32x32x16_bf16((a), (b), (c), 0, 0, 0)
__device__ __forceinline__ float max3f(float a, float b, float c) { float r; asm("v_max3_f32 %0, %1, %2, %3" : "=v"(r) : "v"(a), "v"(b), "v"(c)); return r; }
__device__ __forceinline__ void att_step(LAS unsigned char* lds, const int t, const int NT, const int j, const int r32, const int hi, const int swz,
                                         const bf16x8 (&qr)[4], f32x16 (&o)[4], f32x16& C0, f32x16& C1, f32x16& N0, f32x16& N1, float& mrun, float& lsum,
                                         const bf16_t* const (&ksrc)[2], const bf16_t* const (&vsrc)[2], const int (&kdst)[2], const int (&vdst)[2]) {
    const int cur = (t & 1) * 32768, nxt = 32768 - cur;
    const bool more = (t + 1 < NT), more2 = (t + 2 < NT);
    u32x4 sk[2], sv[2];
    if (more2) {
#pragma unroll
        for (int i = 0; i < 2; ++i) sk[i] = *(const u32x4*)(ksrc[i] + (size_t)(t + 2) * 64 * NZA);
    }
    if (more) {
#pragma unroll
        for (int i = 0; i < 2; ++i) sv[i] = *(const u32x4*)(vsrc[i] + (t + 1) * 64);
    }
    const LAS unsigned char* kb = lds + nxt + j * 8192 + r32 * 128;
    const LAS unsigned char* vb = lds + cur + 16384 + r32 * 128;
#define KOFF(d0) ((((2 * (d0) + hi) ^ swz)) * 16)
#define VLD(b, jj) (*(const LAS bf16x8*)(vb + (b) * 4096 + ((((2 * (jj) + hi) ^ swz)) * 16)))
    bf16x8 ka[4][2];
#pragma unroll
    for (int d0 = 0; d0 < 4; ++d0) { ka[d0][0] = *(const LAS bf16x8*)(kb + KOFF(d0)); ka[d0][1] = *(const LAS bf16x8*)(kb + 4096 + KOFF(d0)); }
    f32x16 z;
#pragma unroll
    for (int r = 0; r < 16; ++r) z[r] = 0.f;
    SBAR();
    float ma, mb;
    N0 = MFMA32(ka[0][0], qr[0], z);
    ma = max3f(C0[0], C0[1], C0[2]); mb = max3f(C0[3], C0[4], C0[5]); ma = max3f(ma, C0[6], C0[7]); mb = max3f(mb, C0[8], C0[9]); SBAR();
    N1 = MFMA32(ka[0][1], qr[0], z);
    ma = max3f(ma, C0[10], C0[11]); mb = max3f(mb, C0[12], C0[13]); ma = max3f(ma, C0[14], C0[15]); mb = max3f(mb, C1[0], C1[1]); SBAR();
    N0 = MFMA32(ka[1][0], qr[1], N0);
    ma = max3f(ma, C1[2], C1[3]); mb = max3f(mb, C1[4], C1[5]); ma = max3f(ma, C1[6], C1[7]); mb = max3f(mb, C1[8], C1[9]); SBAR();
    N1 = MFMA32(ka[1][1], qr[1], N1);
    ma = max3f(ma, C1[10], C1[11]); mb = max3f(mb, C1[12], C1[13]); ma = max3f(ma, C1[14], C1[15]); SBAR();
    float rm = fmaxf(ma, mb);
    rm = half_swap_max(rm);
    if (__any(rm > mrun)) {
        const float mnew = fmaxf(mrun, rm), alpha = __builtin_amdgcn_exp2f(mrun - mnew);
        lsum *= alpha;
#pragma unroll
        for (int b = 0; b < 4; ++b)
#pragma unroll
            for (int r = 0; r < 16; ++r) o[b][r] *= alpha;
        mrun = mnew;
    }
    const float mr = mrun;
    float s0 = 0.f, s1 = 0.f;
    u32x4 pw[4];
    bf16x8 va[4], vn[4];
#define VQ(P, base, g, i) do { const float e0_ = __builtin_amdgcn_exp2f(P[(base) + 2 * (i)] - mr), e1_ = __builtin_amdgcn_exp2f(P[(base) + 2 * (i) + 1] - mr); s0 += e0_; s1 += e1_; pw[g][i] = cvtpk(e0_, e1_); } while (0)
    SBAR();
#pragma unroll
    for (int b = 0; b < 4; ++b) va[b] = VLD(b, 0);
    N0 = MFMA32(ka[2][0], qr[2], N0); VQ(C0, 0, 0, 0); SBAR();
    N1 = MFMA32(ka[2][1], qr[2], N1); VQ(C0, 0, 0, 1); SBAR();
    N0 = MFMA32(ka[3][0], qr[3], N0); VQ(C0, 0, 0, 2); SBAR();
    N1 = MFMA32(ka[3][1], qr[3], N1); VQ(C0, 0, 0, 3); SBAR();
#pragma unroll
    for (int b = 0; b < 4; ++b) vn[b] = VLD(b, 1);
    { const bf16x8 pb = __builtin_bit_cast(bf16x8, pw[0]);
      o[0] = MFMA32(va[0], pb, o[0]); VQ(C0, 8, 1, 0); SBAR();
      o[1] = MFMA32(va[1], pb, o[1]); VQ(C0, 8, 1, 1); SBAR();
      o[2] = MFMA32(va[2], pb, o[2]); VQ(C0, 8, 1, 2); SBAR();
      o[3] = MFMA32(va[3], pb, o[3]); VQ(C0, 8, 1, 3); SBAR(); }
#pragma unroll
    for (int b = 0; b < 4; ++b) va[b] = VLD(b, 2);
    { const bf16x8 pb = __builtin_bit_cast(bf16x8, pw[1]);
      o[0] = MFMA32(vn[0], pb, o[0]); VQ(C1, 0, 2, 0); SBAR();
      o[1] = MFMA32(vn[1], pb, o[1]); VQ(C1, 0, 2, 1); SBAR();
      o[2] = MFMA32(vn[2], pb, o[2]); VQ(C1, 0, 2, 2); SBAR();
      o[3] = MFMA32(vn[3], pb, o[3]); VQ(C1, 0, 2, 3); SBAR(); }
#pragma unroll
    for (int b = 0; b < 4; ++b) vn[b] = VLD(b, 3);
    { const bf16x8 pb = __builtin_bit_cast(bf16x8, pw[2]);
      o[0] = MFMA32(va[0], pb, o[0]); VQ(C1, 8, 3, 0); SBAR();
      o[1] = MFMA32(va[1], pb, o[1]); VQ(C1, 8, 3, 1); SBAR();
      o[2] = MFMA32(va[2], pb, o[2]); VQ(C1, 8, 3, 2); SBAR();
      o[3] = MFMA32(va[3], pb, o[3]); VQ(C1, 8, 3, 3); SBAR(); }
    { const bf16x8 pb = __builtin_bit_cast(bf16x8, pw[3]);
      o[0] = MFMA32(vn[0], pb, o[0]);
      o[1] = MFMA32(vn[1], pb, o[1]);
      o[2] = MFMA32(vn[2], pb, o[2]);
      o[3] = MFMA32(vn[3], pb, o[3]); }
    lsum += s0 + s1;
#undef VQ
#undef KOFF
#undef VLD
    if (more2) {
#pragma unroll
        for (int i = 0; i < 2; ++i) *(LAS u32x4*)(lds + cur + kdst[i]) = sk[i];
    }
    if (more) {
#pragma unroll
        for (int i = 0; i < 2; ++i) *(LAS u32x4*)(lds + nxt + vdst[i]) = sv[i];
    }
    __syncthreads();
}

__device__ __forceinline__ void attn_unit(LAS unsigned char* lds, const bf16_t* __restrict__ ZA, const bf16_t* __restrict__ ZT, bf16_t* __restrict__ CAT, const float* __restrict__ subg,
                                          float lam, int seqrow0, int slen, int h, int qb) {
    int tid_ = threadIdx.x; asm volatile("" : "+v"(tid_));
    const int tid = tid_, lane = tid & 63, r32 = lane & 31, hi = lane >> 5;
    const int wid = __builtin_amdgcn_readfirstlane(tid >> 6), j = wid >> 2, sub = wid & 3;
    const int qrow = seqrow0 + qb * 128 + sub * 32 + r32;
    bf16x8 qr[4];
#pragma unroll
    for (int d0 = 0; d0 < 4; ++d0) qr[d0] = *(const bf16x8*)(ZA + (size_t)qrow * NZA + 512 + h * 128 + j * 64 + d0 * 16 + hi * 8);
    const bf16_t* ksrc[2]; const bf16_t* vsrc[2]; int kdst[2], vdst[2];
#pragma unroll
    for (int i = 0; i < 2; ++i) {
        const int kv = (tid >> 4) + 32 * i, ch = tid & 15, jj = ch >> 3, dch = ch & 7, rho = (kv & ~15) | swap23(kv & 15);
        ksrc[i] = ZA + (size_t)(seqrow0 + kv) * NZA + 1024 + h * 128 + ch * 8;
        kdst[i] = jj * 8192 + rho * 128 + ((dch ^ ((rho >> 1) & 7)) * 16);
        const int d = (tid >> 3) + 64 * i, vch = tid & 7;
        vsrc[i] = ZT + (size_t)(512 + h * 128 + d) * NTOK + seqrow0 + vch * 8;
        vdst[i] = 16384 + d * 128 + ((vch ^ ((d >> 1) & 7)) * 16);
    }
    const int NT = slen / 64;
    const int swz = (r32 >> 1) & 7;
    {
        u32x4 a[2], b[2], c[2];
#pragma unroll
        for (int i = 0; i < 2; ++i) { a[i] = *(const u32x4*)ksrc[i]; b[i] = *(const u32x4*)vsrc[i]; c[i] = *(const u32x4*)(ksrc[i] + (size_t)64 * NZA); }
#pragma unroll
        for (int i = 0; i < 2; ++i) { *(LAS u32x4*)(lds + kdst[i]) = a[i]; *(LAS u32x4*)(lds + vdst[i]) = b[i]; *(LAS u32x4*)(lds + 32768 + kdst[i]) = c[i]; }
    }
    __syncthreads();
    f32x16 o[4], SA0, SA1, SB0, SB1;
#pragma unroll
    for (int b = 0; b < 4; ++b)
#pragma unroll
        for (int r = 0; r < 16; ++r) o[b][r] = 0.f;
#pragma unroll
    for (int r = 0; r < 16; ++r) { SA0[r] = 0.f; SA1[r] = 0.f; }
    {
        const LAS unsigned char* kb = lds + j * 8192 + r32 * 128;
#pragma unroll
        for (int d0 = 0; d0 < 4; ++d0) {
            const int off = ((2 * d0 + hi) ^ swz) * 16;
            const bf16x8 a0 = *(const LAS bf16x8*)(kb + off), a1 = *(const LAS bf16x8*)(kb + 4096 + off);
            SA0 = MFMA32(a0, qr[d0], SA0); SA1 = MFMA32(a1, qr[d0], SA1);
        }
    }
    asm volatile("s_nop 15\n\ts_nop 7" : "+v"(SA0), "+v"(SA1));
    float mrun = -INFINITY, lsum = 0.f;
    for (int t = 0; t < NT; t += 2) {
        att_step(lds, t, NT, j, r32, hi, swz, qr, o, SA0, SA1, SB0, SB1, mrun, lsum, ksrc, vsrc, kdst, vdst);
        att_step(lds, t + 1, NT, j, r32, hi, swz, qr, o, SB0, SB1, SA0, SA1, mrun, lsum, ksrc, vsrc, kdst, vdst);
    }
    const float inv = 1.0f / half_swap_sum(lsum);
    LAS float* X = (LAS float*)lds + sub * 4096 + lane;
    if (j == 1) {
        const float f = inv * lam;
#pragma unroll
        for (int b = 0; b < 4; ++b)
#pragma unroll
            for (int r = 0; r < 16; ++r) X[(b * 16 + r) * 64] = o[b][r] * f;
    }
    __syncthreads();
    if (j == 0) {
        float ss = 0.f;
#pragma unroll
        for (int b = 0; b < 4; ++b)
#pragma unroll
            for (int r = 0; r < 16; ++r) { const float v = o[b][r] * inv - X[(b * 16 + r) * 64]; o[b][r] = v; ss += v * v; }
        ss = half_swap_sum(ss);
        const float rs = __builtin_amdgcn_rsqf(ss * (1.0f / 128.0f) + EPS) * (1.0f - LAM_INIT);
        bf16_t* op = CAT + (size_t)qrow * DM + 512 + h * 128;
#pragma unroll
        for (int b = 0; b < 4; ++b)
#pragma unroll
            for (int a = 0; a < 4; ++a) {
                const int d0 = 32 * b + 8 * a + 4 * hi; const f32x4 g = *(const f32x4*)(subg + d0);
                u32x2 w; w.x = cvtpk(o[b][4 * a] * rs * g[0], o[b][4 * a + 1] * rs * g[1]); w.y = cvtpk(o[b][4 * a + 2] * rs * g[2], o[b][4 * a + 3] * rs * g[3]);
                *(u32x2*)(op + d0) = w;
            }
    }
    __syncthreads();
}

__device__ __forceinline__ void gmlp_item(LAS unsigned char* lds, const bf16_t* __restrict__ ZA, const bf16_t* __restrict__ ZT, bf16_t* __restrict__ CAT, const float* __restrict__ Wsg,
                                          const float* __restrict__ vng, const float* __restrict__ bsg, int ck, int g) {
    int tid_ = threadIdx.x; asm volatile("" : "+v"(tid_));
    const int tid = tid_, lane = tid & 63, r32 = lane & 31, hi = lane >> 5;
    const int wid = __builtin_amdgcn_readfirstlane(tid >> 6);
    const int R0 = ck * 128;
    LAS float* red = (LAS float*)(lds + 32768); LAS float* rstd = (LAS float*)(lds + 32768 + 2048);
#pragma unroll
    for (int i = 0; i < 4; ++i) {
        const int c = tid + 512 * i, e = c >> 4, ch = c & 15;
        const u32x4 v = *(const u32x4*)(ZT + (size_t)(g * 128 + e) * NTOK + R0 + ch * 8);
        *(LAS u32x4*)(lds + e * 256 + ((ch ^ (e & 15)) * 16)) = v;
    }
    __syncthreads();
    { const int q = tid & 127, part = tid >> 7; float s = 0.f;
#pragma unroll 8
      for (int ee = 0; ee < 32; ++ee) { const int e = part * 32 + ee; const unsigned short b = *(const LAS unsigned short*)(lds + e * 256 + (((q >> 3) ^ (e & 15)) * 16) + (q & 7) * 2); const float v = __uint_as_float((unsigned)b << 16); s += v * v; }
      red[part * 128 + q] = s; }
    __syncthreads();
    if (tid < 128) rstd[tid] = __builtin_amdgcn_rsqf((red[tid] + red[128 + tid] + red[256 + tid] + red[384 + tid]) * (1.0f / 128.0f) + EPS);
    __syncthreads();
    const int eblk = wid & 3, pb0 = 2 * (wid >> 2);
    f32x16 acc[2];
#pragma unroll
    for (int r = 0; r < 16; ++r) { acc[0][r] = 0.f; acc[1][r] = 0.f; }
#pragma unroll
    for (int kk = 0; kk < 8; ++kk) {
        const bf16x8 a = *(const LAS bf16x8*)(lds + (32 * eblk + r32) * 256 + (((2 * kk + hi) ^ (r32 & 15)) * 16));
        const f32x4 ra = *(const LAS f32x4*)(rstd + 16 * kk + 8 * hi), rb = *(const LAS f32x4*)(rstd + 16 * kk + 8 * hi + 4);
#pragma unroll
        for (int pp = 0; pp < 2; ++pp) {
            const float* wp = Wsg + (size_t)(32 * (pb0 + pp) + r32) * 128 + 16 * kk + 8 * hi;
            const f32x4 wa = *(const f32x4*)wp * ra, wb = *(const f32x4*)(wp + 4) * rb;
            const bf16x8 b = __builtin_bit_cast(bf16x8, pack8(wa, wb));
            acc[pp] = __builtin_amdgcn_mfma_f32_32x32x16_bf16(a, b, acc[pp], 0, 0, 0);
        }
    }
#pragma unroll
    for (int pp = 0; pp < 2; ++pp) {
        const int p = 32 * (pb0 + pp) + r32, row = R0 + p; const float bs = bsg[p];
#pragma unroll
        for (int a4 = 0; a4 < 4; ++a4) {
            const int e0 = 32 * eblk + 8 * a4 + 4 * hi; const f32x4 gv = *(const f32x4*)(vng + e0);
            const u32x2 uu = *(const u32x2*)(ZA + (size_t)row * NZA + g * 128 + e0);
            const float o0 = bflo(uu.x) * (gv[0] * acc[pp][4 * a4] + bs), o1 = bfhi(uu.x) * (gv[1] * acc[pp][4 * a4 + 1] + bs),
                        o2 = bflo(uu.y) * (gv[2] * acc[pp][4 * a4 + 2] + bs), o3 = bfhi(uu.y) * (gv[3] * acc[pp][4 * a4 + 3] + bs);
            u32x2 w; w.x = cvtpk(o0, o1); w.y = cvtpk(o2, o3);
            *(u32x2*)(CAT + (size_t)row * DM + g * 128 + e0) = w;
        }
    }
    __syncthreads();
}

#define XB_TMO      128
#define XB_XCNT(j)  (256  + 64 * (j))
#define XB_XSUB(j)  (1280 + 64 * (j))
#define XB_XGEN(j)  (2304 + 64 * (j))
#define XB_TOP      3328
#define XB_TOPGEN   3392
#define XCD_BAR_WORDS 3456
#define XB_SPIN_CAP (1u << 18)

__device__ __forceinline__ unsigned xb_ld(unsigned* p)              { return __hip_atomic_load(p, __ATOMIC_RELAXED, __HIP_MEMORY_SCOPE_AGENT); }
__device__ __forceinline__ unsigned xb_add(unsigned* p, unsigned v) { return __hip_atomic_fetch_add(p, v, __ATOMIC_RELAXED, __HIP_MEMORY_SCOPE_AGENT); }
__device__ __forceinline__ unsigned xb_xcc_id() { return (unsigned)__builtin_amdgcn_s_getreg((3 << 11) | 20) & 0xFu; }
#define XB_SPIN(cond, bar) do { unsigned _sp = 0; while (cond) { __builtin_amdgcn_s_sleep(1); \
    if ((++_sp & 255u) == 0u) { if (xb_ld(&(bar)[XB_TMO])) break; if (_sp > XB_SPIN_CAP) { atomicAdd(&(bar)[XB_TMO], 1u); break; } } } } while (0)

struct XcdBarrier {
    unsigned* bar; unsigned x;
    volatile LAS unsigned* st;
};

__device__ __forceinline__ XcdBarrier xcd_barrier_post(unsigned* bar, volatile LAS unsigned* st) {
    XcdBarrier b; b.bar = bar; b.x = xb_xcc_id(); b.st = st;
    if (threadIdx.x == 0) (void)xb_add(&bar[XB_XCNT(b.x)], 1u);
    return b;
}
__device__ __forceinline__ void xcd_barrier_complete(unsigned* bar, unsigned x, unsigned& nloc, unsigned& nx) {
    const unsigned G = gridDim.x * gridDim.y * gridDim.z;
    unsigned sum, cnt, mine, sp = 0u;
    for (;;) {
        sum = 0u; cnt = 0u; mine = 0u;
#pragma unroll
        for (unsigned j = 0; j < 16; ++j) { const unsigned c = xb_ld(&bar[XB_XCNT(j)]); sum += c; cnt += (c > 0u) ? 1u : 0u; mine = (j == x) ? c : mine; }
        if (sum == G) break;
        __builtin_amdgcn_s_sleep(1);
        if ((++sp & 255u) == 0u) { if (xb_ld(&bar[XB_TMO])) break; if (sp > XB_SPIN_CAP) { atomicAdd(&bar[XB_TMO], 1u); break; } }
    }
    nloc = mine > 0u ? mine : 1u; nx = cnt > 0u ? cnt : 1u;
}

__device__ __forceinline__ void xcd_barrier(const XcdBarrier& b) {
    asm volatile("s_waitcnt vmcnt(0)" ::: "memory");
    __syncthreads();
    if (threadIdx.x == 0) {
        unsigned* bar = b.bar;
        __builtin_amdgcn_s_waitcnt(0);
        unsigned nloc = b.st[0], nx = b.st[1];
        if (nloc == 0u) { xcd_barrier_complete(bar, b.x, nloc, nx); b.st[0] = nloc; b.st[1] = nx; }
        const unsigned old = xb_add(&bar[XB_XSUB(b.x)], 1u);
        const unsigned gen = old / nloc;
        if (old + 1u == (gen + 1u) * nloc) {
            __builtin_amdgcn_fence(__ATOMIC_RELEASE, "agent");
            asm volatile("s_waitcnt vmcnt(0)" ::: "memory");
            const unsigned og = xb_add(&bar[XB_TOP], 1u);
            const unsigned tg = og / nx;
            if (og + 1u == (tg + 1u) * nx) xb_add(&bar[XB_TOPGEN], 1u);
            else XB_SPIN(xb_ld(&bar[XB_TOPGEN]) == tg, bar);
            __builtin_amdgcn_fence(__ATOMIC_ACQUIRE, "agent");
            xb_add(&bar[XB_XGEN(b.x)], 1u);
            asm volatile("s_waitcnt vmcnt(0)" ::: "memory");
        } else {
            XB_SPIN(xb_ld(&bar[XB_XGEN(b.x)]) == gen, bar);
            __builtin_amdgcn_fence(__ATOMIC_ACQUIRE, "agent");
            asm volatile("s_waitcnt vmcnt(0)" ::: "memory");
        }
    }
    __syncthreads();
}

#define GEMM_RUN(EPI, g, E) do { pg8::StaticOrder S_; S_.init((g).M, (g).N, G, (int)blockIdx.x); pg8::gemm_phase<EPI, pg8::StaticOrder, PG8_ALIGN, PG8_SP2>(lds, (g), S_, (E)); } while (0)
#define GRID_SYNC0() grid.sync()
#ifdef USE_CG_SYNC
#define GRID_SYNC() grid.sync()
#else
#define GRID_SYNC() xcd_barrier(bar)
#endif
#ifndef PHMASK
#define PHMASK 0xffff
#endif
#define PH(n) (((PHMASK) >> (n)) & 1)
#ifndef REP_P2
#define REP_P2 1
#endif
#ifndef REP_G
#define REP_G 1
#endif

__global__ void __launch_bounds__(512) mega_fwd(Params P) {
    extern __shared__ __attribute__((aligned(16))) unsigned char lds_raw[];
    LAS unsigned char* lds = (LAS unsigned char*)lds_raw;
    cg::grid_group grid = cg::this_grid();
    const int tid = threadIdx.x, lane = tid & 63, wave = __builtin_amdgcn_readfirstlane(tid >> 6);
    const int G = gridDim.x, bx = blockIdx.x;
    const int vcu = (G % 8 == 0) ? (bx % 8) * (G / 8) + bx / 8 : bx;
    unsigned char* ws = P.ws;
    const float* x_prompt = P.in[0]; const float* x_sample = P.in[1];
    float* sumsq = (float*)(ws + WS_SUMSQ);
    volatile LAS unsigned* MISC = (volatile LAS unsigned*)(lds + 131072 + 320);
    if (tid < 64) MISC[tid] = 0u;
    __syncthreads();
    XcdBarrier bar = xcd_barrier_post((unsigned*)(ws + WS_BAR), MISC + 8);
    bf16_t* WinT = (bf16_t*)(ws + WS_WIN); bf16_t* WoutT = (bf16_t*)(ws + WS_WOUT); bf16_t* W1T = (bf16_t*)(ws + WS_W1); bf16_t* W2T = (bf16_t*)(ws + WS_W2);
    bf16_t* CinT = (bf16_t*)(ws + WS_CIN); bf16_t* CoutT = (bf16_t*)(ws + WS_COUT); float* rope = (float*)(ws + WS_ROPE);
    bf16_t* ZT = (bf16_t*)(ws + WS_HB); bf16_t* HB = (bf16_t*)(ws + WS_HB);
    bf16_t* XN = (bf16_t*)(ws + WS_BIG); bf16_t* CAT = (bf16_t*)(ws + WS_BIG); bf16_t* HID = (bf16_t*)(ws + WS_BIG);
    bf16_t* TB = (bf16_t*)(ws + WS_BIG); bf16_t* UB = (bf16_t*)(ws + WS_BIG + 64 * MiB);
    bf16_t* ZA = (bf16_t*)P.out; float* H = P.out;

    if (PH(0)) {
        LAS float* scr = (LAS float*)(lds + wave * 16384);
        const int gw = vcu * 8 + wave, NGW = G * 8;
        constexpr int I_EIN = 16 * 80, I_EOUT = 16 * 32, I_W1 = 16 * 128, I_W2 = 64 * 32, I_CIN = 16 * 96, I_COUT = 16 * 32;
        constexpr int NITEMS = I_EIN + I_EOUT + 2 * I_W1 + 2 * I_W2 + I_CIN + I_COUT;
        for (int it = gw; it < NITEMS; it += NGW) {
            int r = it;
            if (r < I_EIN) { transpose_item<1>(P.in[6], DM, 2560, WinT, nullptr, scr, r, lane); continue; } r -= I_EIN;
            if (r < I_EOUT) { transpose_item<0>(P.in[7], DM, DM, WoutT, nullptr, scr, r, lane); continue; } r -= I_EOUT;
            if (r < I_W1) { transpose_item<0>(P.in[4], DM, DFF, W1T, P.in[3], scr, r, lane); continue; } r -= I_W1;
            if (r < I_W1) { transpose_item<0>(P.in[4] + (size_t)DM * DFF, DM, DFF, W1T + (size_t)DM * DFF, P.in[3] + DM, scr, r, lane); continue; } r -= I_W1;
            if (r < I_W2) { transpose_item<0>(P.in[5], DFF, DM, W2T, nullptr, scr, r, lane); continue; } r -= I_W2;
            if (r < I_W2) { transpose_item<0>(P.in[5] + (size_t)DM * DFF, DFF, DM, W2T + (size_t)DM * DFF, nullptr, scr, r, lane); continue; } r -= I_W2;
            if (r < I_CIN) { transpose_item<2>(P.in[16], DM, 3072, CinT, P.in[2] + DM, scr, r, lane); continue; } r -= I_CIN;
            transpose_item<0>(P.in[18], DM, DM, CoutT, nullptr, scr, r, lane);
        }
        for (int m = gw; m < NTOK; m += NGW) {
            const float* xr = (m < NPROMPT) ? x_prompt + (size_t)m * DM : x_sample + (size_t)(m - NPROMPT) * DM;
            rms_row_to_bf16(xr, P.in[2], XN + (size_t)m * DM, lane);
        }
        const int gt = vcu * 512 + tid, NGT = G * 512;
        for (int i = gt; i < 4 * NTOK; i += NGT) sumsq[i] = 0.f;
        for (int i = gt; i < 8192 * 8; i += NGT) {
            const int pos = i >> 3, fi = i & 7;
            const float inv = exp2f(-(float)fi * 0.125f * 18.931568569324174f);
            const float ang = (float)pos * inv;
            const double ad = (double)ang; const double kq = rint(ad * 0.15915494309189535); const float rr = (float)(ad - kq * 6.283185307179586);
            rope[pos * 16 + fi] = __cosf(rr); rope[pos * 16 + 8 + fi] = __sinf(rr);
        }
    }
    GRID_SYNC0();

    if (PH(1)) {
        pg8::Gemm ga{XN, WinT, NTOK, 1536, DM}; EpiA ea{ZA, rope};
        GEMM_RUN(EpiA, ga, ea);
        pg8::Gemm gb{WinT + (size_t)1536 * DM, XN, 1024, NTOK, DM}; EpiB eb{ZT};
        GEMM_RUN(EpiB, gb, eb);
    }
    GRID_SYNC();

    if (PH(2)) {
        float s1 = 0.f, s2 = 0.f;
        for (int i = 0; i < 64; ++i) { s1 += P.in[11][i] * P.in[12][i]; s2 += P.in[13][i] * P.in[14][i]; }
        const float lam = __expf(s1) - __expf(s2) + LAM_INIT;
        for (int rep_ = 0; rep_ < REP_P2; ++rep_)
        for (int k = vcu; k < 256; k += G) {
#pragma unroll 1
            for (int w = 0; w < 2; ++w) { const int idx = 2 * k + w, bh = idx >> 6, qb = idx & 63; attn_unit(lds, ZA, ZT, CAT, P.in[15], lam, NPROMPT + (bh >> 2) * 8192, 8192, bh & 3, qb); }
#pragma unroll 1
            for (int w = 0; w < 2; ++w) { const int idx = 2 * k + w, bh = idx >> 5, qb = idx & 31; attn_unit(lds, ZA, ZT, CAT, P.in[15], lam, (bh >> 2) * 4096, 4096, bh & 3, qb); }
        }
        for (int it = vcu; it < 1024; it += G) { const int ck = it >> 2, g = it & 3; gmlp_item(lds, ZA, ZT, CAT, P.in[9] + (size_t)g * 16384, P.in[8] + g * 128, P.in[10] + g * 128, ck, g); }
    }
    GRID_SYNC();

    if (PH(3)) {
        pg8::Gemm g{CAT, WoutT, NTOK, DM, DM}; EpiRes<0> e{x_prompt, x_sample - (size_t)NPROMPT * DM, H, HB, sumsq, 0};
        GEMM_RUN(EpiRes<0>, g, e);
    }
    GRID_SYNC();

#pragma unroll 1
    for (int hf = 0; hf < 2 && PH(4); ++hf) {
        if (PH(10)) { pg8::Gemm g{HB + (size_t)hf * 16384 * DM, W1T, 16384, DFF, DM}; EpiFfn1 e{HID, sumsq, hf * 16384}; GEMM_RUN(EpiFfn1, g, e); }
        GRID_SYNC();
        if (PH(11)) { pg8::Gemm g{HID, W2T, 16384, DM, DFF}; EpiRes<1> e{nullptr, nullptr, H, HB, sumsq + NTOK, hf * 16384}; GEMM_RUN(EpiRes<1>, g, e); }
        GRID_SYNC();
    }

    if (PH(5)) { pg8::Gemm g{HB, CinT, NTOK, 2048, DM}; EpiConvT e{TB, sumsq + NTOK}; GEMM_RUN(EpiConvT, g, e); }
    GRID_SYNC();
    if (PH(6)) { pg8::Gemm g{HB, CinT + (size_t)2048 * DM, NTOK, DM, DM}; EpiConvU e{UB, TB, sumsq + NTOK, P.in[17]}; GEMM_RUN(EpiConvU, g, e); }
    GRID_SYNC();
    if (PH(7)) { pg8::Gemm g{UB, CoutT, NTOK, DM, DM}; EpiRes<1> e{nullptr, nullptr, H, HB, sumsq + 2 * NTOK, 0}; GEMM_RUN(EpiRes<1>, g, e); }
    GRID_SYNC();

#pragma unroll 1
    for (int hf = 0; hf < 2 && PH(8); ++hf) {
        { pg8::Gemm g{HB + (size_t)hf * 16384 * DM, W1T + (size_t)DM * DFF, 16384, DFF, DM}; EpiFfn1 e{HID, sumsq + 2 * NTOK, hf * 16384}; GEMM_RUN(EpiFfn1, g, e); }
        GRID_SYNC();
        { pg8::Gemm g{HID, W2T + (size_t)DM * DFF, 16384, DM, DFF}; EpiRes<2> e{nullptr, nullptr, H, HB, sumsq + 3 * NTOK, hf * 16384}; GEMM_RUN(EpiRes<2>, g, e); }
        GRID_SYNC();
    }

    if (PH(9)) {
        const int gw = vcu * 8 + wave, NGW = G * 8; const float* fg = P.in[19];
        for (int m = gw; m < NTOK; m += NGW) {
            const float rs = 1.0f / sqrtf(sumsq[3 * NTOK + m] * (1.0f / DM) + EPS);
            f32x4* hr = (f32x4*)(H + (size_t)m * DM) + lane; const f32x4* gr = (const f32x4*)fg + lane;
#pragma unroll
            for (int jx = 0; jx < 4; ++jx) hr[64 * jx] = hr[64 * jx] * rs * gr[64 * jx];
        }
    }
}

extern "C" void kernel_launch(void* const* d_in, const int* in_sizes, int n_in, void* d_out, int out_size, void* d_ws, size_t ws_size, hipStream_t stream) {
    static int grid = 0;
    if (grid == 0) {
        if (n_in != 20 || out_size != NTOK * DM || ws_size < WS_END) { fprintf(stderr, "kernel_launch: unexpected shapes (n_in %d out %d ws %zu)\n", n_in, out_size, ws_size); grid = -1; return; }
        int dev = 0, cus = 0, per_cu = 0;
        hipGetDevice(&dev); hipDeviceGetAttribute(&cus, hipDeviceAttributeMultiprocessorCount, dev);
        if (hipFuncSetAttribute((const void*)mega_fwd, hipFuncAttributeMaxDynamicSharedMemorySize, LDS_BYTES) != hipSuccess) { fprintf(stderr, "kernel_launch: hipFuncSetAttribute failed\n"); grid = -1; return; }
        if (hipOccupancyMaxActiveBlocksPerMultiprocessor(&per_cu, (const void*)mega_fwd, 512, LDS_BYTES) != hipSuccess || per_cu < 1) { fprintf(stderr, "kernel_launch: occupancy query says %d\n", per_cu); per_cu = 1; }
        (void)hipGetLastError();
        grid = cus * per_cu;
    }
    if (grid < 0) return;
    if (hipMemsetAsync((char*)d_ws + WS_BAR, 0, BAR_BYTES, stream) != hipSuccess) { fprintf(stderr, "kernel_launch: memset failed\n"); return; }
    Params p{};
    for (int i = 0; i < 20; ++i) p.in[i] = (const float*)d_in[i];
    p.out = (float*)d_out; p.ws = (unsigned char*)d_ws;
    void* args[] = {&p};
    hipError_t e = hipLaunchCooperativeKernel((const void*)mega_fwd, dim3(grid), dim3(512), args, LDS_BYTES, stream);
    if (e != hipSuccess) fprintf(stderr, "kernel_launch: cooperative launch failed: %s (grid %d)\n", hipGetErrorString(e), grid);
}
```

```cpp
#include <hip/hip_runtime.h>
#include <hip/hip_cooperative_groups.h>
#include <cstdio>
#include <cstdint>
namespace cg = cooperative_groups;
namespace pg8 {
#define PG8_LAS __attribute__((address_space(3)))
typedef unsigned short bf16_t;
typedef short bf16x8 __attribute__((ext_vector_type(8)));
typedef float f32x4 __attribute__((ext_vector_type(4)));
typedef unsigned u32x4 __attribute__((ext_vector_type(4)));
constexpr int BM = 256, BK = 64, HALF = 128, HTB = HALF * BK * 2  , STAGE_BYTES = 8 * HTB, NXCD = 8, WGM = 8;

__host__ __device__ __forceinline__ int lds_byte(int r, int c) { const int st = (r >> 4) * 2 + (c >> 5), rr = r & 15, cc = c & 31, ob = rr * 64 + cc * 2; return st * 1024 + (ob ^ (((ob >> 9) & 1) << 5)); }
__host__ __device__ __forceinline__ void stage_rc(int b, int& R, int& C) { const int st = b / 1024, sb = b % 1024, swz = sb ^ (((sb >> 9) & 1) << 5); R = (st >> 1) * 16 + swz / 64; C = (st & 1) * 32 + (swz % 64) / 2; }
__host__ __device__ __forceinline__ int perm32(int rho) { const int n = rho >> 4, i = rho & 15; return 8 * (i >> 2) + 4 * n + (i & 3); }

struct Unit { int pm, pn; };
struct Gemm { const bf16_t* A; const bf16_t* Bt; int M, N, K; };

struct StaticOrder {
    int nM, nN, nwg, G, c;
    __host__ __device__ void init(int M, int N, int G_, int c_) { nM = M / BM; nN = N / BM; nwg = nM * nN; G = G_; c = c_; }
    __host__ __device__ bool next(int i, Unit& u) const {
        const long L = (long)i * G + c; if (L >= nwg) return false;
        int wgid = (int)L; { const int q = nwg / NXCD, r = nwg % NXCD, xcd = wgid % NXCD, off = wgid / NXCD; wgid = (xcd < r ? xcd * (q + 1) : r * (q + 1) + (xcd - r) * q) + off; }
        const int nig = WGM * nN, gid = wgid / nig, fm = gid * WGM, gsz = (nM - fm) < WGM ? (nM - fm) : WGM;
        u.pm = fm + ((wgid % nig) % gsz); u.pn = (wgid % nig) / gsz; return true;
    }
    __device__ __forceinline__ void a_ready(const Unit&) const {}
    __device__ __forceinline__ void done(const Unit&) const {}
};

__device__ __forceinline__ unsigned cvt_pk_bf16(float lo, float hi) { unsigned r; asm volatile("v_cvt_pk_bf16_f32 %0, %1, %2" : "=v"(r) : "v"(lo), "v"(hi)); return r; }
typedef float f32x2 __attribute__((ext_vector_type(2)));
__device__ __forceinline__ f32x2 gelu_pk(f32x2 v) {
    const f32x2 av = __builtin_elementwise_abs(v), d = av * 0.2316418882f + 1.0f;
    f32x2 t; t.x = __builtin_amdgcn_rcpf(d.x); t.y = __builtin_amdgcn_rcpf(d.y);
    f32x2 q = t * 0.5307027145f + (-0.7265760135f); q = q * t + 0.7107068705f; q = q * t + (-0.142248368f); q = q * t + 0.127414796f; q = q * t;
    const f32x2 s = (v * v) * (-0.72134752044f);
    f32x2 e; e.x = __builtin_amdgcn_exp2f(s.x); e.y = __builtin_amdgcn_exp2f(s.y);
    const f32x2 m = v * (q * e), r = v - m;
    f32x2 o; o.x = v.x < 0.f ? m.x : r.x; o.y = v.y < 0.f ? m.y : r.y; return o;
}

template <class Epi, class Sched, bool ALIGN_EPI = false, bool SP2 = false>
__device__ __forceinline__ void gemm_phase(PG8_LAS unsigned char* lds, const Gemm g, const Sched& S, const Epi& E) {
    int tid_ = threadIdx.x; asm volatile("" : "+v"(tid_));
    const int tid = tid_, wid = __builtin_amdgcn_readfirstlane(tid >> 6), lane = tid & 63, wr = wid >> 2, wc = wid & 3, fr = lane & 15, fq = lane >> 4;
    const int K = g.K, nt = K / BK;
    unsigned voffA[2], voffB[2];
#pragma unroll
    for (int i = 0; i < 2; ++i) { int R, C; stage_rc(tid * 16 + i * 8192, R, C); const int Rb = Epi::PERM ? ((R & ~31) + perm32(R & 31)) : R;
        voffA[i] = (unsigned)(R * K + C) * 2u; voffB[i] = (unsigned)(Rb * K + C) * 2u; }
    const size_t kstep = (size_t)(BK * 2);
    const size_t hstep = (size_t)HALF * K * 2;
    const size_t tstep = 2 * hstep;
    const unsigned ldsw = (unsigned)wid * 1024u;
    const int aoff = lds_byte(wr * 64 + fr, fq * 8), boff = lds_byte(wc * 32 + fr, fq * 8);
#define PG8_SA(b, h) (((b) * 2 + (h)) * HTB)
#define PG8_SB(b, h) ((4 + (b) * 2 + (h)) * HTB)
#define PG8_STAGE(bufoff, gbase, voff) do { _Pragma("unroll") for (int _i = 0; _i < 2; ++_i) \
        __builtin_amdgcn_global_load_lds((const unsigned*)((const char*)(gbase) + (voff)[_i]), (PG8_LAS unsigned*)(lds + (bufoff) + ldsw + _i * 8192), 16, 0, 0); } while (0)
#define PG8_LDA(dst, b, h) do { _Pragma("unroll") for (int m = 0; m < 4; ++m) _Pragma("unroll") for (int k = 0; k < 2; ++k) dst[m][k] = *(const PG8_LAS bf16x8*)(lds + PG8_SA(b, h) + aoff + m * 2048 + k * 1024); } while (0)
#define PG8_LDB(dst, b, h) do { _Pragma("unroll") for (int n = 0; n < 2; ++n) _Pragma("unroll") for (int k = 0; k < 2; ++k) dst[n][k] = *(const PG8_LAS bf16x8*)(lds + PG8_SB(b, h) + boff + n * 2048 + k * 1024); } while (0)
#define PG8_MMA(ai, bj, At, Bt) do { __builtin_amdgcn_s_setprio(1); _Pragma("unroll") for (int m = 0; m < 4; ++m) _Pragma("unroll") for (int n = 0; n < 2; ++n) _Pragma("unroll") for (int k = 0; k < 2; ++k) \
        acc[ai][bj][m][n] = __builtin_amdgcn_mfma_f32_16x16x32_bf16(Bt[n][k], At[m][k], acc[ai][bj][m][n], 0, 0, 0); __builtin_amdgcn_s_setprio(0); } while (0)
#define PG8_WAIT_V(n) asm volatile("s_waitcnt vmcnt(" #n ")" ::: "memory")
#define PG8_WAIT_L(n) asm volatile("s_waitcnt lgkmcnt(" #n ")" ::: "memory")
#define PG8_BAR __builtin_amdgcn_s_barrier()
#define PG8_SCHED __builtin_amdgcn_sched_barrier(0)
    Unit cur, nxt; int ui = 0;
    if (!S.next(0, cur)) return;
    f32x4 acc[2][2][4][2];
#pragma unroll
    for (int a = 0; a < 2; ++a)
#pragma unroll
        for (int b = 0; b < 2; ++b)
#pragma unroll
            for (int m = 0; m < 4; ++m)
#pragma unroll
                for (int n = 0; n < 2; ++n) acc[a][b][m][n] = (f32x4){0.f, 0.f, 0.f, 0.f};
    bf16x8 At[4][2], B0[2][2], B1[2][2];
    const char* cA = (const char*)g.A + (size_t)cur.pm * tstep; const char* cB = (const char*)g.Bt + (size_t)cur.pn * tstep;
    S.a_ready(cur);
    if constexpr (SP2) {
        PG8_STAGE(PG8_SB(0, 0), cB, voffB); PG8_STAGE(PG8_SB(0, 1), cB + hstep, voffB); PG8_STAGE(PG8_SA(0, 0), cA, voffA); PG8_STAGE(PG8_SA(0, 1), cA + hstep, voffA);
        if (wr == 1) PG8_BAR;
        PG8_WAIT_V(2); PG8_BAR;
        PG8_STAGE(PG8_SB(1, 0), cB + kstep, voffB); PG8_STAGE(PG8_SA(1, 0), cA + kstep, voffA); PG8_STAGE(PG8_SB(1, 1), cB + hstep + kstep, voffB);
        PG8_WAIT_V(6); PG8_BAR;
    } else {
        PG8_STAGE(PG8_SB(0, 0), cB, voffB); PG8_STAGE(PG8_SA(0, 0), cA, voffA); PG8_STAGE(PG8_SB(0, 1), cB + hstep, voffB); PG8_STAGE(PG8_SA(0, 1), cA + hstep, voffA);
        if (wr == 1) PG8_BAR;
        PG8_WAIT_V(4); PG8_BAR;
        PG8_STAGE(PG8_SB(1, 0), cB + kstep, voffB); PG8_STAGE(PG8_SA(1, 0), cA + kstep, voffA); PG8_STAGE(PG8_SB(1, 1), cB + hstep + kstep, voffB);
        PG8_WAIT_V(6); PG8_BAR;
    }
    for (;;) {
        const bool has_next = S.next(ui + 1, nxt);
        const char* nA = has_next ? (const char*)g.A + (size_t)nxt.pm * tstep : cA; const char* nB = has_next ? (const char*)g.Bt + (size_t)nxt.pn * tstep : cB;
        for (int t = 0; t < nt; t += 2) {
            const bool last = (t == nt - 2);
            const char* a1 = cA + (size_t)(t + 1) * kstep;
            const char* a2 = last ? nA : cA + (size_t)(t + 2) * kstep; const char* b2 = last ? nB : cB + (size_t)(t + 2) * kstep;
            const char* a3 = a2 + kstep; const char* b3 = b2 + kstep;
            if (last && has_next) S.a_ready(nxt);
            if constexpr (SP2) {
            PG8_LDB(B0, 0, 0); PG8_LDB(B1, 0, 1); PG8_SCHED; PG8_LDA(At, 0, 0); PG8_STAGE(PG8_SA(1, 1), a1 + hstep, voffA);
            PG8_WAIT_V(8); PG8_WAIT_L(0); PG8_BAR; PG8_MMA(0, 0, At, B0); PG8_MMA(0, 1, At, B1); PG8_BAR; PG8_SCHED;
            PG8_LDA(At, 0, 1); PG8_STAGE(PG8_SB(0, 0), b2, voffB); PG8_STAGE(PG8_SB(0, 1), b2 + hstep, voffB); PG8_STAGE(PG8_SA(0, 0), a2, voffA);
            PG8_WAIT_V(8); PG8_WAIT_L(0); PG8_BAR; PG8_MMA(1, 0, At, B0); PG8_MMA(1, 1, At, B1); PG8_BAR; PG8_SCHED;
            PG8_LDB(B0, 1, 0); PG8_LDB(B1, 1, 1); PG8_SCHED; PG8_LDA(At, 1, 0); PG8_STAGE(PG8_SA(0, 1), a2 + hstep, voffA);
            PG8_WAIT_V(8); PG8_WAIT_L(0); PG8_BAR; PG8_MMA(0, 0, At, B0); PG8_MMA(0, 1, At, B1); PG8_BAR; PG8_SCHED;
            PG8_LDA(At, 1, 1); PG8_STAGE(PG8_SB(1, 0), b3, voffB); PG8_STAGE(PG8_SB(1, 1), b3 + hstep, voffB); PG8_STAGE(PG8_SA(1, 0), a3, voffA);
            PG8_WAIT_V(8); PG8_WAIT_L(0); PG8_BAR; PG8_MMA(1, 0, At, B0); PG8_MMA(1, 1, At, B1); PG8_BAR; PG8_SCHED;
            } else {
            PG8_LDB(B0, 0, 0); PG8_SCHED; PG8_LDA(At, 0, 0); PG8_STAGE(PG8_SA(1, 1), a1 + hstep, voffA);
            PG8_WAIT_L(8); PG8_BAR; PG8_WAIT_L(0); PG8_MMA(0, 0, At, B0); PG8_BAR; PG8_SCHED;
            PG8_LDB(B1, 0, 1); PG8_STAGE(PG8_SB(0, 0), b2, voffB);
            PG8_BAR; PG8_WAIT_L(0); PG8_MMA(0, 1, At, B1); PG8_BAR;
            PG8_LDA(At, 0, 1); PG8_STAGE(PG8_SA(0, 0), a2, voffA);
            PG8_BAR; PG8_WAIT_L(0); PG8_MMA(1, 0, At, B0); PG8_BAR; PG8_SCHED;
            PG8_STAGE(PG8_SB(0, 1), b2 + hstep, voffB);
            PG8_WAIT_V(6); PG8_BAR; PG8_MMA(1, 1, At, B1); PG8_BAR;
            PG8_LDB(B0, 1, 0); PG8_SCHED; PG8_LDA(At, 1, 0); PG8_STAGE(PG8_SA(0, 1), a2 + hstep, voffA);
            PG8_WAIT_L(8); PG8_BAR; PG8_WAIT_L(0); PG8_MMA(0, 0, At, B0); PG8_BAR; PG8_SCHED;
            PG8_LDB(B1, 1, 1); PG8_STAGE(PG8_SB(1, 0), b3, voffB);
            PG8_BAR; PG8_WAIT_L(0); PG8_MMA(0, 1, At, B1); PG8_BAR;
            PG8_LDA(At, 1, 1); PG8_STAGE(PG8_SA(1, 0), a3, voffA);
            PG8_BAR; PG8_WAIT_L(0); PG8_MMA(1, 0, At, B0); PG8_BAR; PG8_SCHED;
            PG8_STAGE(PG8_SB(1, 1), b3 + hstep, voffB);
            PG8_WAIT_V(6); PG8_BAR; PG8_MMA(1, 1, At, B1); PG8_BAR;
            }
        }
        if constexpr (ALIGN_EPI) { if (wr == 0) PG8_BAR; }
        if constexpr (!Epi::AFTER_DRAIN) { E(acc, cur, wr, wc, fr, fq); S.done(cur); }
        if (!has_next) break;
#pragma unroll
        for (int a = 0; a < 2; ++a)
#pragma unroll
            for (int b = 0; b < 2; ++b)
#pragma unroll
                for (int m = 0; m < 4; ++m)
#pragma unroll
                    for (int n = 0; n < 2; ++n) acc[a][b][m][n] = (f32x4){0.f, 0.f, 0.f, 0.f};
        cur = nxt; cA = nA; cB = nB; ++ui;
        if constexpr (ALIGN_EPI) { if (wr == 1) PG8_BAR; }
    }
    PG8_WAIT_V(0);
    if constexpr (!ALIGN_EPI) { if (wr == 0) PG8_BAR; }
    PG8_BAR;
    if constexpr (Epi::AFTER_DRAIN) { E.fused(acc, cur, wr, wc, fr, fq, lds, wid, lane); S.done(cur); }
#undef PG8_SA
#undef PG8_SB
#undef PG8_STAGE
#undef PG8_LDA
#undef PG8_LDB
#undef PG8_MMA
#undef PG8_WAIT_V
#undef PG8_WAIT_L
#undef PG8_BAR
#undef PG8_SCHED
}
}

#ifndef PG8_SP2
#define PG8_SP2 true
#endif
#ifndef PG8_ALIGN
#define PG8_ALIGN true
#endif
#define LAS __attribute__((address_space(3)))
typedef unsigned short bf16_t;
typedef short bf16x8 __attribute__((ext_vector_type(8)));
typedef float f32x4 __attribute__((ext_vector_type(4)));
typedef float f32x16 __attribute__((ext_vector_type(16)));
typedef unsigned u32x4 __attribute__((ext_vector_type(4)));
typedef unsigned u32x2 __attribute__((ext_vector_type(2)));
using pg8::Unit;

constexpr int NTOK = 32768, NPROMPT = 16384, DM = 1024, DFF = 4096;
constexpr int NZA = 1536;
constexpr float EPS = 1e-5f;
constexpr float C2 = 0.125f * 1.4426950408889634f;
constexpr float LAM_INIT = 0.2f;
constexpr size_t MiB = 1u << 20;
constexpr size_t WS_SUMSQ = 0;
constexpr size_t WS_BAR = 512 * 1024, BAR_BYTES = 16384;
constexpr size_t WS_WIN = 1 * MiB, WS_WOUT = 6 * MiB, WS_W1 = 8 * MiB, WS_W2 = 24 * MiB, WS_CIN = 40 * MiB, WS_COUT = 46 * MiB, WS_ROPE = 48 * MiB;
constexpr size_t WS_HB = 49 * MiB;
constexpr size_t WS_BIG = 113 * MiB;
constexpr size_t WS_END = 241 * MiB;
constexpr int LDS_BYTES = 147456;

struct Params { const float* in[20]; float* out; unsigned char* ws; };

typedef float f32x2_t __attribute__((ext_vector_type(2))); typedef __bf16 bf16x2_t __attribute__((ext_vector_type(2)));
__device__ __forceinline__ unsigned cvtpk(float lo, float hi) { f32x2_t v = {lo, hi}; bf16x2_t b = __builtin_convertvector(v, bf16x2_t); return __builtin_bit_cast(unsigned, b); }
__device__ __forceinline__ u32x4 pack8(f32x4 a, f32x4 b) { u32x4 w; w.x = cvtpk(a[0], a[1]); w.y = cvtpk(a[2], a[3]); w.z = cvtpk(b[0], b[1]); w.w = cvtpk(b[2], b[3]); return w; }
__device__ __forceinline__ float bflo(unsigned x) { return __uint_as_float(x << 16); }
__device__ __forceinline__ float bfhi(unsigned x) { return __uint_as_float(x & 0xffff0000u); }
__device__ __forceinline__ void unpack8(u32x4 w, f32x4& a, f32x4& b) { a = (f32x4){bflo(w.x), bfhi(w.x), bflo(w.y), bfhi(w.y)}; b = (f32x4){bflo(w.z), bfhi(w.z), bflo(w.w), bfhi(w.w)}; }
__device__ __forceinline__ float gelu_tanh(float x) { const float t = x * (1.0f + 0.044715f * x * x); const float e = __builtin_amdgcn_exp2f(-2.302208198f * t); return x * __builtin_amdgcn_rcpf(1.0f + e); }
__device__ __forceinline__ f32x4 gelu4(f32x4 v) { return (f32x4){gelu_tanh(v[0]), gelu_tanh(v[1]), gelu_tanh(v[2]), gelu_tanh(v[3])}; }
__device__ __forceinline__ float wave_sum(float v) {
#pragma unroll
    for (int o = 1; o < 64; o <<= 1) v += __shfl_xor(v, o);
    return v;
}
__device__ __forceinline__ int seqpos(int row) { return row < NPROMPT ? (row & 4095) : (row & 8191); }

struct EpiA {
    static constexpr bool PERM = true, AFTER_DRAIN = false;
    bf16_t* ZA; const float* rope;
    __device__ __forceinline__ void operator()(const f32x4 (&acc)[2][2][4][2], const Unit& u, int wr, int wc, int fr, int fq) const {
        const int row0 = u.pm * 256 + wr * 64 + fr, kind = u.pn >> 1, col0 = u.pn * 256 + wc * 32 + 8 * fq;
        const bool ropew = (kind != 0) && ((wc & 1) == 0);
        const float sgn = (fq == 0) ? -1.f : 1.f, sc = (kind == 1) ? C2 : 1.f;
#pragma unroll
        for (int ai = 0; ai < 2; ++ai)
#pragma unroll
            for (int m = 0; m < 4; ++m) {
                const int row = row0 + ai * 128 + m * 16;
                f32x4 c0 = {1.f, 1.f, 1.f, 1.f}, c1 = c0, s0 = {0.f, 0.f, 0.f, 0.f}, s1 = s0;
                if (ropew) { const float* rp = rope + seqpos(row) * 16; c0 = *(const f32x4*)rp; c1 = *(const f32x4*)(rp + 4); s0 = *(const f32x4*)(rp + 8); s1 = *(const f32x4*)(rp + 12); }
                bf16_t* op = ZA + (size_t)row * NZA + col0;
#pragma unroll
                for (int bj = 0; bj < 2; ++bj) {
                    f32x4 v0 = acc[ai][bj][m][0], v1 = acc[ai][bj][m][1];
                    if (kind == 0) { v0 = gelu4(v0); v1 = gelu4(v1); }
                    else {
                        if (ropew) {
                            f32x4 p0, p1;
#pragma unroll
                            for (int e = 0; e < 4; ++e) { p0[e] = __shfl_xor(v0[e], 16); p1[e] = __shfl_xor(v1[e], 16); }
                            if (fq < 2) { v0 = v0 * c0 + (p0 * s0) * sgn; v1 = v1 * c1 + (p1 * s1) * sgn; }
                        }
                        v0 = v0 * sc; v1 = v1 * sc;
                    }
                    *(u32x4*)(op + bj * 128) = pack8(v0, v1);
                }
                asm volatile("" ::: "memory");
            }
    }
};
struct EpiB {
    static constexpr bool PERM = true, AFTER_DRAIN = false;
    bf16_t* ZT;
    __device__ __forceinline__ void operator()(const f32x4 (&acc)[2][2][4][2], const Unit& u, int wr, int wc, int fr, int fq) const {
        const int row0 = u.pm * 256 + wr * 64 + fr, col0 = u.pn * 256 + wc * 32 + 8 * fq; const bool act = u.pm < 2;
#pragma unroll
        for (int ai = 0; ai < 2; ++ai)
#pragma unroll
            for (int m = 0; m < 4; ++m) {
                bf16_t* op = ZT + (size_t)(row0 + ai * 128 + m * 16) * NTOK + col0;
#pragma unroll
                for (int bj = 0; bj < 2; ++bj) {
                    f32x4 v0 = acc[ai][bj][m][0], v1 = acc[ai][bj][m][1];
                    if (act) { v0 = gelu4(v0); v1 = gelu4(v1); }
                    *(u32x4*)(op + bj * 128) = pack8(v0, v1);
                }
            }
    }
};
template <int MODE> struct EpiRes {
    static constexpr bool PERM = true, AFTER_DRAIN = false;
    const float* res0; const float* res1; float* H; bf16_t* HB; float* sumsq; int rowbase;
    __device__ __forceinline__ void operator()(const f32x4 (&acc)[2][2][4][2], const Unit& u, int wr, int wc, int fr, int fq) const {
        const int row0 = rowbase + u.pm * 256 + wr * 64 + fr, col0 = u.pn * 256 + wc * 32 + 8 * fq;
#pragma unroll
        for (int ai = 0; ai < 2; ++ai)
#pragma unroll
            for (int m = 0; m < 4; ++m) {
                const int row = row0 + ai * 128 + m * 16;
                const size_t off = (size_t)row * DM + col0; float ss = 0.f;
#pragma unroll
                for (int bj = 0; bj < 2; ++bj) {
                    f32x4 r0, r1;
                    if (MODE == 0) { const float* rp = (row < NPROMPT ? res0 : res1) + off + bj * 128; r0 = *(const f32x4*)rp; r1 = *(const f32x4*)(rp + 4); }
                    else unpack8(*(const u32x4*)(HB + off + bj * 128), r0, r1);
                    const f32x4 v0 = acc[ai][bj][m][0] + r0, v1 = acc[ai][bj][m][1] + r1;
                    if (MODE == 2) { *(f32x4*)(H + off + bj * 128) = v0; *(f32x4*)(H + off + bj * 128 + 4) = v1; }
                    else *(u32x4*)(HB + off + bj * 128) = pack8(v0, v1);
                    ss += (v0[0] * v0[0] + v0[1] * v0[1]) + (v0[2] * v0[2] + v0[3] * v0[3]) + (v1[0] * v1[0] + v1[1] * v1[1]) + (v1[2] * v1[2] + v1[3] * v1[3]);
                }
                ss += __shfl_xor(ss, 16); ss += __shfl_xor(ss, 32);
                if (fq == 0) __hip_atomic_fetch_add(sumsq + row, ss, __ATOMIC_RELAXED, __HIP_MEMORY_SCOPE_AGENT);
                asm volatile("" ::: "memory");
            }
    }
};
struct EpiFfn1 {
    static constexpr bool PERM = true, AFTER_DRAIN = false;
    bf16_t* HID; const float* sumsq; int rowbase;
    __device__ __forceinline__ void operator()(const f32x4 (&acc)[2][2][4][2], const Unit& u, int wr, int wc, int fr, int fq) const {
        const int lrow0 = u.pm * 256 + wr * 64 + fr, col0 = u.pn * 256 + wc * 32 + 8 * fq;
#pragma unroll
        for (int ai = 0; ai < 2; ++ai)
#pragma unroll
            for (int m = 0; m < 4; ++m) {
                const int lrow = lrow0 + ai * 128 + m * 16;
                const float rs = __builtin_amdgcn_rsqf(sumsq[rowbase + lrow] * (1.0f / DM) + EPS);
                bf16_t* op = HID + (size_t)lrow * DFF + col0;
#pragma unroll
                for (int bj = 0; bj < 2; ++bj) {
                    f32x4 v0 = acc[ai][bj][m][0] * rs, v1 = acc[ai][bj][m][1] * rs;
#pragma unroll
                    for (int e = 0; e < 4; ++e) { const float a = fmaxf(v0[e], 0.f), b = fmaxf(v1[e], 0.f); v0[e] = a * a; v1[e] = b * b; }
                    *(u32x4*)(op + bj * 128) = pack8(v0, v1);
                }
                asm volatile("" ::: "memory");
            }
    }
};
struct EpiConvT {
    static constexpr bool PERM = true, AFTER_DRAIN = false;
    bf16_t* T; const float* sumsq;
    __device__ __forceinline__ void operator()(const f32x4 (&acc)[2][2][4][2], const Unit& u, int wr, int wc, int fr, int fq) const {
        const int row0 = u.pm * 256 + wr * 64 + fr, ch0 = u.pn * 128 + wc * 32 + 8 * fq;
#pragma unroll
        for (int ai = 0; ai < 2; ++ai)
#pragma unroll
            for (int m = 0; m < 4; ++m) {
                const int row = row0 + ai * 128 + m * 16;
                const float rs = __builtin_amdgcn_rsqf(sumsq[row] * (1.0f / DM) + EPS), rs2 = rs * rs;
                const f32x4 v0 = acc[ai][0][m][0] * acc[ai][1][m][0] * rs2, v1 = acc[ai][0][m][1] * acc[ai][1][m][1] * rs2;
                *(u32x4*)(T + (size_t)row * DM + ch0) = pack8(v0, v1);
                asm volatile("" ::: "memory");
            }
    }
};
struct EpiConvU {
    static constexpr bool PERM = true, AFTER_DRAIN = false;
    bf16_t* U; const bf16_t* T; const float* sumsq; const float* cw;
    __device__ __forceinline__ void operator()(const f32x4 (&acc)[2][2][4][2], const Unit& u, int wr, int wc, int fr, int fq) const {
        const int row0 = u.pm * 256 + wr * 64 + fr;
#pragma unroll
        for (int bj = 0; bj < 2; ++bj) {
            const int ch0 = u.pn * 256 + bj * 128 + wc * 32 + 8 * fq;
            const f32x4 w0a = *(const f32x4*)(cw + ch0), w0b = *(const f32x4*)(cw + ch0 + 4), w1a = *(const f32x4*)(cw + DM + ch0), w1b = *(const f32x4*)(cw + DM + ch0 + 4),
                        w2a = *(const f32x4*)(cw + 2 * DM + ch0), w2b = *(const f32x4*)(cw + 2 * DM + ch0 + 4);
#pragma unroll
            for (int ai = 0; ai < 2; ++ai)
#pragma unroll
                for (int m = 0; m < 4; ++m) {
                    const int row = row0 + ai * 128 + m * 16, pos = seqpos(row), slen = row < NPROMPT ? 4096 : 8192;
                    const float rs = __builtin_amdgcn_rsqf(sumsq[row] * (1.0f / DM) + EPS);
                    const bf16_t* tp = T + (size_t)row * DM + ch0;
                    const u32x4 z = {0u, 0u, 0u, 0u};
                    const u32x4 tc = *(const u32x4*)tp;
                    const u32x4 tl = (pos > 0) ? *(const u32x4*)(tp - DM) : z;
                    const u32x4 tn = (pos < slen - 1) ? *(const u32x4*)(tp + DM) : z;
                    f32x4 ca, cb, la, lb, na, nb; unpack8(tc, ca, cb); unpack8(tl, la, lb); unpack8(tn, na, nb);
                    const f32x4 ya = w0a * la + w1a * ca + w2a * na, yb = w0b * lb + w1b * cb + w2b * nb;
                    const f32x4 v0 = acc[ai][bj][m][0] * rs * ya, v1 = acc[ai][bj][m][1] * rs * yb;
                    *(u32x4*)(U + (size_t)row * DM + ch0) = pack8(v0, v1);
                    asm volatile("" ::: "memory");
                }
        }
    }
};

template <int MAP> __device__ __forceinline__ int orow_map(int n) {
    if (MAP == 1) { const int b = n >> 9; const int ob = (b == 0) ? 0 : (b == 1) ? 3 : (b == 2) ? 1 : (b == 3) ? 2 : 4; return ob * 512 + (n & 511); }
    if (MAP == 2) { if (n < 1024) return 2048 + n; const int hs = (n >= 2048) ? 1 : 0; const int ch = n - 1024 - hs * 1024; return (ch >> 7) * 256 + hs * 128 + (ch & 127); }
    return n;
}
template <int MAP> __device__ __forceinline__ void transpose_item(const float* W, int K, int N, bf16_t* WT, const float* gk, LAS float* scr, int item, int lane) {
    const int nblk = N / 32, kb = item / nblk, nb = item % nblk, k0 = 64 * kb, n0 = 32 * nb;
#pragma unroll 8
    for (int i = 0; i < 32; ++i) { const int kk = 2 * i + (lane >> 5); float v = W[(size_t)(k0 + kk) * N + n0 + (lane & 31)]; if (gk) v *= gk[k0 + kk]; scr[kk * 33 + (lane & 31)] = v; }
    asm volatile("s_waitcnt lgkmcnt(0)" ::: "memory");
    const int c = lane & 7; const int or0 = orow_map<MAP>(n0);
#pragma unroll
    for (int j = 0; j < 4; ++j) { const int n = (lane >> 3) + 8 * j; const LAS float* s = scr + (8 * c) * 33 + n;
        u32x4 o; o.x = cvtpk(s[0 * 33], s[1 * 33]); o.y = cvtpk(s[2 * 33], s[3 * 33]); o.z = cvtpk(s[4 * 33], s[5 * 33]); o.w = cvtpk(s[6 * 33], s[7 * 33]);
        *(u32x4*)(WT + (size_t)(or0 + n) * K + k0 + 8 * c) = o; }
    asm volatile("s_waitcnt lgkmcnt(0)" ::: "memory");
}
__device__ __forceinline__ void rms_row_to_bf16(const float* xrow, const float* g, bf16_t* orow, int lane) {
    const f32x4* xr = (const f32x4*)xrow + lane; const f32x4* gr = (const f32x4*)g + lane;
    f32x4 v[4]; float s = 0.f;
#pragma unroll
    for (int j = 0; j < 4; ++j) { v[j] = xr[64 * j]; s += (v[j][0] * v[j][0] + v[j][1] * v[j][1]) + (v[j][2] * v[j][2] + v[j][3] * v[j][3]); }
    const float rstd = 1.0f / sqrtf(wave_sum(s) * (1.0f / DM) + EPS);
    u32x2* o8 = (u32x2*)orow + lane;
#pragma unroll
    for (int j = 0; j < 4; ++j) { const f32x4 gg = gr[64 * j]; const f32x4 y = v[j] * rstd * gg; u32x2 w; w.x = cvtpk(y[0], y[1]); w.y = cvtpk(y[2], y[3]); o8[64 * j] = w; }
}

__device__ __forceinline__ int swap23(int x) { return (x & ~12) | ((x & 4) << 1) | ((x & 8) >> 1); }
__device__ __forceinline__ float half_swap_max(float v) { auto rr = __builtin_amdgcn_permlane32_swap(__float_as_uint(v), __float_as_uint(v), false, false); return fmaxf(__uint_as_float(rr[0]), __uint_as_float(rr[1])); }
__device__ __forceinline__ float half_swap_sum(float v) { auto rr = __builtin_amdgcn_permlane32_swap(__float_as_uint(v), __float_as_uint(v), false, false); return __uint_as_float(rr[0]) + __uint_as_float(rr[1]); }

#define SBAR() __builtin_amdgcn_sched_barrier(0)
#define MFMA32(a, b, c) __builtin_amdgcn_mfma_f32_32x32x16_bf16((a), (b), (c), 0, 0, 0)
__device__ __forceinline__ float max3f(float a, float b, float c) { float r; asm("v_max3_f32 %0, %1, %2, %3" : "=v"(r) : "v"(a), "v"(b), "v"(c)); return r; }
__device__ __forceinline__ void glds16(const void* gsrc, unsigned lds_dst) { unsigned keep;
    asm volatile("s_mov_b32 %0, m0\n\ts_mov_b32 m0, %2\n\ts_nop 0\n\tglobal_load_lds_dwordx4 %1, off\n\ts_mov_b32 m0, %0" : "=&s"(keep) : "v"(gsrc), "s"(lds_dst) : "memory"); }
#define WAIT_BAR(N) asm volatile("s_waitcnt vmcnt(" #N ") lgkmcnt(0)\n\ts_barrier" ::: "memory")
constexpr int ATT_STAGE = 32768;
__device__ __forceinline__ void att_step(LAS unsigned char* lds, const int t, const int NT, const int j, const int r32, const int hi, const int swz,
                                         const bf16x8 (&qr)[4], f32x16 (&o)[4], f32x16& C0, f32x16& C1, f32x16& N0, f32x16& N1, float& mrun, float& lsum,
                                         const bf16_t* const (&ksrc)[2], const bf16_t* const (&vsrc)[2], const unsigned kdma, const unsigned vdma, int& sl0, int& sl1, int& sl2) {
    const bool k3 = (t + 3 < NT), v2 = (t + 2 < NT);
    if (k3) {
#pragma unroll
        for (int i = 0; i < 2; ++i) glds16(ksrc[i] + (size_t)(t + 3) * 64 * NZA, (unsigned)__builtin_amdgcn_readfirstlane(kdma + sl0 + i * 1024));
    }
    if (v2) {
#pragma unroll
        for (int i = 0; i < 2; ++i) glds16(vsrc[i] + (t + 2) * 64, (unsigned)__builtin_amdgcn_readfirstlane(vdma + sl2 + i * 1024));
    }
    const LAS unsigned char* kb = lds + sl1 + j * 8192 + r32 * 128;
    const LAS unsigned char* vb = lds + sl0 + 16384 + r32 * 128;
#define KOFF(d0) ((((2 * (d0) + hi) ^ swz)) * 16)
#define VLD(b, jj) (*(const LAS bf16x8*)(vb + (b) * 4096 + ((((2 * (jj) + hi) ^ swz)) * 16)))
    bf16x8 ka[4][2];
#pragma unroll
    for (int d0 = 0; d0 < 4; ++d0) { ka[d0][0] = *(const LAS bf16x8*)(kb + KOFF(d0)); ka[d0][1] = *(const LAS bf16x8*)(kb + 4096 + KOFF(d0)); }
    f32x16 z;
#pragma unroll
    for (int r = 0; r < 16; ++r) z[r] = 0.f;
    SBAR();
    float ma, mb;
    N0 = MFMA32(ka[0][0], qr[0], z);
    ma = max3f(C0[0], C0[1], C0[2]); mb = max3f(C0[3], C0[4], C0[5]); ma = max3f(ma, C0[6], C0[7]); mb = max3f(mb, C0[8], C0[9]); SBAR();
    N1 = MFMA32(ka[0][1], qr[0], z);
    ma = max3f(ma, C0[10], C0[11]); mb = max3f(mb, C0[12], C0[13]); ma = max3f(ma, C0[14], C0[15]); mb = max3f(mb, C1[0], C1[1]); SBAR();
    N0 = MFMA32(ka[1][0], qr[1], N0);
    ma = max3f(ma, C1[2], C1[3]); mb = max3f(mb, C1[4], C1[5]); ma = max3f(ma, C1[6], C1[7]); mb = max3f(mb, C1[8], C1[9]); SBAR();
    N1 = MFMA32(ka[1][1], qr[1], N1);
    ma = max3f(ma, C1[10], C1[11]); mb = max3f(mb, C1[12], C1[13]); ma = max3f(ma, C1[14], C1[15]); SBAR();
    float rm = fmaxf(ma, mb);
    rm = half_swap_max(rm);
    if (__any(rm > mrun)) {
        const float mnew = fmaxf(mrun, rm), alpha = __builtin_amdgcn_exp2f(mrun - mnew);
        lsum *= alpha;
#pragma unroll
        for (int b = 0; b < 4; ++b)
#pragma unroll
            for (int r = 0; r < 16; ++r) o[b][r] *= alpha;
        mrun = mnew;
    }
    const float mr = mrun;
    float s0 = 0.f, s1 = 0.f;
    u32x4 pw[4];
    bf16x8 va[4], vn[4];
#define VQ(P, base, g, i) do { const float e0_ = __builtin_amdgcn_exp2f(P[(base) + 2 * (i)] - mr), e1_ = __builtin_amdgcn_exp2f(P[(base) + 2 * (i) + 1] - mr); s0 += e0_; s1 += e1_; asm volatile("" : "+v"(s0), "+v"(s1)); pw[g][i] = cvtpk(e0_, e1_); } while (0)
    SBAR();
#pragma unroll
    for (int b = 0; b < 4; ++b) va[b] = VLD(b, 0);
    N0 = MFMA32(ka[2][0], qr[2], N0); VQ(C0, 0, 0, 0); SBAR();
    N1 = MFMA32(ka[2][1], qr[2], N1); VQ(C0, 0, 0, 1); SBAR();
    N0 = MFMA32(ka[3][0], qr[3], N0); VQ(C0, 0, 0, 2); SBAR();
    N1 = MFMA32(ka[3][1], qr[3], N1); VQ(C0, 0, 0, 3); SBAR();
#pragma unroll
    for (int b = 0; b < 4; ++b) vn[b] = VLD(b, 1);
    { const bf16x8 pb = __builtin_bit_cast(bf16x8, pw[0]);
      o[0] = MFMA32(va[0], pb, o[0]); VQ(C0, 8, 1, 0); SBAR();
      o[1] = MFMA32(va[1], pb, o[1]); VQ(C0, 8, 1, 1); SBAR();
      o[2] = MFMA32(va[2], pb, o[2]); VQ(C0, 8, 1, 2); SBAR();
      o[3] = MFMA32(va[3], pb, o[3]); VQ(C0, 8, 1, 3); SBAR(); }
#pragma unroll
    for (int b = 0; b < 4; ++b) va[b] = VLD(b, 2);
    { const bf16x8 pb = __builtin_bit_cast(bf16x8, pw[1]);
      o[0] = MFMA32(vn[0], pb, o[0]); VQ(C1, 0, 2, 0); SBAR();
      o[1] = MFMA32(vn[1], pb, o[1]); VQ(C1, 0, 2, 1); SBAR();
      o[2] = MFMA32(vn[2], pb, o[2]); VQ(C1, 0, 2, 2); SBAR();
      o[3] = MFMA32(vn[3], pb, o[3]); VQ(C1, 0, 2, 3); SBAR(); }
#pragma unroll
    for (int b = 0; b < 4; ++b) vn[b] = VLD(b, 3);
    { const bf16x8 pb = __builtin_bit_cast(bf16x8, pw[2]);
      o[0] = MFMA32(va[0], pb, o[0]); VQ(C1, 8, 3, 0); SBAR();
      o[1] = MFMA32(va[1], pb, o[1]); VQ(C1, 8, 3, 1); SBAR();
      o[2] = MFMA32(va[2], pb, o[2]); VQ(C1, 8, 3, 2); SBAR();
      o[3] = MFMA32(va[3], pb, o[3]); VQ(C1, 8, 3, 3); SBAR(); }
    { const bf16x8 pb = __builtin_bit_cast(bf16x8, pw[3]);
      o[0] = MFMA32(vn[0], pb, o[0]);
      o[1] = MFMA32(vn[1], pb, o[1]);
      o[2] = MFMA32(vn[2], pb, o[2]);
      o[3] = MFMA32(vn[3], pb, o[3]); }
    lsum += s0 + s1;
#undef VQ
#undef KOFF
#undef VLD
    if (k3) WAIT_BAR(4); else WAIT_BAR(0);
    { const int s_ = sl0; sl0 = sl1; sl1 = sl2; sl2 = s_; }
}

__device__ __forceinline__ void attn_unit(LAS unsigned char* lds, const bf16_t* __restrict__ ZA, const bf16_t* __restrict__ ZT, bf16_t* __restrict__ CAT, const float* __restrict__ subg,
                                          float lam, int seqrow0, int slen, int h, int qb) {
    int tid_ = threadIdx.x; asm volatile("" : "+v"(tid_));
    const int tid = tid_, lane = tid & 63, r32 = lane & 31, hi = lane >> 5;
    const int wid = __builtin_amdgcn_readfirstlane(tid >> 6), j = wid >> 2, sub = wid & 3;
    const int qrow = seqrow0 + qb * 128 + sub * 32 + r32;
    bf16x8 qr[4];
#pragma unroll
    for (int d0 = 0; d0 < 4; ++d0) qr[d0] = *(const bf16x8*)(ZA + (size_t)qrow * NZA + 512 + h * 128 + j * 64 + d0 * 16 + hi * 8);
    const bf16_t* ksrc[2]; const bf16_t* vsrc[2];
#pragma unroll
    for (int i = 0; i < 2; ++i) {
        const int pc = 2 * wid + i, jj = pc >> 3, rho = (pc & 7) * 8 + (lane >> 3), cs = lane & 7, dch = cs ^ ((rho >> 1) & 7), kv = (rho & ~15) | swap23(rho & 15);
        ksrc[i] = ZA + (size_t)(seqrow0 + kv) * NZA + 1024 + h * 128 + jj * 64 + dch * 8;
        const int d = pc * 8 + (lane >> 3), vch = cs ^ ((d >> 1) & 7);
        vsrc[i] = ZT + (size_t)(512 + h * 128 + d) * NTOK + seqrow0 + vch * 8;
    }
    const unsigned lds0 = (unsigned)(uintptr_t)lds;
    const unsigned kdma = lds0 + wid * 2048, vdma = lds0 + 16384 + wid * 2048;
    const int NT = slen / 64;
    const int swz = (r32 >> 1) & 7;
#pragma unroll
    for (int i = 0; i < 2; ++i) {
        glds16(ksrc[i], (unsigned)__builtin_amdgcn_readfirstlane(kdma + i * 1024));
        glds16(vsrc[i], (unsigned)__builtin_amdgcn_readfirstlane(vdma + i * 1024));
        glds16(ksrc[i] + (size_t)64 * NZA, (unsigned)__builtin_amdgcn_readfirstlane(kdma + ATT_STAGE + i * 1024));
        glds16(vsrc[i] + 64, (unsigned)__builtin_amdgcn_readfirstlane(vdma + ATT_STAGE + i * 1024));
        glds16(ksrc[i] + (size_t)128 * NZA, (unsigned)__builtin_amdgcn_readfirstlane(kdma + 2 * ATT_STAGE + i * 1024));
    }
    WAIT_BAR(0);
    f32x16 o[4], SA0, SA1, SB0, SB1;
#pragma unroll
    for (int b = 0; b < 4; ++b)
#pragma unroll
        for (int r = 0; r < 16; ++r) o[b][r] = 0.f;
#pragma unroll
    for (int r = 0; r < 16; ++r) { SA0[r] = 0.f; SA1[r] = 0.f; }
    {
        const LAS unsigned char* kb = lds + j * 8192 + r32 * 128;
#pragma unroll
        for (int d0 = 0; d0 < 4; ++d0) {
            const int off = ((2 * d0 + hi) ^ swz) * 16;
            const bf16x8 a0 = *(const LAS bf16x8*)(kb + off), a1 = *(const LAS bf16x8*)(kb + 4096 + off);
            SA0 = MFMA32(a0, qr[d0], SA0); SA1 = MFMA32(a1, qr[d0], SA1);
        }
    }
    WAIT_BAR(0);
    float mrun = -INFINITY, lsum = 0.f;
    int sl0 = 0, sl1 = ATT_STAGE, sl2 = 2 * ATT_STAGE;
    for (int t = 0; t < NT; t += 2) {
        att_step(lds, t, NT, j, r32, hi, swz, qr, o, SA0, SA1, SB0, SB1, mrun, lsum, ksrc, vsrc, kdma, vdma, sl0, sl1, sl2);
        att_step(lds, t + 1, NT, j, r32, hi, swz, qr, o, SB0, SB1, SA0, SA1, mrun, lsum, ksrc, vsrc, kdma, vdma, sl0, sl1, sl2);
    }
    const float inv = 1.0f / half_swap_sum(lsum);
    LAS float* X = (LAS float*)lds + sub * 4096 + lane;
    if (j == 1) {
        const float f = inv * lam;
#pragma unroll
        for (int b = 0; b < 4; ++b)
#pragma unroll
            for (int r = 0; r < 16; ++r) X[(b * 16 + r) * 64] = o[b][r] * f;
    }
    __syncthreads();
    if (j == 0) {
        float ss = 0.f;
#pragma unroll
        for (int b = 0; b < 4; ++b)
#pragma unroll
            for (int r = 0; r < 16; ++r) { const float v = o[b][r] * inv - X[(b * 16 + r) * 64]; o[b][r] = v; ss += v * v; }
        ss = half_swap_sum(ss);
        const float rs = __builtin_amdgcn_rsqf(ss * (1.0f / 128.0f) + EPS) * (1.0f - LAM_INIT);
        bf16_t* op = CAT + (size_t)qrow * DM + 512 + h * 128;
#pragma unroll
        for (int b = 0; b < 4; ++b)
#pragma unroll
            for (int a = 0; a < 4; ++a) {
                const int d0 = 32 * b + 8 * a + 4 * hi; const f32x4 g = *(const f32x4*)(subg + d0);
                u32x2 w; w.x = cvtpk(o[b][4 * a] * rs * g[0], o[b][4 * a + 1] * rs * g[1]); w.y = cvtpk(o[b][4 * a + 2] * rs * g[2], o[b][4 * a + 3] * rs * g[3]);
                *(u32x2*)(op + d0) = w;
            }
    }
    __syncthreads();
}

__device__ __forceinline__ void gmlp_item(LAS unsigned char* lds, const bf16_t* __restrict__ ZA, const bf16_t* __restrict__ ZT, bf16_t* __restrict__ CAT, const float* __restrict__ Wsg,
                                          const float* __restrict__ vng, const float* __restrict__ bsg, int ck, int g) {
    int tid_ = threadIdx.x; asm volatile("" : "+v"(tid_));
    const int tid = tid_, lane = tid & 63, r32 = lane & 31, hi = lane >> 5;
    const int wid = __builtin_amdgcn_readfirstlane(tid >> 6);
    const int R0 = ck * 128;
    LAS float* red = (LAS float*)(lds + 32768); LAS float* rstd = (LAS float*)(lds + 32768 + 2048);
#pragma unroll
    for (int i = 0; i < 4; ++i) {
        const int c = tid + 512 * i, e = c >> 4, ch = c & 15;
        const u32x4 v = *(const u32x4*)(ZT + (size_t)(g * 128 + e) * NTOK + R0 + ch * 8);
        *(LAS u32x4*)(lds + e * 256 + ((ch ^ (e & 15)) * 16)) = v;
    }
    __syncthreads();
    { const int q = tid & 127, part = tid >> 7; float s = 0.f;
#pragma unroll 8
      for (int ee = 0; ee < 32; ++ee) { const int e = part * 32 + ee; const unsigned short b = *(const LAS unsigned short*)(lds + e * 256 + (((q >> 3) ^ (e & 15)) * 16) + (q & 7) * 2); const float v = __uint_as_float((unsigned)b << 16); s += v * v; }
      red[part * 128 + q] = s; }
    __syncthreads();
    if (tid < 128) rstd[tid] = __builtin_amdgcn_rsqf((red[tid] + red[128 + tid] + red[256 + tid] + red[384 + tid]) * (1.0f / 128.0f) + EPS);
    __syncthreads();
    const int eblk = wid & 3, pb0 = 2 * (wid >> 2);
    f32x16 acc[2];
#pragma unroll
    for (int r = 0; r < 16; ++r) { acc[0][r] = 0.f; acc[1][r] = 0.f; }
#pragma unroll
    for (int kk = 0; kk < 8; ++kk) {
        const bf16x8 a = *(const LAS bf16x8*)(lds + (32 * eblk + r32) * 256 + (((2 * kk + hi) ^ (r32 & 15)) * 16));
        const f32x4 ra = *(const LAS f32x4*)(rstd + 16 * kk + 8 * hi), rb = *(const LAS f32x4*)(rstd + 16 * kk + 8 * hi + 4);
#pragma unroll
        for (int pp = 0; pp < 2; ++pp) {
            const float* wp = Wsg + (size_t)(32 * (pb0 + pp) + r32) * 128 + 16 * kk + 8 * hi;
            const f32x4 wa = *(const f32x4*)wp * ra, wb = *(const f32x4*)(wp + 4) * rb;
            const bf16x8 b = __builtin_bit_cast(bf16x8, pack8(wa, wb));
            acc[pp] = __builtin_amdgcn_mfma_f32_32x32x16_bf16(a, b, acc[pp], 0, 0, 0);
        }
    }
#pragma unroll
    for (int pp = 0; pp < 2; ++pp) {
        const int p = 32 * (pb0 + pp) + r32, row = R0 + p; const float bs = bsg[p];
#pragma unroll
        for (int a4 = 0; a4 < 4; ++a4) {
            const int e0 = 32 * eblk + 8 * a4 + 4 * hi; const f32x4 gv = *(const f32x4*)(vng + e0);
            const u32x2 uu = *(const u32x2*)(ZA + (size_t)row * NZA + g * 128 + e0);
            const float o0 = bflo(uu.x) * (gv[0] * acc[pp][4 * a4] + bs), o1 = bfhi(uu.x) * (gv[1] * acc[pp][4 * a4 + 1] + bs),
                        o2 = bflo(uu.y) * (gv[2] * acc[pp][4 * a4 + 2] + bs), o3 = bfhi(uu.y) * (gv[3] * acc[pp][4 * a4 + 3] + bs);
            u32x2 w; w.x = cvtpk(o0, o1); w.y = cvtpk(o2, o3);
            *(u32x2*)(CAT + (size_t)row * DM + g * 128 + e0) = w;
        }
    }
    __syncthreads();
}

#define XB_TMO      128
#define XB_XCNT(j)  (256  + 64 * (j))
#define XB_XSUB(j)  (1280 + 64 * (j))
#define XB_XGEN(j)  (2304 + 64 * (j))
#define XB_TOP      3328
#define XB_TOPGEN   3392
#define XCD_BAR_WORDS 3456
#define XB_SPIN_CAP (1u << 18)

__device__ __forceinline__ unsigned xb_ld(unsigned* p)              { return __hip_atomic_load(p, __ATOMIC_RELAXED, __HIP_MEMORY_SCOPE_AGENT); }
__device__ __forceinline__ unsigned xb_add(unsigned* p, unsigned v) { return __hip_atomic_fetch_add(p, v, __ATOMIC_RELAXED, __HIP_MEMORY_SCOPE_AGENT); }
__device__ __forceinline__ unsigned xb_xcc_id() { return (unsigned)__builtin_amdgcn_s_getreg((3 << 11) | 20) & 0xFu; }
#define XB_SPIN(cond, bar) do { unsigned _sp = 0; while (cond) { __builtin_amdgcn_s_sleep(1); \
    if ((++_sp & 255u) == 0u) { if (xb_ld(&(bar)[XB_TMO])) break; if (_sp > XB_SPIN_CAP) { atomicAdd(&(bar)[XB_TMO], 1u); break; } } } } while (0)

struct XcdBarrier {
    unsigned* bar; unsigned x;
    volatile LAS unsigned* st;
};

__device__ __forceinline__ XcdBarrier xcd_barrier_post(unsigned* bar, volatile LAS unsigned* st) {
    XcdBarrier b; b.bar = bar; b.x = xb_xcc_id(); b.st = st;
    if (threadIdx.x == 0) (void)xb_add(&bar[XB_XCNT(b.x)], 1u);
    return b;
}
__device__ __forceinline__ void xcd_barrier_complete(unsigned* bar, unsigned x, unsigned& nloc, unsigned& nx) {
    const unsigned G = gridDim.x * gridDim.y * gridDim.z;
    unsigned sum, cnt, mine, sp = 0u;
    for (;;) {
        sum = 0u; cnt = 0u; mine = 0u;
#pragma unroll
        for (unsigned j = 0; j < 16; ++j) { const unsigned c = xb_ld(&bar[XB_XCNT(j)]); sum += c; cnt += (c > 0u) ? 1u : 0u; mine = (j == x) ? c : mine; }
        if (sum == G) break;
        __builtin_amdgcn_s_sleep(1);
        if ((++sp & 255u) == 0u) { if (xb_ld(&bar[XB_TMO])) break; if (sp > XB_SPIN_CAP) { atomicAdd(&bar[XB_TMO], 1u); break; } }
    }
    nloc = mine > 0u ? mine : 1u; nx = cnt > 0u ? cnt : 1u;
}

__device__ __forceinline__ void xcd_barrier(const XcdBarrier& b) {
    asm volatile("s_waitcnt vmcnt(0)" ::: "memory");
    __syncthreads();
    if (threadIdx.x == 0) {
        unsigned* bar = b.bar;
        __builtin_amdgcn_s_waitcnt(0);
        unsigned nloc = b.st[0], nx = b.st[1];
        if (nloc == 0u) { xcd_barrier_complete(bar, b.x, nloc, nx); b.st[0] = nloc; b.st[1] = nx; }
        const unsigned old = xb_add(&bar[XB_XSUB(b.x)], 1u);
        const unsigned gen = old / nloc;
        if (old + 1u == (gen + 1u) * nloc) {
            __builtin_amdgcn_fence(__ATOMIC_RELEASE, "agent");
            asm volatile("s_waitcnt vmcnt(0)" ::: "memory");
            const unsigned og = xb_add(&bar[XB_TOP], 1u);
            const unsigned tg = og / nx;
            if (og + 1u == (tg + 1u) * nx) xb_add(&bar[XB_TOPGEN], 1u);
            else XB_SPIN(xb_ld(&bar[XB_TOPGEN]) == tg, bar);
            __builtin_amdgcn_fence(__ATOMIC_ACQUIRE, "agent");
            xb_add(&bar[XB_XGEN(b.x)], 1u);
            asm volatile("s_waitcnt vmcnt(0)" ::: "memory");
        } else {
            XB_SPIN(xb_ld(&bar[XB_XGEN(b.x)]) == gen, bar);
            __builtin_amdgcn_fence(__ATOMIC_ACQUIRE, "agent");
            asm volatile("s_waitcnt vmcnt(0)" ::: "memory");
        }
    }
    __syncthreads();
}

#define GEMM_RUN(EPI, g, E) do { pg8::StaticOrder S_; S_.init((g).M, (g).N, G, (int)blockIdx.x); pg8::gemm_phase<EPI, pg8::StaticOrder, PG8_ALIGN, PG8_SP2>(lds, (g), S_, (E)); } while (0)
#define GRID_SYNC0() grid.sync()
#ifdef USE_CG_SYNC
#define GRID_SYNC() grid.sync()
#else
#define GRID_SYNC() xcd_barrier(bar)
#endif
#ifndef PHMASK
#define PHMASK 0xffff
#endif
#define PH(n) (((PHMASK) >> (n)) & 1)
#ifndef REP_P2
#define REP_P2 1
#endif
#ifndef REP_G
#define REP_G 1
#endif

__global__ void __launch_bounds__(512) mega_fwd(Params P) {
    extern __shared__ __attribute__((aligned(16))) unsigned char lds_raw[];
    LAS unsigned char* lds = (LAS unsigned char*)lds_raw;
    cg::grid_group grid = cg::this_grid();
    const int tid = threadIdx.x, lane = tid & 63, wave = __builtin_amdgcn_readfirstlane(tid >> 6);
    const int G = gridDim.x, bx = blockIdx.x;
    const int vcu = (G % 8 == 0) ? (bx % 8) * (G / 8) + bx / 8 : bx;
    unsigned char* ws = P.ws;
    const float* x_prompt = P.in[0]; const float* x_sample = P.in[1];
    float* sumsq = (float*)(ws + WS_SUMSQ);
    volatile LAS unsigned* MISC = (volatile LAS unsigned*)(lds + 131072 + 320);
    if (tid < 64) MISC[tid] = 0u;
    __syncthreads();
    XcdBarrier bar = xcd_barrier_post((unsigned*)(ws + WS_BAR), MISC + 8);
    bf16_t* WinT = (bf16_t*)(ws + WS_WIN); bf16_t* WoutT = (bf16_t*)(ws + WS_WOUT); bf16_t* W1T = (bf16_t*)(ws + WS_W1); bf16_t* W2T = (bf16_t*)(ws + WS_W2);
    bf16_t* CinT = (bf16_t*)(ws + WS_CIN); bf16_t* CoutT = (bf16_t*)(ws + WS_COUT); float* rope = (float*)(ws + WS_ROPE);
    bf16_t* ZT = (bf16_t*)(ws + WS_HB); bf16_t* HB = (bf16_t*)(ws + WS_HB);
    bf16_t* XN = (bf16_t*)(ws + WS_BIG); bf16_t* CAT = (bf16_t*)(ws + WS_BIG); bf16_t* HID = (bf16_t*)(ws + WS_BIG);
    bf16_t* TB = (bf16_t*)(ws + WS_BIG); bf16_t* UB = (bf16_t*)(ws + WS_BIG + 64 * MiB);
    bf16_t* ZA = (bf16_t*)P.out; float* H = P.out;

    if (PH(0)) {
        LAS float* scr = (LAS float*)(lds + wave * 16384);
        const int gw = vcu * 8 + wave, NGW = G * 8;
        constexpr int I_EIN = 16 * 80, I_EOUT = 16 * 32, I_W1 = 16 * 128, I_W2 = 64 * 32, I_CIN = 16 * 96, I_COUT = 16 * 32;
        constexpr int NITEMS = I_EIN + I_EOUT + 2 * I_W1 + 2 * I_W2 + I_CIN + I_COUT;
        for (int it = gw; it < NITEMS; it += NGW) {
            int r = it;
            if (r < I_EIN) { transpose_item<1>(P.in[6], DM, 2560, WinT, nullptr, scr, r, lane); continue; } r -= I_EIN;
            if (r < I_EOUT) { transpose_item<0>(P.in[7], DM, DM, WoutT, nullptr, scr, r, lane); continue; } r -= I_EOUT;
            if (r < I_W1) { transpose_item<0>(P.in[4], DM, DFF, W1T, P.in[3], scr, r, lane); continue; } r -= I_W1;
            if (r < I_W1) { transpose_item<0>(P.in[4] + (size_t)DM * DFF, DM, DFF, W1T + (size_t)DM * DFF, P.in[3] + DM, scr, r, lane); continue; } r -= I_W1;
            if (r < I_W2) { transpose_item<0>(P.in[5], DFF, DM, W2T, nullptr, scr, r, lane); continue; } r -= I_W2;
            if (r < I_W2) { transpose_item<0>(P.in[5] + (size_t)DM * DFF, DFF, DM, W2T + (size_t)DM * DFF, nullptr, scr, r, lane); continue; } r -= I_W2;
            if (r < I_CIN) { transpose_item<2>(P.in[16], DM, 3072, CinT, P.in[2] + DM, scr, r, lane); continue; } r -= I_CIN;
            transpose_item<0>(P.in[18], DM, DM, CoutT, nullptr, scr, r, lane);
        }
        for (int m = gw; m < NTOK; m += NGW) {
            const float* xr = (m < NPROMPT) ? x_prompt + (size_t)m * DM : x_sample + (size_t)(m - NPROMPT) * DM;
            rms_row_to_bf16(xr, P.in[2], XN + (size_t)m * DM, lane);
        }
        const int gt = vcu * 512 + tid, NGT = G * 512;
        for (int i = gt; i < 4 * NTOK; i += NGT) sumsq[i] = 0.f;
        for (int i = gt; i < 8192 * 8; i += NGT) {
            const int pos = i >> 3, fi = i & 7;
            const float inv = exp2f(-(float)fi * 0.125f * 18.931568569324174f);
            const float ang = (float)pos * inv;
            const double ad = (double)ang; const double kq = rint(ad * 0.15915494309189535); const float rr = (float)(ad - kq * 6.283185307179586);
            rope[pos * 16 + fi] = __cosf(rr); rope[pos * 16 + 8 + fi] = __sinf(rr);
        }
    }
    GRID_SYNC0();

    if (PH(1)) {
        pg8::Gemm ga{XN, WinT, NTOK, 1536, DM}; EpiA ea{ZA, rope};
        GEMM_RUN(EpiA, ga, ea);
        pg8::Gemm gb{WinT + (size_t)1536 * DM, XN, 1024, NTOK, DM}; EpiB eb{ZT};
        GEMM_RUN(EpiB, gb, eb);
    }
    GRID_SYNC();

    if (PH(2)) {
        float s1 = 0.f, s2 = 0.f;
        for (int i = 0; i < 64; ++i) { s1 += P.in[11][i] * P.in[12][i]; s2 += P.in[13][i] * P.in[14][i]; }
        const float lam = __expf(s1) - __expf(s2) + LAM_INIT;
        for (int rep_ = 0; rep_ < REP_P2; ++rep_)
        for (int k = vcu; k < 256; k += G) {
#pragma unroll 1
            for (int w = 0; w < 2; ++w) { const int idx = 2 * k + w, bh = idx >> 6, qb = idx & 63; attn_unit(lds, ZA, ZT, CAT, P.in[15], lam, NPROMPT + (bh >> 2) * 8192, 8192, bh & 3, qb); }
#pragma unroll 1
            for (int w = 0; w < 2; ++w) { const int idx = 2 * k + w, bh = idx >> 5, qb = idx & 31; attn_unit(lds, ZA, ZT, CAT, P.in[15], lam, (bh >> 2) * 4096, 4096, bh & 3, qb); }
        }
        for (int it = vcu; it < 1024; it += G) { const int ck = it >> 2, g = it & 3; gmlp_item(lds, ZA, ZT, CAT, P.in[9] + (size_t)g * 16384, P.in[8] + g * 128, P.in[10] + g * 128, ck, g); }
    }
    GRID_SYNC();

    if (PH(3)) {
        pg8::Gemm g{CAT, WoutT, NTOK, DM, DM}; EpiRes<0> e{x_prompt, x_sample - (size_t)NPROMPT * DM, H, HB, sumsq, 0};
        GEMM_RUN(EpiRes<0>, g, e);
    }
    GRID_SYNC();

#pragma unroll 1
    for (int hf = 0; hf < 2 && PH(4); ++hf) {
        if (PH(10)) { pg8::Gemm g{HB + (size_t)hf * 16384 * DM, W1T, 16384, DFF, DM}; EpiFfn1 e{HID, sumsq, hf * 16384}; GEMM_RUN(EpiFfn1, g, e); }
        GRID_SYNC();
        if (PH(11)) { pg8::Gemm g{HID, W2T, 16384, DM, DFF}; EpiRes<1> e{nullptr, nullptr, H, HB, sumsq + NTOK, hf * 16384}; GEMM_RUN(EpiRes<1>, g, e); }
        GRID_SYNC();
    }

    if (PH(5)) { pg8::Gemm g{HB, CinT, NTOK, 2048, DM}; EpiConvT e{TB, sumsq + NTOK}; GEMM_RUN(EpiConvT, g, e); }
    GRID_SYNC();
    if (PH(6)) { pg8::Gemm g{HB, CinT + (size_t)2048 * DM, NTOK, DM, DM}; EpiConvU e{UB, TB, sumsq + NTOK, P.in[17]}; GEMM_RUN(EpiConvU, g, e); }
    GRID_SYNC();
    if (PH(7)) { pg8::Gemm g{UB, CoutT, NTOK, DM, DM}; EpiRes<1> e{nullptr, nullptr, H, HB, sumsq + 2 * NTOK, 0}; GEMM_RUN(EpiRes<1>, g, e); }
    GRID_SYNC();

#pragma unroll 1
    for (int hf = 0; hf < 2 && PH(8); ++hf) {
        { pg8::Gemm g{HB + (size_t)hf * 16384 * DM, W1T + (size_t)DM * DFF, 16384, DFF, DM}; EpiFfn1 e{HID, sumsq + 2 * NTOK, hf * 16384}; GEMM_RUN(EpiFfn1, g, e); }
        GRID_SYNC();
        { pg8::Gemm g{HID, W2T + (size_t)DM * DFF, 16384, DM, DFF}; EpiRes<2> e{nullptr, nullptr, H, HB, sumsq + 3 * NTOK, hf * 16384}; GEMM_RUN(EpiRes<2>, g, e); }
        GRID_SYNC();
    }

    if (PH(9)) {
        const int gw = vcu * 8 + wave, NGW = G * 8; const float* fg = P.in[19];
        for (int m = gw; m < NTOK; m += NGW) {
            const float rs = 1.0f / sqrtf(sumsq[3 * NTOK + m] * (1.0f / DM) + EPS);
            f32x4* hr = (f32x4*)(H + (size_t)m * DM) + lane; const f32x4* gr = (const f32x4*)fg + lane;
#pragma unroll
            for (int jx = 0; jx < 4; ++jx) hr[64 * jx] = hr[64 * jx] * rs * gr[64 * jx];
        }
    }
}

extern "C" void kernel_launch(void* const* d_in, const int* in_sizes, int n_in, void* d_out, int out_size, void* d_ws, size_t ws_size, hipStream_t stream) {
    static int grid = 0;
    if (grid == 0) {
        if (n_in != 20 || out_size != NTOK * DM || ws_size < WS_END) { fprintf(stderr, "kernel_launch: unexpected shapes (n_in %d out %d ws %zu)\n", n_in, out_size, ws_size); grid = -1; return; }
        int dev = 0, cus = 0, per_cu = 0;
        hipGetDevice(&dev); hipDeviceGetAttribute(&cus, hipDeviceAttributeMultiprocessorCount, dev);
        if (hipFuncSetAttribute((const void*)mega_fwd, hipFuncAttributeMaxDynamicSharedMemorySize, LDS_BYTES) != hipSuccess) { fprintf(stderr, "kernel_launch: hipFuncSetAttribute failed\n"); grid = -1; return; }
        if (hipOccupancyMaxActiveBlocksPerMultiprocessor(&per_cu, (const void*)mega_fwd, 512, LDS_BYTES) != hipSuccess || per_cu < 1) { fprintf(stderr, "kernel_launch: occupancy query says %d\n", per_cu); per_cu = 1; }
        (void)hipGetLastError();
        grid = cus * per_cu;
    }
    if (grid < 0) return;
    if (hipMemsetAsync((char*)d_ws + WS_BAR, 0, BAR_BYTES, stream) != hipSuccess) { fprintf(stderr, "kernel_launch: memset failed\n"); return; }
    Params p{};
    for (int i = 0; i < 20; ++i) p.in[i] = (const float*)d_in[i];
    p.out = (float*)d_out; p.ws = (unsigned char*)d_ws;
    void* args[] = {&p};
    hipError_t e = hipLaunchCooperativeKernel((const void*)mega_fwd, dim3(grid), dim3(512), args, LDS_BYTES, stream);
    if (e != hipSuccess) fprintf(stderr, "kernel_launch: cooperative launch failed: %s (grid %d)\n", hipGetErrorString(e), grid);
}
```

```cpp
#include <hip/hip_runtime.h>
#include <hip/hip_cooperative_groups.h>
#include <cstdio>
#include <cstdint>
namespace cg = cooperative_groups;
namespace pg8 {
#define PG8_LAS __attribute__((address_space(3)))
typedef unsigned short bf16_t;
typedef short bf16x8 __attribute__((ext_vector_type(8)));
typedef float f32x4 __attribute__((ext_vector_type(4)));
typedef unsigned u32x4 __attribute__((ext_vector_type(4)));
constexpr int BM = 256, BK = 64, HALF = 128, HTB = HALF * BK * 2  , STAGE_BYTES = 8 * HTB, NXCD = 8, WGM = 8;

__host__ __device__ __forceinline__ int lds_byte(int r, int c) { const int st = (r >> 4) * 2 + (c >> 5), rr = r & 15, cc = c & 31, ob = rr * 64 + cc * 2; return st * 1024 + (ob ^ (((ob >> 9) & 1) << 5)); }
__host__ __device__ __forceinline__ void stage_rc(int b, int& R, int& C) { const int st = b / 1024, sb = b % 1024, swz = sb ^ (((sb >> 9) & 1) << 5); R = (st >> 1) * 16 + swz / 64; C = (st & 1) * 32 + (swz % 64) / 2; }
__host__ __device__ __forceinline__ int perm32(int rho) { const int n = rho >> 4, i = rho & 15; return 8 * (i >> 2) + 4 * n + (i & 3); }

struct Unit { int pm, pn; };
struct Gemm { const bf16_t* A; const bf16_t* Bt; int M, N, K; };

struct StaticOrder {
    int nM, nN, nwg, G, c;
    __host__ __device__ void init(int M, int N, int G_, int c_) { nM = M / BM; nN = N / BM; nwg = nM * nN; G = G_; c = c_; }
    __host__ __device__ bool next(int i, Unit& u) const {
        const long L = (long)i * G + c; if (L >= nwg) return false;
        int wgid = (int)L; { const int q = nwg / NXCD, r = nwg % NXCD, xcd = wgid % NXCD, off = wgid / NXCD; wgid = (xcd < r ? xcd * (q + 1) : r * (q + 1) + (xcd - r) * q) + off; }
        const int nig = WGM * nN, gid = wgid / nig, fm = gid * WGM, gsz = (nM - fm) < WGM ? (nM - fm) : WGM;
        u.pm = fm + ((wgid % nig) % gsz); u.pn = (wgid % nig) / gsz; return true;
    }
    __device__ __forceinline__ void a_ready(const Unit&) const {}
    __device__ __forceinline__ void done(const Unit&) const {}
};

__device__ __forceinline__ unsigned cvt_pk_bf16(float lo, float hi) { unsigned r; asm volatile("v_cvt_pk_bf16_f32 %0, %1, %2" : "=v"(r) : "v"(lo), "v"(hi)); return r; }
typedef float f32x2 __attribute__((ext_vector_type(2)));
__device__ __forceinline__ f32x2 gelu_pk(f32x2 v) {
    const f32x2 av = __builtin_elementwise_abs(v), d = av * 0.2316418882f + 1.0f;
    f32x2 t; t.x = __builtin_amdgcn_rcpf(d.x); t.y = __builtin_amdgcn_rcpf(d.y);
    f32x2 q = t * 0.5307027145f + (-0.7265760135f); q = q * t + 0.7107068705f; q = q * t + (-0.142248368f); q = q * t + 0.127414796f; q = q * t;
    const f32x2 s = (v * v) * (-0.72134752044f);
    f32x2 e; e.x = __builtin_amdgcn_exp2f(s.x); e.y = __builtin_amdgcn_exp2f(s.y);
    const f32x2 m = v * (q * e), r = v - m;
    f32x2 o; o.x = v.x < 0.f ? m.x : r.x; o.y = v.y < 0.f ? m.y : r.y; return o;
}

template <class Epi, class Sched, bool ALIGN_EPI = false, bool SP2 = false>
__device__ __forceinline__ void gemm_phase(PG8_LAS unsigned char* lds, const Gemm g, const Sched& S, const Epi& E) {
    int tid_ = threadIdx.x; asm volatile("" : "+v"(tid_));
    const int tid = tid_, wid = __builtin_amdgcn_readfirstlane(tid >> 6), lane = tid & 63, wr = wid >> 2, wc = wid & 3, fr = lane & 15, fq = lane >> 4;
    const int K = g.K, nt = K / BK;
    unsigned voffA[2], voffB[2];
#pragma unroll
    for (int i = 0; i < 2; ++i) { int R, C; stage_rc(tid * 16 + i * 8192, R, C); const int Rb = Epi::PERM ? ((R & ~31) + perm32(R & 31)) : R;
        voffA[i] = (unsigned)(R * K + C) * 2u; voffB[i] = (unsigned)(Rb * K + C) * 2u; }
    const size_t kstep = (size_t)(BK * 2);
    const size_t hstep = (size_t)HALF * K * 2;
    const size_t tstep = 2 * hstep;
    const unsigned ldsw = (unsigned)wid * 1024u;
    const int aoff = lds_byte(wr * 64 + fr, fq * 8), boff = lds_byte(wc * 32 + fr, fq * 8);
#define PG8_SA(b, h) (((b) * 2 + (h)) * HTB)
#define PG8_SB(b, h) ((4 + (b) * 2 + (h)) * HTB)
#define PG8_STAGE(bufoff, gbase, voff) do { _Pragma("unroll") for (int _i = 0; _i < 2; ++_i) \
        __builtin_amdgcn_global_load_lds((const unsigned*)((const char*)(gbase) + (voff)[_i]), (PG8_LAS unsigned*)(lds + (bufoff) + ldsw + _i * 8192), 16, 0, 0); } while (0)
#define PG8_LDA(dst, b, h) do { _Pragma("unroll") for (int m = 0; m < 4; ++m) _Pragma("unroll") for (int k = 0; k < 2; ++k) dst[m][k] = *(const PG8_LAS bf16x8*)(lds + PG8_SA(b, h) + aoff + m * 2048 + k * 1024); } while (0)
#define PG8_LDB(dst, b, h) do { _Pragma("unroll") for (int n = 0; n < 2; ++n) _Pragma("unroll") for (int k = 0; k < 2; ++k) dst[n][k] = *(const PG8_LAS bf16x8*)(lds + PG8_SB(b, h) + boff + n * 2048 + k * 1024); } while (0)
#define PG8_MMA(ai, bj, At, Bt) do { __builtin_amdgcn_s_setprio(1); _Pragma("unroll") for (int m = 0; m < 4; ++m) _Pragma("unroll") for (int n = 0; n < 2; ++n) _Pragma("unroll") for (int k = 0; k < 2; ++k) \
        acc[ai][bj][m][n] = __builtin_amdgcn_mfma_f32_16x16x32_bf16(Bt[n][k], At[m][k], acc[ai][bj][m][n], 0, 0, 0); __builtin_amdgcn_s_setprio(0); } while (0)
#define PG8_WAIT_V(n) asm volatile("s_waitcnt vmcnt(" #n ")" ::: "memory")
#define PG8_WAIT_L(n) asm volatile("s_waitcnt lgkmcnt(" #n ")" ::: "memory")
#define PG8_BAR __builtin_amdgcn_s_barrier()
#define PG8_SCHED __builtin_amdgcn_sched_barrier(0)
    Unit cur, nxt; int ui = 0;
    if (!S.next(0, cur)) return;
    f32x4 acc[2][2][4][2];
#pragma unroll
    for (int a = 0; a < 2; ++a)
#pragma unroll
        for (int b = 0; b < 2; ++b)
#pragma unroll
            for (int m = 0; m < 4; ++m)
#pragma unroll
                for (int n = 0; n < 2; ++n) acc[a][b][m][n] = (f32x4){0.f, 0.f, 0.f, 0.f};
    bf16x8 At[4][2], B0[2][2], B1[2][2];
    const char* cA = (const char*)g.A + (size_t)cur.pm * tstep; const char* cB = (const char*)g.Bt + (size_t)cur.pn * tstep;
    S.a_ready(cur);
    if constexpr (SP2) {
        PG8_STAGE(PG8_SB(0, 0), cB, voffB); PG8_STAGE(PG8_SB(0, 1), cB + hstep, voffB); PG8_STAGE(PG8_SA(0, 0), cA, voffA); PG8_STAGE(PG8_SA(0, 1), cA + hstep, voffA);
        if (wr == 1) PG8_BAR;
        PG8_WAIT_V(2); PG8_BAR;
        PG8_STAGE(PG8_SB(1, 0), cB + kstep, voffB); PG8_STAGE(PG8_SA(1, 0), cA + kstep, voffA); PG8_STAGE(PG8_SB(1, 1), cB + hstep + kstep, voffB);
        PG8_WAIT_V(6); PG8_BAR;
    } else {
        PG8_STAGE(PG8_SB(0, 0), cB, voffB); PG8_STAGE(PG8_SA(0, 0), cA, voffA); PG8_STAGE(PG8_SB(0, 1), cB + hstep, voffB); PG8_STAGE(PG8_SA(0, 1), cA + hstep, voffA);
        if (wr == 1) PG8_BAR;
        PG8_WAIT_V(4); PG8_BAR;
        PG8_STAGE(PG8_SB(1, 0), cB + kstep, voffB); PG8_STAGE(PG8_SA(1, 0), cA + kstep, voffA); PG8_STAGE(PG8_SB(1, 1), cB + hstep + kstep, voffB);
        PG8_WAIT_V(6); PG8_BAR;
    }
    for (;;) {
        const bool has_next = S.next(ui + 1, nxt);
        const char* nA = has_next ? (const char*)g.A + (size_t)nxt.pm * tstep : cA; const char* nB = has_next ? (const char*)g.Bt + (size_t)nxt.pn * tstep : cB;
        for (int t = 0; t < nt; t += 2) {
            const bool last = (t == nt - 2);
            const char* a1 = cA + (size_t)(t + 1) * kstep;
            const char* a2 = last ? nA : cA + (size_t)(t + 2) * kstep; const char* b2 = last ? nB : cB + (size_t)(t + 2) * kstep;
            const char* a3 = a2 + kstep; const char* b3 = b2 + kstep;
            if (last && has_next) S.a_ready(nxt);
            if constexpr (SP2) {
            PG8_LDB(B0, 0, 0); PG8_LDB(B1, 0, 1); PG8_SCHED; PG8_LDA(At, 0, 0); PG8_STAGE(PG8_SA(1, 1), a1 + hstep, voffA);
            PG8_WAIT_V(8); PG8_WAIT_L(0); PG8_BAR; PG8_MMA(0, 0, At, B0); PG8_MMA(0, 1, At, B1); PG8_BAR; PG8_SCHED;
            PG8_LDA(At, 0, 1); PG8_STAGE(PG8_SB(0, 0), b2, voffB); PG8_STAGE(PG8_SB(0, 1), b2 + hstep, voffB); PG8_STAGE(PG8_SA(0, 0), a2, voffA);
            PG8_WAIT_V(8); PG8_WAIT_L(0); PG8_BAR; PG8_MMA(1, 0, At, B0); PG8_MMA(1, 1, At, B1); PG8_BAR; PG8_SCHED;
            PG8_LDB(B0, 1, 0); PG8_LDB(B1, 1, 1); PG8_SCHED; PG8_LDA(At, 1, 0); PG8_STAGE(PG8_SA(0, 1), a2 + hstep, voffA);
            PG8_WAIT_V(8); PG8_WAIT_L(0); PG8_BAR; PG8_MMA(0, 0, At, B0); PG8_MMA(0, 1, At, B1); PG8_BAR; PG8_SCHED;
            PG8_LDA(At, 1, 1); PG8_STAGE(PG8_SB(1, 0), b3, voffB); PG8_STAGE(PG8_SB(1, 1), b3 + hstep, voffB); PG8_STAGE(PG8_SA(1, 0), a3, voffA);
            PG8_WAIT_V(8); PG8_WAIT_L(0); PG8_BAR; PG8_MMA(1, 0, At, B0); PG8_MMA(1, 1, At, B1); PG8_BAR; PG8_SCHED;
            } else {
            PG8_LDB(B0, 0, 0); PG8_SCHED; PG8_LDA(At, 0, 0); PG8_STAGE(PG8_SA(1, 1), a1 + hstep, voffA);
            PG8_WAIT_L(8); PG8_BAR; PG8_WAIT_L(0); PG8_MMA(0, 0, At, B0); PG8_BAR; PG8_SCHED;
            PG8_LDB(B1, 0, 1); PG8_STAGE(PG8_SB(0, 0), b2, voffB);
            PG8_BAR; PG8_WAIT_L(0); PG8_MMA(0, 1, At, B1); PG8_BAR;
            PG8_LDA(At, 0, 1); PG8_STAGE(PG8_SA(0, 0), a2, voffA);
            PG8_BAR; PG8_WAIT_L(0); PG8_MMA(1, 0, At, B0); PG8_BAR; PG8_SCHED;
            PG8_STAGE(PG8_SB(0, 1), b2 + hstep, voffB);
            PG8_WAIT_V(6); PG8_BAR; PG8_MMA(1, 1, At, B1); PG8_BAR;
            PG8_LDB(B0, 1, 0); PG8_SCHED; PG8_LDA(At, 1, 0); PG8_STAGE(PG8_SA(0, 1), a2 + hstep, voffA);
            PG8_WAIT_L(8); PG8_BAR; PG8_WAIT_L(0); PG8_MMA(0, 0, At, B0); PG8_BAR; PG8_SCHED;
            PG8_LDB(B1, 1, 1); PG8_STAGE(PG8_SB(1, 0), b3, voffB);
            PG8_BAR; PG8_WAIT_L(0); PG8_MMA(0, 1, At, B1); PG8_BAR;
            PG8_LDA(At, 1, 1); PG8_STAGE(PG8_SA(1, 0), a3, voffA);
            PG8_BAR; PG8_WAIT_L(0); PG8_MMA(1, 0, At, B0); PG8_BAR; PG8_SCHED;
            PG8_STAGE(PG8_SB(1, 1), b3 + hstep, voffB);
            PG8_WAIT_V(6); PG8_BAR; PG8_MMA(1, 1, At, B1); PG8_BAR;
            }
        }
        if constexpr (ALIGN_EPI) { if (wr == 0) PG8_BAR; }
        if constexpr (!Epi::AFTER_DRAIN) { E(acc, cur, wr, wc, fr, fq); S.done(cur); }
        if (!has_next) break;
#pragma unroll
        for (int a = 0; a < 2; ++a)
#pragma unroll
            for (int b = 0; b < 2; ++b)
#pragma unroll
                for (int m = 0; m < 4; ++m)
#pragma unroll
                    for (int n = 0; n < 2; ++n) acc[a][b][m][n] = (f32x4){0.f, 0.f, 0.f, 0.f};
        cur = nxt; cA = nA; cB = nB; ++ui;
        if constexpr (ALIGN_EPI) { if (wr == 1) PG8_BAR; }
    }
    PG8_WAIT_V(0);
    if constexpr (!ALIGN_EPI) { if (wr == 0) PG8_BAR; }
    PG8_BAR;
    if constexpr (Epi::AFTER_DRAIN) { E.fused(acc, cur, wr, wc, fr, fq, lds, wid, lane); S.done(cur); }
#undef PG8_SA
#undef PG8_SB
#undef PG8_STAGE
#undef PG8_LDA
#undef PG8_LDB
#undef PG8_MMA
#undef PG8_WAIT_V
#undef PG8_WAIT_L
#undef PG8_BAR
#undef PG8_SCHED
}
}

#ifndef PG8_SP2
#define PG8_SP2 true
#endif
#ifndef PG8_ALIGN
#define PG8_ALIGN true
#endif
#define LAS __attribute__((address_space(3)))
typedef unsigned short bf16_t;
typedef short bf16x8 __attribute__((ext_vector_type(8)));
typedef float f32x4 __attribute__((ext_vector_type(4)));
typedef float f32x16 __attribute__((ext_vector_type(16)));
typedef unsigned u32x4 __attribute__((ext_vector_type(4)));
typedef unsigned u32x2 __attribute__((ext_vector_type(2)));
using pg8::Unit;

constexpr int NTOK = 32768, NPROMPT = 16384, DM = 1024, DFF = 4096;
constexpr int NZA = 1536;
constexpr float EPS = 1e-5f;
constexpr float C2 = 0.125f * 1.4426950408889634f;
constexpr float LAM_INIT = 0.2f;
constexpr size_t MiB = 1u << 20;
constexpr size_t WS_SUMSQ = 0;
constexpr size_t WS_BAR = 512 * 1024, BAR_BYTES = 16384;
constexpr size_t WS_WIN = 1 * MiB, WS_WOUT = 6 * MiB, WS_W1 = 8 * MiB, WS_W2 = 24 * MiB, WS_CIN = 40 * MiB, WS_COUT = 46 * MiB, WS_ROPE = 48 * MiB;
constexpr size_t WS_HB = 49 * MiB;
constexpr size_t WS_BIG = 113 * MiB;
constexpr size_t WS_END = 241 * MiB;
constexpr int LDS_BYTES = 147456;

struct Params { const float* in[20]; float* out; unsigned char* ws; };

typedef float f32x2_t __attribute__((ext_vector_type(2))); typedef __bf16 bf16x2_t __attribute__((ext_vector_type(2)));
__device__ __forceinline__ unsigned cvtpk(float lo, float hi) { f32x2_t v = {lo, hi}; bf16x2_t b = __builtin_convertvector(v, bf16x2_t); return __builtin_bit_cast(unsigned, b); }
__device__ __forceinline__ u32x4 pack8(f32x4 a, f32x4 b) { u32x4 w; w.x = cvtpk(a[0], a[1]); w.y = cvtpk(a[2], a[3]); w.z = cvtpk(b[0], b[1]); w.w = cvtpk(b[2], b[3]); return w; }
__device__ __forceinline__ float bflo(unsigned x) { return __uint_as_float(x << 16); }
__device__ __forceinline__ float bfhi(unsigned x) { return __uint_as_float(x & 0xffff0000u); }
__device__ __forceinline__ void unpack8(u32x4 w, f32x4& a, f32x4& b) { a = (f32x4){bflo(w.x), bfhi(w.x), bflo(w.y), bfhi(w.y)}; b = (f32x4){bflo(w.z), bfhi(w.z), bflo(w.w), bfhi(w.w)}; }
__device__ __forceinline__ float gelu_tanh(float x) { const float t = x * (1.0f + 0.044715f * x * x); const float e = __builtin_amdgcn_exp2f(-2.302208198f * t); return x * __builtin_amdgcn_rcpf(1.0f + e); }
__device__ __forceinline__ f32x4 gelu4(f32x4 v) { return (f32x4){gelu_tanh(v[0]), gelu_tanh(v[1]), gelu_tanh(v[2]), gelu_tanh(v[3])}; }
__device__ __forceinline__ float wave_sum(float v) {
#pragma unroll
    for (int o = 1; o < 64; o <<= 1) v += __shfl_xor(v, o);
    return v;
}
__device__ __forceinline__ int seqpos(int row) { return row < NPROMPT ? (row & 4095) : (row & 8191); }

struct EpiA {
    static constexpr bool PERM = true, AFTER_DRAIN = false;
    bf16_t* ZA; const float* rope;
    __device__ __forceinline__ void operator()(const f32x4 (&acc)[2][2][4][2], const Unit& u, int wr, int wc, int fr, int fq) const {
        const int row0 = u.pm * 256 + wr * 64 + fr, kind = u.pn >> 1, col0 = u.pn * 256 + wc * 32 + 8 * fq;
        const bool ropew = (kind != 0) && ((wc & 1) == 0);
        const float sgn = (fq == 0) ? -1.f : 1.f, sc = (kind == 1) ? C2 : 1.f;
#pragma unroll
        for (int ai = 0; ai < 2; ++ai)
#pragma unroll
            for (int m = 0; m < 4; ++m) {
                const int row = row0 + ai * 128 + m * 16;
                f32x4 c0 = {1.f, 1.f, 1.f, 1.f}, c1 = c0, s0 = {0.f, 0.f, 0.f, 0.f}, s1 = s0;
                if (ropew) { const float* rp = rope + seqpos(row) * 16; c0 = *(const f32x4*)rp; c1 = *(const f32x4*)(rp + 4); s0 = *(const f32x4*)(rp + 8); s1 = *(const f32x4*)(rp + 12); }
                bf16_t* op = ZA + (size_t)row * NZA + col0;
#pragma unroll
                for (int bj = 0; bj < 2; ++bj) {
                    f32x4 v0 = acc[ai][bj][m][0], v1 = acc[ai][bj][m][1];
                    if (kind == 0) { v0 = gelu4(v0); v1 = gelu4(v1); }
                    else {
                        if (ropew) {
                            f32x4 p0, p1;
#pragma unroll
                            for (int e = 0; e < 4; ++e) { p0[e] = __shfl_xor(v0[e], 16); p1[e] = __shfl_xor(v1[e], 16); }
                            if (fq < 2) { v0 = v0 * c0 + (p0 * s0) * sgn; v1 = v1 * c1 + (p1 * s1) * sgn; }
                        }
                        v0 = v0 * sc; v1 = v1 * sc;
                    }
                    *(u32x4*)(op + bj * 128) = pack8(v0, v1);
                }
                asm volatile("" ::: "memory");
            }
    }
};
struct EpiB {
    static constexpr bool PERM = true, AFTER_DRAIN = false;
    bf16_t* ZT;
    __device__ __forceinline__ void operator()(const f32x4 (&acc)[2][2][4][2], const Unit& u, int wr, int wc, int fr, int fq) const {
        const int row0 = u.pm * 256 + wr * 64 + fr, col0 = u.pn * 256 + wc * 32 + 8 * fq; const bool act = u.pm < 2;
#pragma unroll
        for (int ai = 0; ai < 2; ++ai)
#pragma unroll
            for (int m = 0; m < 4; ++m) {
                bf16_t* op = ZT + (size_t)(row0 + ai * 128 + m * 16) * NTOK + col0;
#pragma unroll
                for (int bj = 0; bj < 2; ++bj) {
                    f32x4 v0 = acc[ai][bj][m][0], v1 = acc[ai][bj][m][1];
                    if (act) { v0 = gelu4(v0); v1 = gelu4(v1); }
                    *(u32x4*)(op + bj * 128) = pack8(v0, v1);
                }
            }
    }
};
template <int MODE> struct EpiRes {
    static constexpr bool PERM = true, AFTER_DRAIN = false;
    const float* res0; const float* res1; float* H; bf16_t* HB; float* sumsq; int rowbase;
    __device__ __forceinline__ void operator()(const f32x4 (&acc)[2][2][4][2], const Unit& u, int wr, int wc, int fr, int fq) const {
        const int row0 = rowbase + u.pm * 256 + wr * 64 + fr, col0 = u.pn * 256 + wc * 32 + 8 * fq;
#pragma unroll
        for (int ai = 0; ai < 2; ++ai)
#pragma unroll
            for (int m = 0; m < 4; ++m) {
                const int row = row0 + ai * 128 + m * 16;
                const size_t off = (size_t)row * DM + col0; float ss = 0.f;
#pragma unroll
                for (int bj = 0; bj < 2; ++bj) {
                    f32x4 r0, r1;
                    if (MODE == 0) { const float* rp = (row < NPROMPT ? res0 : res1) + off + bj * 128; r0 = *(const f32x4*)rp; r1 = *(const f32x4*)(rp + 4); }
                    else unpack8(*(const u32x4*)(HB + off + bj * 128), r0, r1);
                    const f32x4 v0 = acc[ai][bj][m][0] + r0, v1 = acc[ai][bj][m][1] + r1;
                    if (MODE == 2) { *(f32x4*)(H + off + bj * 128) = v0; *(f32x4*)(H + off + bj * 128 + 4) = v1; }
                    else *(u32x4*)(HB + off + bj * 128) = pack8(v0, v1);
                    ss += (v0[0] * v0[0] + v0[1] * v0[1]) + (v0[2] * v0[2] + v0[3] * v0[3]) + (v1[0] * v1[0] + v1[1] * v1[1]) + (v1[2] * v1[2] + v1[3] * v1[3]);
                }
                ss += __shfl_xor(ss, 16); ss += __shfl_xor(ss, 32);
                if (fq == 0) __hip_atomic_fetch_add(sumsq + row, ss, __ATOMIC_RELAXED, __HIP_MEMORY_SCOPE_AGENT);
                asm volatile("" ::: "memory");
            }
    }
};
struct EpiFfn1 {
    static constexpr bool PERM = true, AFTER_DRAIN = false;
    bf16_t* HID; const float* sumsq; int rowbase;
    __device__ __forceinline__ void operator()(const f32x4 (&acc)[2][2][4][2], const Unit& u, int wr, int wc, int fr, int fq) const {
        const int lrow0 = u.pm * 256 + wr * 64 + fr, col0 = u.pn * 256 + wc * 32 + 8 * fq;
#pragma unroll
        for (int ai = 0; ai < 2; ++ai)
#pragma unroll
            for (int m = 0; m < 4; ++m) {
                const int lrow = lrow0 + ai * 128 + m * 16;
                const float rs = __builtin_amdgcn_rsqf(sumsq[rowbase + lrow] * (1.0f / DM) + EPS);
                bf16_t* op = HID + (size_t)lrow * DFF + col0;
#pragma unroll
                for (int bj = 0; bj < 2; ++bj) {
                    f32x4 v0 = acc[ai][bj][m][0] * rs, v1 = acc[ai][bj][m][1] * rs;
#pragma unroll
                    for (int e = 0; e < 4; ++e) { const float a = fmaxf(v0[e], 0.f), b = fmaxf(v1[e], 0.f); v0[e] = a * a; v1[e] = b * b; }
                    *(u32x4*)(op + bj * 128) = pack8(v0, v1);
                }
                asm volatile("" ::: "memory");
            }
    }
};
struct EpiConvT {
    static constexpr bool PERM = true, AFTER_DRAIN = false;
    bf16_t* T; const float* sumsq;
    __device__ __forceinline__ void operator()(const f32x4 (&acc)[2][2][4][2], const Unit& u, int wr, int wc, int fr, int fq) const {
        const int row0 = u.pm * 256 + wr * 64 + fr, ch0 = u.pn * 128 + wc * 32 + 8 * fq;
#pragma unroll
        for (int ai = 0; ai < 2; ++ai)
#pragma unroll
            for (int m = 0; m < 4; ++m) {
                const int row = row0 + ai * 128 + m * 16;
                const float rs = __builtin_amdgcn_rsqf(sumsq[row] * (1.0f / DM) + EPS), rs2 = rs * rs;
                const f32x4 v0 = acc[ai][0][m][0] * acc[ai][1][m][0] * rs2, v1 = acc[ai][0][m][1] * acc[ai][1][m][1] * rs2;
                *(u32x4*)(T + (size_t)row * DM + ch0) = pack8(v0, v1);
                asm volatile("" ::: "memory");
            }
    }
};
struct EpiConvU {
    static constexpr bool PERM = true, AFTER_DRAIN = false;
    bf16_t* U; const bf16_t* T; const float* sumsq; const float* cw;
    __device__ __forceinline__ void operator()(const f32x4 (&acc)[2][2][4][2], const Unit& u, int wr, int wc, int fr, int fq) const {
        const int row0 = u.pm * 256 + wr * 64 + fr;
#pragma unroll
        for (int bj = 0; bj < 2; ++bj) {
            const int ch0 = u.pn * 256 + bj * 128 + wc * 32 + 8 * fq;
            const f32x4 w0a = *(const f32x4*)(cw + ch0), w0b = *(const f32x4*)(cw + ch0 + 4), w1a = *(const f32x4*)(cw + DM + ch0), w1b = *(const f32x4*)(cw + DM + ch0 + 4),
                        w2a = *(const f32x4*)(cw + 2 * DM + ch0), w2b = *(const f32x4*)(cw + 2 * DM + ch0 + 4);
#pragma unroll
            for (int ai = 0; ai < 2; ++ai)
#pragma unroll
                for (int m = 0; m < 4; ++m) {
                    const int row = row0 + ai * 128 + m * 16, pos = seqpos(row), slen = row < NPROMPT ? 4096 : 8192;
                    const float rs = __builtin_amdgcn_rsqf(sumsq[row] * (1.0f / DM) + EPS);
                    const bf16_t* tp = T + (size_t)row * DM + ch0;
                    const u32x4 z = {0u, 0u, 0u, 0u};
                    const u32x4 tc = *(const u32x4*)tp;
                    const u32x4 tl = (pos > 0) ? *(const u32x4*)(tp - DM) : z;
                    const u32x4 tn = (pos < slen - 1) ? *(const u32x4*)(tp + DM) : z;
                    f32x4 ca, cb, la, lb, na, nb; unpack8(tc, ca, cb); unpack8(tl, la, lb); unpack8(tn, na, nb);
                    const f32x4 ya = w0a * la + w1a * ca + w2a * na, yb = w0b * lb + w1b * cb + w2b * nb;
                    const f32x4 v0 = acc[ai][bj][m][0] * rs * ya, v1 = acc[ai][bj][m][1] * rs * yb;
                    *(u32x4*)(U + (size_t)row * DM + ch0) = pack8(v0, v1);
                    asm volatile("" ::: "memory");
                }
        }
    }
};

template <int MAP> __device__ __forceinline__ int orow_map(int n) {
    if (MAP == 1) { const int b = n >> 9; const int ob = (b == 0) ? 0 : (b == 1) ? 3 : (b == 2) ? 1 : (b == 3) ? 2 : 4; return ob * 512 + (n & 511); }
    if (MAP == 2) { if (n < 1024) return 2048 + n; const int hs = (n >= 2048) ? 1 : 0; const int ch = n - 1024 - hs * 1024; return (ch >> 7) * 256 + hs * 128 + (ch & 127); }
    return n;
}
template <int MAP> __device__ __forceinline__ void transpose_item(const float* W, int K, int N, bf16_t* WT, const float* gk, LAS float* scr, int item, int lane) {
    const int nblk = N / 32, kb = item / nblk, nb = item % nblk, k0 = 64 * kb, n0 = 32 * nb;
#pragma unroll 8
    for (int i = 0; i < 32; ++i) { const int kk = 2 * i + (lane >> 5); float v = W[(size_t)(k0 + kk) * N + n0 + (lane & 31)]; if (gk) v *= gk[k0 + kk]; scr[kk * 33 + (lane & 31)] = v; }
    asm volatile("s_waitcnt lgkmcnt(0)" ::: "memory");
    const int c = lane & 7; const int or0 = orow_map<MAP>(n0);
#pragma unroll
    for (int j = 0; j < 4; ++j) { const int n = (lane >> 3) + 8 * j; const LAS float* s = scr + (8 * c) * 33 + n;
        u32x4 o; o.x = cvtpk(s[0 * 33], s[1 * 33]); o.y = cvtpk(s[2 * 33], s[3 * 33]); o.z = cvtpk(s[4 * 33], s[5 * 33]); o.w = cvtpk(s[6 * 33], s[7 * 33]);
        *(u32x4*)(WT + (size_t)(or0 + n) * K + k0 + 8 * c) = o; }
    asm volatile("s_waitcnt lgkmcnt(0)" ::: "memory");
}
__device__ __forceinline__ void rms_row_to_bf16(const float* xrow, const float* g, bf16_t* orow, int lane) {
    const f32x4* xr = (const f32x4*)xrow + lane; const f32x4* gr = (const f32x4*)g + lane;
    f32x4 v[4]; float s = 0.f;
#pragma unroll
    for (int j = 0; j < 4; ++j) { v[j] = xr[64 * j]; s += (v[j][0] * v[j][0] + v[j][1] * v[j][1]) + (v[j][2] * v[j][2] + v[j][3] * v[j][3]); }
    const float rstd = 1.0f / sqrtf(wave_sum(s) * (1.0f / DM) + EPS);
    u32x2* o8 = (u32x2*)orow + lane;
#pragma unroll
    for (int j = 0; j < 4; ++j) { const f32x4 gg = gr[64 * j]; const f32x4 y = v[j] * rstd * gg; u32x2 w; w.x = cvtpk(y[0], y[1]); w.y = cvtpk(y[2], y[3]); o8[64 * j] = w; }
}

__device__ __forceinline__ int swap23(int x) { return (x & ~12) | ((x & 4) << 1) | ((x & 8) >> 1); }
__device__ __forceinline__ float half_swap_max(float v) { auto rr = __builtin_amdgcn_permlane32_swap(__float_as_uint(v), __float_as_uint(v), false, false); return fmaxf(__uint_as_float(rr[0]), __uint_as_float(rr[1])); }
__device__ __forceinline__ float half_swap_sum(float v) { auto rr = __builtin_amdgcn_permlane32_swap(__float_as_uint(v), __float_as_uint(v), false, false); return __uint_as_float(rr[0]) + __uint_as_float(rr[1]); }

#define SBAR() __builtin_amdgcn_sched_barrier(0)
#define MFMA32(a, b, c) __builtin_amdgcn_mfma_f32_32x32x16_bf16((a), (b), (c), 0, 0, 0)
__device__ __forceinline__ float max3f(float a, float b, float c) { float r; asm("v_max3_f32 %0, %1, %2, %3" : "=v"(r) : "v"(a), "v"(b), "v"(c)); return r; }
__device__ __forceinline__ void glds16(const void* gsrc, unsigned lds_dst) { unsigned keep;
    asm volatile("s_mov_b32 %0, m0\n\ts_mov_b32 m0, %2\n\ts_nop 0\n\tglobal_load_lds_dwordx4 %1, off\n\ts_mov_b32 m0, %0" : "=&s"(keep) : "v"(gsrc), "s"(lds_dst) : "memory"); }
#define WAIT_BAR(N) asm volatile("s_waitcnt vmcnt(" #N ") lgkmcnt(0)\n\ts_barrier" ::: "memory")
constexpr int ATT_STAGE = 32768;
__device__ __forceinline__ void att_step(LAS unsigned char* lds, const int t, const int NT, const int j, const int r32, const int hi, const int swz,
                                         const bf16x8 (&qr)[4], f32x16 (&o)[4], f32x16& C0, f32x16& C1, f32x16& N0, f32x16& N1, f32x16& negm, float& mrun, float& lsum,
                                         const bf16_t* const (&ksrc)[2], const bf16_t* const (&vsrc)[2], const unsigned kdma, const unsigned vdma, int& sl0, int& sl1, int& sl2) {
    const bool k3 = (t + 3 < NT), v2 = (t + 2 < NT);
    if (k3) {
#pragma unroll
        for (int i = 0; i < 2; ++i) glds16(ksrc[i] + (size_t)(t + 3) * 64 * NZA, (unsigned)__builtin_amdgcn_readfirstlane(kdma + sl0 + i * 1024));
    }
    if (v2) {
#pragma unroll
        for (int i = 0; i < 2; ++i) glds16(vsrc[i] + (t + 2) * 64, (unsigned)__builtin_amdgcn_readfirstlane(vdma + sl2 + i * 1024));
    }
    const LAS unsigned char* kb = lds + sl1 + j * 8192 + r32 * 128;
    const LAS unsigned char* vb = lds + sl0 + 16384 + r32 * 128;
#define KOFF(d0) ((((2 * (d0) + hi) ^ swz)) * 16)
#define VLD(b, jj) (*(const LAS bf16x8*)(vb + (b) * 4096 + ((((2 * (jj) + hi) ^ swz)) * 16)))
#ifdef PROBE_T1
#define VDUP(jj) do { _Pragma("unroll") for (int b_ = 0; b_ < 4; ++b_) { const bf16x8 d_ = *(volatile const LAS bf16x8*)(vb + b_ * 4096 + ((((2 * (jj) + hi) ^ swz)) * 16)); dsum[b_] = d_; } } while (0)
#define VUSE() asm volatile("" :: "v"(dsum[0]), "v"(dsum[1]), "v"(dsum[2]), "v"(dsum[3]))
#else
#define VDUP(jj) do {} while (0)
#define VUSE() do {} while (0)
#endif
    bf16x8 ka[4][2];
#pragma unroll
    for (int d0 = 0; d0 < 2; ++d0) { ka[d0][0] = *(const LAS bf16x8*)(kb + KOFF(d0)); ka[d0][1] = *(const LAS bf16x8*)(kb + 4096 + KOFF(d0)); }
    SBAR();
    float ma, mb;
    N0 = MFMA32(ka[0][0], qr[0], negm);
    ma = max3f(C0[0], C0[1], C0[2]); mb = max3f(C0[3], C0[4], C0[5]); ma = max3f(ma, C0[6], C0[7]); mb = max3f(mb, C0[8], C0[9]); SBAR();
    N1 = MFMA32(ka[0][1], qr[0], negm);
#pragma unroll
    for (int d0 = 2; d0 < 4; ++d0) { ka[d0][0] = *(const LAS bf16x8*)(kb + KOFF(d0)); ka[d0][1] = *(const LAS bf16x8*)(kb + 4096 + KOFF(d0)); }
    ma = max3f(ma, C0[10], C0[11]); mb = max3f(mb, C0[12], C0[13]); ma = max3f(ma, C0[14], C0[15]); mb = max3f(mb, C1[0], C1[1]); SBAR();
    N0 = MFMA32(ka[1][0], qr[1], N0);
    ma = max3f(ma, C1[2], C1[3]); mb = max3f(mb, C1[4], C1[5]); ma = max3f(ma, C1[6], C1[7]); mb = max3f(mb, C1[8], C1[9]); SBAR();
    N1 = MFMA32(ka[1][1], qr[1], N1);
    ma = max3f(ma, C1[10], C1[11]); mb = max3f(mb, C1[12], C1[13]); ma = max3f(ma, C1[14], C1[15]); SBAR();
    float rm = fmaxf(ma, mb);
    rm = half_swap_max(rm);
    if (__builtin_expect(__any(rm > 6.0f), 0)) {
        const float dm = fmaxf(rm, 0.f), alpha = __builtin_amdgcn_exp2f(-dm);
        mrun += dm; lsum *= alpha;
#pragma unroll
        for (int b = 0; b < 4; ++b)
#pragma unroll
            for (int r = 0; r < 16; ++r) o[b][r] *= alpha;
#pragma unroll
        for (int r = 0; r < 16; ++r) { C0[r] -= dm; C1[r] -= dm; N0[r] -= dm; N1[r] -= dm; negm[r] = -mrun; }
    }
    float s0 = 0.f, s1 = 0.f;
    u32x4 pw[4];
    bf16x8 va[4], vn[4];
#ifdef PROBE_T1
    bf16x8 dsum[4];
#endif
#ifdef PROBE_T2
#define XDUP(x) do { float d_ = (x); asm volatile("v_exp_f32 %0, %0" : "+v"(d_)); } while (0)
#else
#define XDUP(x) do {} while (0)
#endif
#define VQ(P, base, g, i) do { XDUP(P[(base) + 2 * (i)]); XDUP(P[(base) + 2 * (i) + 1]); const float e0_ = __builtin_amdgcn_exp2f(P[(base) + 2 * (i)]), e1_ = __builtin_amdgcn_exp2f(P[(base) + 2 * (i) + 1]); s0 += e0_; s1 += e1_; asm volatile("" : "+v"(s0), "+v"(s1)); pw[g][i] = cvtpk(e0_, e1_); } while (0)
    SBAR();
#pragma unroll
    for (int b = 0; b < 4; ++b) va[b] = VLD(b, 0);
    VDUP(0);
    N0 = MFMA32(ka[2][0], qr[2], N0); VQ(C0, 0, 0, 0); SBAR();
    N1 = MFMA32(ka[2][1], qr[2], N1); VQ(C0, 0, 0, 1); SBAR();
    N0 = MFMA32(ka[3][0], qr[3], N0); VQ(C0, 0, 0, 2); SBAR();
    N1 = MFMA32(ka[3][1], qr[3], N1); VQ(C0, 0, 0, 3); SBAR();
#pragma unroll
    for (int b = 0; b < 4; ++b) vn[b] = VLD(b, 1);
    VDUP(1);
    { const bf16x8 pb = __builtin_bit_cast(bf16x8, pw[0]);
      o[0] = MFMA32(va[0], pb, o[0]); VQ(C0, 8, 1, 0); SBAR();
      o[1] = MFMA32(va[1], pb, o[1]); VQ(C0, 8, 1, 1); SBAR();
      o[2] = MFMA32(va[2], pb, o[2]); VQ(C0, 8, 1, 2); SBAR();
      o[3] = MFMA32(va[3], pb, o[3]); VQ(C0, 8, 1, 3); SBAR(); }
#pragma unroll
    for (int b = 0; b < 4; ++b) va[b] = VLD(b, 2);
    VDUP(2);
    { const bf16x8 pb = __builtin_bit_cast(bf16x8, pw[1]);
      o[0] = MFMA32(vn[0], pb, o[0]); VQ(C1, 0, 2, 0); SBAR();
      o[1] = MFMA32(vn[1], pb, o[1]); VQ(C1, 0, 2, 1); SBAR();
      o[2] = MFMA32(vn[2], pb, o[2]); VQ(C1, 0, 2, 2); SBAR();
      o[3] = MFMA32(vn[3], pb, o[3]); VQ(C1, 0, 2, 3); SBAR(); }
#pragma unroll
    for (int b = 0; b < 4; ++b) vn[b] = VLD(b, 3);
    VDUP(3);
    { const bf16x8 pb = __builtin_bit_cast(bf16x8, pw[2]);
      o[0] = MFMA32(va[0], pb, o[0]); VQ(C1, 8, 3, 0); SBAR();
      o[1] = MFMA32(va[1], pb, o[1]); VQ(C1, 8, 3, 1); SBAR();
      o[2] = MFMA32(va[2], pb, o[2]); VQ(C1, 8, 3, 2); SBAR();
      o[3] = MFMA32(va[3], pb, o[3]); VQ(C1, 8, 3, 3); SBAR(); }
    { const bf16x8 pb = __builtin_bit_cast(bf16x8, pw[3]);
      o[0] = MFMA32(vn[0], pb, o[0]);
      o[1] = MFMA32(vn[1], pb, o[1]);
      o[2] = MFMA32(vn[2], pb, o[2]);
      o[3] = MFMA32(vn[3], pb, o[3]); }
    VUSE();
    lsum += s0 + s1;
#undef VQ
#undef KOFF
#undef VLD
    if (k3) WAIT_BAR(4); else WAIT_BAR(0);
    { const int s_ = sl0; sl0 = sl1; sl1 = sl2; sl2 = s_; }
}

__device__ __forceinline__ void attn_unit(LAS unsigned char* lds, const bf16_t* __restrict__ ZA, const bf16_t* __restrict__ ZT, bf16_t* __restrict__ CAT, const float* __restrict__ subg,
                                          float lam, int seqrow0, int slen, int h, int qb) {
    int tid_ = threadIdx.x; asm volatile("" : "+v"(tid_));
    const int tid = tid_, lane = tid & 63, r32 = lane & 31, hi = lane >> 5;
    const int wid = __builtin_amdgcn_readfirstlane(tid >> 6), j = wid >> 2, sub = wid & 3;
    const int qrow = seqrow0 + qb * 128 + sub * 32 + r32;
    bf16x8 qr[4];
#pragma unroll
    for (int d0 = 0; d0 < 4; ++d0) qr[d0] = *(const bf16x8*)(ZA + (size_t)qrow * NZA + 512 + h * 128 + j * 64 + d0 * 16 + hi * 8);
    const bf16_t* ksrc[2]; const bf16_t* vsrc[2];
#pragma unroll
    for (int i = 0; i < 2; ++i) {
        const int pc = 2 * wid + i, jj = pc >> 3, rho = (pc & 7) * 8 + (lane >> 3), cs = lane & 7, dch = cs ^ ((rho >> 1) & 7), kv = (rho & ~15) | swap23(rho & 15);
        ksrc[i] = ZA + (size_t)(seqrow0 + kv) * NZA + 1024 + h * 128 + jj * 64 + dch * 8;
        const int d = pc * 8 + (lane >> 3), vch = cs ^ ((d >> 1) & 7);
        vsrc[i] = ZT + (size_t)(512 + h * 128 + d) * NTOK + seqrow0 + vch * 8;
    }
    const unsigned lds0 = (unsigned)(uintptr_t)lds;
    const unsigned kdma = lds0 + wid * 2048, vdma = lds0 + 16384 + wid * 2048;
    const int NT = slen / 64;
    const int swz = (r32 >> 1) & 7;
#pragma unroll
    for (int i = 0; i < 2; ++i) {
        glds16(ksrc[i], (unsigned)__builtin_amdgcn_readfirstlane(kdma + i * 1024));
        glds16(vsrc[i], (unsigned)__builtin_amdgcn_readfirstlane(vdma + i * 1024));
        glds16(ksrc[i] + (size_t)64 * NZA, (unsigned)__builtin_amdgcn_readfirstlane(kdma + ATT_STAGE + i * 1024));
        glds16(vsrc[i] + 64, (unsigned)__builtin_amdgcn_readfirstlane(vdma + ATT_STAGE + i * 1024));
        glds16(ksrc[i] + (size_t)128 * NZA, (unsigned)__builtin_amdgcn_readfirstlane(kdma + 2 * ATT_STAGE + i * 1024));
    }
    WAIT_BAR(0);
    f32x16 o[4], SA0, SA1, SB0, SB1;
#pragma unroll
    for (int b = 0; b < 4; ++b)
#pragma unroll
        for (int r = 0; r < 16; ++r) o[b][r] = 0.f;
#pragma unroll
    for (int r = 0; r < 16; ++r) { SA0[r] = 0.f; SA1[r] = 0.f; }
    {
        const LAS unsigned char* kb = lds + j * 8192 + r32 * 128;
#pragma unroll
        for (int d0 = 0; d0 < 4; ++d0) {
            const int off = ((2 * d0 + hi) ^ swz) * 16;
            const bf16x8 a0 = *(const LAS bf16x8*)(kb + off), a1 = *(const LAS bf16x8*)(kb + 4096 + off);
            SA0 = MFMA32(a0, qr[d0], SA0); SA1 = MFMA32(a1, qr[d0], SA1);
        }
    }
    float mrun, lsum = 0.f; f32x16 negm;
    {
        float rm = fmaxf(SA0[0], SA1[0]);
#pragma unroll
        for (int r = 1; r < 16; ++r) rm = fmaxf(rm, fmaxf(SA0[r], SA1[r]));
        mrun = half_swap_max(rm);
#pragma unroll
        for (int r = 0; r < 16; ++r) { SA0[r] -= mrun; SA1[r] -= mrun; negm[r] = -mrun; }
    }
    asm volatile("s_nop 15\n\ts_nop 7" : "+v"(SA0), "+v"(SA1));
    WAIT_BAR(0);
    int sl0 = 0, sl1 = ATT_STAGE, sl2 = 2 * ATT_STAGE;
    for (int t = 0; t < NT; t += 2) {
        att_step(lds, t, NT, j, r32, hi, swz, qr, o, SA0, SA1, SB0, SB1, negm, mrun, lsum, ksrc, vsrc, kdma, vdma, sl0, sl1, sl2);
        att_step(lds, t + 1, NT, j, r32, hi, swz, qr, o, SB0, SB1, SA0, SA1, negm, mrun, lsum, ksrc, vsrc, kdma, vdma, sl0, sl1, sl2);
    }
    const float inv = 1.0f / half_swap_sum(lsum);
    LAS float* X = (LAS float*)lds + sub * 4096 + lane;
    if (j == 1) {
        const float f = inv * lam;
#pragma unroll
        for (int b = 0; b < 4; ++b)
#pragma unroll
            for (int r = 0; r < 16; ++r) X[(b * 16 + r) * 64] = o[b][r] * f;
    }
    __syncthreads();
    if (j == 0) {
        float ss = 0.f;
#pragma unroll
        for (int b = 0; b < 4; ++b)
#pragma unroll
            for (int r = 0; r < 16; ++r) { const float v = o[b][r] * inv - X[(b * 16 + r) * 64]; o[b][r] = v; ss += v * v; }
        ss = half_swap_sum(ss);
        const float rs = __builtin_amdgcn_rsqf(ss * (1.0f / 128.0f) + EPS) * (1.0f - LAM_INIT);
        bf16_t* op = CAT + (size_t)qrow * DM + 512 + h * 128;
#pragma unroll
        for (int b = 0; b < 4; ++b)
#pragma unroll
            for (int a = 0; a < 4; ++a) {
                const int d0 = 32 * b + 8 * a + 4 * hi; const f32x4 g = *(const f32x4*)(subg + d0);
                u32x2 w; w.x = cvtpk(o[b][4 * a] * rs * g[0], o[b][4 * a + 1] * rs * g[1]); w.y = cvtpk(o[b][4 * a + 2] * rs * g[2], o[b][4 * a + 3] * rs * g[3]);
                *(u32x2*)(op + d0) = w;
            }
    }
    __syncthreads();
}

__device__ __forceinline__ void gmlp_item(LAS unsigned char* lds, const bf16_t* __restrict__ ZA, const bf16_t* __restrict__ ZT, bf16_t* __restrict__ CAT, const float* __restrict__ Wsg,
                                          const float* __restrict__ vng, const float* __restrict__ bsg, int ck, int g) {
    int tid_ = threadIdx.x; asm volatile("" : "+v"(tid_));
    const int tid = tid_, lane = tid & 63, r32 = lane & 31, hi = lane >> 5;
    const int wid = __builtin_amdgcn_readfirstlane(tid >> 6);
    const int R0 = ck * 128;
    LAS float* red = (LAS float*)(lds + 32768); LAS float* rstd = (LAS float*)(lds + 32768 + 2048);
#pragma unroll
    for (int i = 0; i < 4; ++i) {
        const int c = tid + 512 * i, e = c >> 4, ch = c & 15;
        const u32x4 v = *(const u32x4*)(ZT + (size_t)(g * 128 + e) * NTOK + R0 + ch * 8);
        *(LAS u32x4*)(lds + e * 256 + ((ch ^ (e & 15)) * 16)) = v;
    }
    __syncthreads();
    { const int q = tid & 127, part = tid >> 7; float s = 0.f;
#pragma unroll 8
      for (int ee = 0; ee < 32; ++ee) { const int e = part * 32 + ee; const unsigned short b = *(const LAS unsigned short*)(lds + e * 256 + (((q >> 3) ^ (e & 15)) * 16) + (q & 7) * 2); const float v = __uint_as_float((unsigned)b << 16); s += v * v; }
      red[part * 128 + q] = s; }
    __syncthreads();
    if (tid < 128) rstd[tid] = __builtin_amdgcn_rsqf((red[tid] + red[128 + tid] + red[256 + tid] + red[384 + tid]) * (1.0f / 128.0f) + EPS);
    __syncthreads();
    const int eblk = wid & 3, pb0 = 2 * (wid >> 2);
    f32x16 acc[2];
#pragma unroll
    for (int r = 0; r < 16; ++r) { acc[0][r] = 0.f; acc[1][r] = 0.f; }
#pragma unroll
    for (int kk = 0; kk < 8; ++kk) {
        const bf16x8 a = *(const LAS bf16x8*)(lds + (32 * eblk + r32) * 256 + (((2 * kk + hi) ^ (r32 & 15)) * 16));
        const f32x4 ra = *(const LAS f32x4*)(rstd + 16 * kk + 8 * hi), rb = *(const LAS f32x4*)(rstd + 16 * kk + 8 * hi + 4);
#pragma unroll
        for (int pp = 0; pp < 2; ++pp) {
            const float* wp = Wsg + (size_t)(32 * (pb0 + pp) + r32) * 128 + 16 * kk + 8 * hi;
            const f32x4 wa = *(const f32x4*)wp * ra, wb = *(const f32x4*)(wp + 4) * rb;
            const bf16x8 b = __builtin_bit_cast(bf16x8, pack8(wa, wb));
            acc[pp] = __builtin_amdgcn_mfma_f32_32x32x16_bf16(a, b, acc[pp], 0, 0, 0);
        }
    }
#pragma unroll
    for (int pp = 0; pp < 2; ++pp) {
        const int p = 32 * (pb0 + pp) + r32, row = R0 + p; const float bs = bsg[p];
#pragma unroll
        for (int a4 = 0; a4 < 4; ++a4) {
            const int e0 = 32 * eblk + 8 * a4 + 4 * hi; const f32x4 gv = *(const f32x4*)(vng + e0);
            const u32x2 uu = *(const u32x2*)(ZA + (size_t)row * NZA + g * 128 + e0);
            const float o0 = bflo(uu.x) * (gv[0] * acc[pp][4 * a4] + bs), o1 = bfhi(uu.x) * (gv[1] * acc[pp][4 * a4 + 1] + bs),
                        o2 = bflo(uu.y) * (gv[2] * acc[pp][4 * a4 + 2] + bs), o3 = bfhi(uu.y) * (gv[3] * acc[pp][4 * a4 + 3] + bs);
            u32x2 w; w.x = cvtpk(o0, o1); w.y = cvtpk(o2, o3);
            *(u32x2*)(CAT + (size_t)row * DM + g * 128 + e0) = w;
        }
    }
    __syncthreads();
}

#define XB_TMO      128
#define XB_XCNT(j)  (256  + 64 * (j))
#define XB_XSUB(j)  (1280 + 64 * (j))
#define XB_XGEN(j)  (2304 + 64 * (j))
#define XB_TOP      3328
#define XB_TOPGEN   3392
#define XCD_BAR_WORDS 3456
#define XB_SPIN_CAP (1u << 18)

__device__ __forceinline__ unsigned xb_ld(unsigned* p)              { return __hip_atomic_load(p, __ATOMIC_RELAXED, __HIP_MEMORY_SCOPE_AGENT); }
__device__ __forceinline__ unsigned xb_add(unsigned* p, unsigned v) { return __hip_atomic_fetch_add(p, v, __ATOMIC_RELAXED, __HIP_MEMORY_SCOPE_AGENT); }
__device__ __forceinline__ unsigned xb_xcc_id() { return (unsigned)__builtin_amdgcn_s_getreg((3 << 11) | 20) & 0xFu; }
#define XB_SPIN(cond, bar) do { unsigned _sp = 0; while (cond) { __builtin_amdgcn_s_sleep(1); \
    if ((++_sp & 255u) == 0u) { if (xb_ld(&(bar)[XB_TMO])) break; if (_sp > XB_SPIN_CAP) { atomicAdd(&(bar)[XB_TMO], 1u); break; } } } } while (0)

struct XcdBarrier {
    unsigned* bar; unsigned x;
    volatile LAS unsigned* st;
};

__device__ __forceinline__ XcdBarrier xcd_barrier_post(unsigned* bar, volatile LAS unsigned* st) {
    XcdBarrier b; b.bar = bar; b.x = xb_xcc_id(); b.st = st;
    if (threadIdx.x == 0) (void)xb_add(&bar[XB_XCNT(b.x)], 1u);
    return b;
}
__device__ __forceinline__ void xcd_barrier_complete(unsigned* bar, unsigned x, unsigned& nloc, unsigned& nx) {
    const unsigned G = gridDim.x * gridDim.y * gridDim.z;
    unsigned sum, cnt, mine, sp = 0u;
    for (;;) {
        sum = 0u; cnt = 0u; mine = 0u;
#pragma unroll
        for (unsigned j = 0; j < 16; ++j) { const unsigned c = xb_ld(&bar[XB_XCNT(j)]); sum += c; cnt += (c > 0u) ? 1u : 0u; mine = (j == x) ? c : mine; }
        if (sum == G) break;
        __builtin_amdgcn_s_sleep(1);
        if ((++sp & 255u) == 0u) { if (xb_ld(&bar[XB_TMO])) break; if (sp > XB_SPIN_CAP) { atomicAdd(&bar[XB_TMO], 1u); break; } }
    }
    nloc = mine > 0u ? mine : 1u; nx = cnt > 0u ? cnt : 1u;
}

__device__ __forceinline__ void xcd_barrier(const XcdBarrier& b) {
    asm volatile("s_waitcnt vmcnt(0)" ::: "memory");
    __syncthreads();
    if (threadIdx.x == 0) {
        unsigned* bar = b.bar;
        __builtin_amdgcn_s_waitcnt(0);
        unsigned nloc = b.st[0], nx = b.st[1];
        if (nloc == 0u) { xcd_barrier_complete(bar, b.x, nloc, nx); b.st[0] = nloc; b.st[1] = nx; }
        const unsigned old = xb_add(&bar[XB_XSUB(b.x)], 1u);
        const unsigned gen = old / nloc;
        if (old + 1u == (gen + 1u) * nloc) {
            __builtin_amdgcn_fence(__ATOMIC_RELEASE, "agent");
            asm volatile("s_waitcnt vmcnt(0)" ::: "memory");
            const unsigned og = xb_add(&bar[XB_TOP], 1u);
            const unsigned tg = og / nx;
            if (og + 1u == (tg + 1u) * nx) xb_add(&bar[XB_TOPGEN], 1u);
            else XB_SPIN(xb_ld(&bar[XB_TOPGEN]) == tg, bar);
            __builtin_amdgcn_fence(__ATOMIC_ACQUIRE, "agent");
            xb_add(&bar[XB_XGEN(b.x)], 1u);
            asm volatile("s_waitcnt vmcnt(0)" ::: "memory");
        } else {
            XB_SPIN(xb_ld(&bar[XB_XGEN(b.x)]) == gen, bar);
            __builtin_amdgcn_fence(__ATOMIC_ACQUIRE, "agent");
            asm volatile("s_waitcnt vmcnt(0)" ::: "memory");
        }
    }
    __syncthreads();
}

#define GEMM_RUN(EPI, g, E) do { pg8::StaticOrder S_; S_.init((g).M, (g).N, G, (int)blockIdx.x); pg8::gemm_phase<EPI, pg8::StaticOrder, PG8_ALIGN, PG8_SP2>(lds, (g), S_, (E)); } while (0)
#define GRID_SYNC0() grid.sync()
#ifdef USE_CG_SYNC
#define GRID_SYNC() grid.sync()
#else
#define GRID_SYNC() xcd_barrier(bar)
#endif
#ifndef PHMASK
#define PHMASK 0xffff
#endif
#define PH(n) (((PHMASK) >> (n)) & 1)
#ifndef REP_P2
#define REP_P2 1
#endif
#ifndef REP_G
#define REP_G 1
#endif

__global__ void __launch_bounds__(512) mega_fwd(Params P) {
    extern __shared__ __attribute__((aligned(16))) unsigned char lds_raw[];
    LAS unsigned char* lds = (LAS unsigned char*)lds_raw;
    cg::grid_group grid = cg::this_grid();
    const int tid = threadIdx.x, lane = tid & 63, wave = __builtin_amdgcn_readfirstlane(tid >> 6);
    const int G = gridDim.x, bx = blockIdx.x;
    const int vcu = (G % 8 == 0) ? (bx % 8) * (G / 8) + bx / 8 : bx;
    unsigned char* ws = P.ws;
    const float* x_prompt = P.in[0]; const float* x_sample = P.in[1];
    float* sumsq = (float*)(ws + WS_SUMSQ);
    volatile LAS unsigned* MISC = (volatile LAS unsigned*)(lds + 131072 + 320);
    if (tid < 64) MISC[tid] = 0u;
    __syncthreads();
    XcdBarrier bar = xcd_barrier_post((unsigned*)(ws + WS_BAR), MISC + 8);
    bf16_t* WinT = (bf16_t*)(ws + WS_WIN); bf16_t* WoutT = (bf16_t*)(ws + WS_WOUT); bf16_t* W1T = (bf16_t*)(ws + WS_W1); bf16_t* W2T = (bf16_t*)(ws + WS_W2);
    bf16_t* CinT = (bf16_t*)(ws + WS_CIN); bf16_t* CoutT = (bf16_t*)(ws + WS_COUT); float* rope = (float*)(ws + WS_ROPE);
    bf16_t* ZT = (bf16_t*)(ws + WS_HB); bf16_t* HB = (bf16_t*)(ws + WS_HB);
    bf16_t* XN = (bf16_t*)(ws + WS_BIG); bf16_t* CAT = (bf16_t*)(ws + WS_BIG); bf16_t* HID = (bf16_t*)(ws + WS_BIG);
    bf16_t* TB = (bf16_t*)(ws + WS_BIG); bf16_t* UB = (bf16_t*)(ws + WS_BIG + 64 * MiB);
    bf16_t* ZA = (bf16_t*)P.out; float* H = P.out;

    if (PH(0)) {
        LAS float* scr = (LAS float*)(lds + wave * 16384);
        const int gw = vcu * 8 + wave, NGW = G * 8;
        constexpr int I_EIN = 16 * 80, I_EOUT = 16 * 32, I_W1 = 16 * 128, I_W2 = 64 * 32, I_CIN = 16 * 96, I_COUT = 16 * 32;
        constexpr int NITEMS = I_EIN + I_EOUT + 2 * I_W1 + 2 * I_W2 + I_CIN + I_COUT;
        for (int it = gw; it < NITEMS; it += NGW) {
            int r = it;
            if (r < I_EIN) { transpose_item<1>(P.in[6], DM, 2560, WinT, nullptr, scr, r, lane); continue; } r -= I_EIN;
            if (r < I_EOUT) { transpose_item<0>(P.in[7], DM, DM, WoutT, nullptr, scr, r, lane); continue; } r -= I_EOUT;
            if (r < I_W1) { transpose_item<0>(P.in[4], DM, DFF, W1T, P.in[3], scr, r, lane); continue; } r -= I_W1;
            if (r < I_W1) { transpose_item<0>(P.in[4] + (size_t)DM * DFF, DM, DFF, W1T + (size_t)DM * DFF, P.in[3] + DM, scr, r, lane); continue; } r -= I_W1;
            if (r < I_W2) { transpose_item<0>(P.in[5], DFF, DM, W2T, nullptr, scr, r, lane); continue; } r -= I_W2;
            if (r < I_W2) { transpose_item<0>(P.in[5] + (size_t)DM * DFF, DFF, DM, W2T + (size_t)DM * DFF, nullptr, scr, r, lane); continue; } r -= I_W2;
            if (r < I_CIN) { transpose_item<2>(P.in[16], DM, 3072, CinT, P.in[2] + DM, scr, r, lane); continue; } r -= I_CIN;
            transpose_item<0>(P.in[18], DM, DM, CoutT, nullptr, scr, r, lane);
        }
        for (int m = gw; m < NTOK; m += NGW) {
            const float* xr = (m < NPROMPT) ? x_prompt + (size_t)m * DM : x_sample + (size_t)(m - NPROMPT) * DM;
            rms_row_to_bf16(xr, P.in[2], XN + (size_t)m * DM, lane);
        }
        const int gt = vcu * 512 + tid, NGT = G * 512;
        for (int i = gt; i < 4 * NTOK; i += NGT) sumsq[i] = 0.f;
        for (int i = gt; i < 8192 * 8; i += NGT) {
            const int pos = i >> 3, fi = i & 7;
            const float inv = exp2f(-(float)fi * 0.125f * 18.931568569324174f);
            const float ang = (float)pos * inv;
            const double ad = (double)ang; const double kq = rint(ad * 0.15915494309189535); const float rr = (float)(ad - kq * 6.283185307179586);
            rope[pos * 16 + fi] = __cosf(rr); rope[pos * 16 + 8 + fi] = __sinf(rr);
        }
    }
    GRID_SYNC0();

    if (PH(1)) {
        pg8::Gemm ga{XN, WinT, NTOK, 1536, DM}; EpiA ea{ZA, rope};
        GEMM_RUN(EpiA, ga, ea);
        pg8::Gemm gb{WinT + (size_t)1536 * DM, XN, 1024, NTOK, DM}; EpiB eb{ZT};
        GEMM_RUN(EpiB, gb, eb);
    }
    GRID_SYNC();

    if (PH(2)) {
        float s1 = 0.f, s2 = 0.f;
        for (int i = 0; i < 64; ++i) { s1 += P.in[11][i] * P.in[12][i]; s2 += P.in[13][i] * P.in[14][i]; }
        const float lam = __expf(s1) - __expf(s2) + LAM_INIT;
        for (int rep_ = 0; rep_ < REP_P2; ++rep_)
        for (int k = vcu; k < 256; k += G) {
#pragma unroll 1
            for (int w = 0; w < 2; ++w) { const int idx = 2 * k + w, bh = idx >> 6, qb = idx & 63; attn_unit(lds, ZA, ZT, CAT, P.in[15], lam, NPROMPT + (bh >> 2) * 8192, 8192, bh & 3, qb); }
#pragma unroll 1
            for (int w = 0; w < 2; ++w) { const int idx = 2 * k + w, bh = idx >> 5, qb = idx & 31; attn_unit(lds, ZA, ZT, CAT, P.in[15], lam, (bh >> 2) * 4096, 4096, bh & 3, qb); }
        }
        for (int it = vcu; it < 1024; it += G) { const int ck = it >> 2, g = it & 3; gmlp_item(lds, ZA, ZT, CAT, P.in[9] + (size_t)g * 16384, P.in[8] + g * 128, P.in[10] + g * 128, ck, g); }
    }
    GRID_SYNC();

    if (PH(3)) {
        pg8::Gemm g{CAT, WoutT, NTOK, DM, DM}; EpiRes<0> e{x_prompt, x_sample - (size_t)NPROMPT * DM, H, HB, sumsq, 0};
        GEMM_RUN(EpiRes<0>, g, e);
    }
    GRID_SYNC();

#pragma unroll 1
    for (int hf = 0; hf < 2 && PH(4); ++hf) {
        if (PH(10)) { pg8::Gemm g{HB + (size_t)hf * 16384 * DM, W1T, 16384, DFF, DM}; EpiFfn1 e{HID, sumsq, hf * 16384}; GEMM_RUN(EpiFfn1, g, e); }
        GRID_SYNC();
        if (PH(11)) { pg8::Gemm g{HID, W2T, 16384, DM, DFF}; EpiRes<1> e{nullptr, nullptr, H, HB, sumsq + NTOK, hf * 16384}; GEMM_RUN(EpiRes<1>, g, e); }
        GRID_SYNC();
    }

    if (PH(5)) { pg8::Gemm g{HB, CinT, NTOK, 2048, DM}; EpiConvT e{TB, sumsq + NTOK}; GEMM_RUN(EpiConvT, g, e); }
    GRID_SYNC();
    if (PH(6)) { pg8::Gemm g{HB, CinT + (size_t)2048 * DM, NTOK, DM, DM}; EpiConvU e{UB, TB, sumsq + NTOK, P.in[17]}; GEMM_RUN(EpiConvU, g, e); }
    GRID_SYNC();
    if (PH(7)) { pg8::Gemm g{UB, CoutT, NTOK, DM, DM}; EpiRes<1> e{nullptr, nullptr, H, HB, sumsq + 2 * NTOK, 0}; GEMM_RUN(EpiRes<1>, g, e); }
    GRID_SYNC();

#pragma unroll 1
    for (int hf = 0; hf < 2 && PH(8); ++hf) {
        { pg8::Gemm g{HB + (size_t)hf * 16384 * DM, W1T + (size_t)DM * DFF, 16384, DFF, DM}; EpiFfn1 e{HID, sumsq + 2 * NTOK, hf * 16384}; GEMM_RUN(EpiFfn1, g, e); }
        GRID_SYNC();
        { pg8::Gemm g{HID, W2T + (size_t)DM * DFF, 16384, DM, DFF}; EpiRes<1> e{nullptr, nullptr, H, HB, sumsq + 3 * NTOK, hf * 16384}; GEMM_RUN(EpiRes<1>, g, e); }
        GRID_SYNC();
    }

    if (PH(9)) {
        const int gw = vcu * 8 + wave, NGW = G * 8; const float* fg = P.in[19];
        for (int m = gw; m < NTOK; m += NGW) {
            const float rs = 1.0f / sqrtf(sumsq[3 * NTOK + m] * (1.0f / DM) + EPS);
            const u32x4* br = (const u32x4*)(HB + (size_t)m * DM) + lane; float* hr = H + (size_t)m * DM + 8 * lane; const float* gr = fg + 8 * lane;
#pragma unroll
            for (int jx = 0; jx < 2; ++jx) { f32x4 a, b; unpack8(br[64 * jx], a, b);
                *(f32x4*)(hr + 512 * jx) = a * rs * *(const f32x4*)(gr + 512 * jx); *(f32x4*)(hr + 512 * jx + 4) = b * rs * *(const f32x4*)(gr + 512 * jx + 4); }
        }
    }
}

extern "C" void kernel_launch(void* const* d_in, const int* in_sizes, int n_in, void* d_out, int out_size, void* d_ws, size_t ws_size, hipStream_t stream) {
    static int grid = 0;
    if (grid == 0) {
        if (n_in != 20 || out_size != NTOK * DM || ws_size < WS_END) { fprintf(stderr, "kernel_launch: unexpected shapes (n_in %d out %d ws %zu)\n", n_in, out_size, ws_size); grid = -1; return; }
        int dev = 0, cus = 0, per_cu = 0;
        hipGetDevice(&dev); hipDeviceGetAttribute(&cus, hipDeviceAttributeMultiprocessorCount, dev);
        if (hipFuncSetAttribute((const void*)mega_fwd, hipFuncAttributeMaxDynamicSharedMemorySize, LDS_BYTES) != hipSuccess) { fprintf(stderr, "kernel_launch: hipFuncSetAttribute failed\n"); grid = -1; return; }
        if (hipOccupancyMaxActiveBlocksPerMultiprocessor(&per_cu, (const void*)mega_fwd, 512, LDS_BYTES) != hipSuccess || per_cu < 1) { fprintf(stderr, "kernel_launch: occupancy query says %d\n", per_cu); per_cu = 1; }
        (void)hipGetLastError();
        grid = cus * per_cu;
    }
    if (grid < 0) return;
    if (hipMemsetAsync((char*)d_ws + WS_BAR, 0, BAR_BYTES, stream) != hipSuccess) { fprintf(stderr, "kernel_launch: memset failed\n"); return; }
    Params p{};
    for (int i = 0; i < 20; ++i) p.in[i] = (const float*)d_in[i];
    p.out = (float*)d_out; p.ws = (unsigned char*)d_ws;
    void* args[] = {&p};
    hipError_t e = hipLaunchCooperativeKernel((const void*)mega_fwd, dim3(grid), dim3(512), args, LDS_BYTES, stream);
    if (e != hipSuccess) fprintf(stderr, "kernel_launch: cooperative launch failed: %s (grid %d)\n", hipGetErrorString(e), grid);
}
```

```cpp
#include <hip/hip_runtime.h>
#include <hip/hip_cooperative_groups.h>
#include <cstdio>
#include <cstdint>
namespace cg = cooperative_groups;
namespace pg8 {
#define PG8_LAS __attribute__((address_space(3)))
typedef unsigned short bf16_t;
typedef short bf16x8 __attribute__((ext_vector_type(8)));
typedef float f32x4 __attribute__((ext_vector_type(4)));
typedef unsigned u32x4 __attribute__((ext_vector_type(4)));
constexpr int BM = 256, BK = 64, HALF = 128, HTB = HALF * BK * 2  , STAGE_BYTES = 8 * HTB, NXCD = 8, WGM = 8;

__host__ __device__ __forceinline__ int lds_byte(int r, int c) { const int st = (r >> 4) * 2 + (c >> 5), rr = r & 15, cc = c & 31, ob = rr * 64 + cc * 2; return st * 1024 + (ob ^ (((ob >> 9) & 1) << 5)); }
__host__ __device__ __forceinline__ void stage_rc(int b, int& R, int& C) { const int st = b / 1024, sb = b % 1024, swz = sb ^ (((sb >> 9) & 1) << 5); R = (st >> 1) * 16 + swz / 64; C = (st & 1) * 32 + (swz % 64) / 2; }
__host__ __device__ __forceinline__ int perm32(int rho) { const int n = rho >> 4, i = rho & 15; return 8 * (i >> 2) + 4 * n + (i & 3); }

struct Unit { int pm, pn; };
struct Gemm { const bf16_t* A; const bf16_t* Bt; int M, N, K; };

struct StaticOrder {
    int nM, nN, nwg, G, c;
    __host__ __device__ void init(int M, int N, int G_, int c_) { nM = M / BM; nN = N / BM; nwg = nM * nN; G = G_; c = c_; }
    __host__ __device__ bool next(int i, Unit& u) const {
        const long L = (long)i * G + c; if (L >= nwg) return false;
        int wgid = (int)L; { const int q = nwg / NXCD, r = nwg % NXCD, xcd = wgid % NXCD, off = wgid / NXCD; wgid = (xcd < r ? xcd * (q + 1) : r * (q + 1) + (xcd - r) * q) + off; }
        const int nig = WGM * nN, gid = wgid / nig, fm = gid * WGM, gsz = (nM - fm) < WGM ? (nM - fm) : WGM;
        u.pm = fm + ((wgid % nig) % gsz); u.pn = (wgid % nig) / gsz; return true;
    }
    __device__ __forceinline__ void a_ready(const Unit&) const {}
    __device__ __forceinline__ void done(const Unit&) const {}
};

__device__ __forceinline__ unsigned cvt_pk_bf16(float lo, float hi) { unsigned r; asm volatile("v_cvt_pk_bf16_f32 %0, %1, %2" : "=v"(r) : "v"(lo), "v"(hi)); return r; }
typedef float f32x2 __attribute__((ext_vector_type(2)));
__device__ __forceinline__ f32x2 gelu_pk(f32x2 v) {
    const f32x2 av = __builtin_elementwise_abs(v), d = av * 0.2316418882f + 1.0f;
    f32x2 t; t.x = __builtin_amdgcn_rcpf(d.x); t.y = __builtin_amdgcn_rcpf(d.y);
    f32x2 q = t * 0.5307027145f + (-0.7265760135f); q = q * t + 0.7107068705f; q = q * t + (-0.142248368f); q = q * t + 0.127414796f; q = q * t;
    const f32x2 s = (v * v) * (-0.72134752044f);
    f32x2 e; e.x = __builtin_amdgcn_exp2f(s.x); e.y = __builtin_amdgcn_exp2f(s.y);
    const f32x2 m = v * (q * e), r = v - m;
    f32x2 o; o.x = v.x < 0.f ? m.x : r.x; o.y = v.y < 0.f ? m.y : r.y; return o;
}

template <class Epi, class Sched, bool ALIGN_EPI = false, bool SP2 = false>
__device__ __forceinline__ void gemm_phase(PG8_LAS unsigned char* lds, const Gemm g, const Sched& S, const Epi& E) {
    int tid_ = threadIdx.x; asm volatile("" : "+v"(tid_));
    const int tid = tid_, wid = __builtin_amdgcn_readfirstlane(tid >> 6), lane = tid & 63, wr = wid >> 2, wc = wid & 3, fr = lane & 15, fq = lane >> 4;
    const int K = g.K, nt = K / BK;
    unsigned voffA[2], voffB[2];
#pragma unroll
    for (int i = 0; i < 2; ++i) { int R, C; stage_rc(tid * 16 + i * 8192, R, C); const int Rb = Epi::PERM ? ((R & ~31) + perm32(R & 31)) : R;
        voffA[i] = (unsigned)(R * K + C) * 2u; voffB[i] = (unsigned)(Rb * K + C) * 2u; }
    const size_t kstep = (size_t)(BK * 2);
    const size_t hstep = (size_t)HALF * K * 2;
    const size_t tstep = 2 * hstep;
    const unsigned ldsw = (unsigned)wid * 1024u;
    const int aoff = lds_byte(wr * 64 + fr, fq * 8), boff = lds_byte(wc * 32 + fr, fq * 8);
#define PG8_SA(b, h) (((b) * 2 + (h)) * HTB)
#define PG8_SB(b, h) ((4 + (b) * 2 + (h)) * HTB)
#define PG8_STAGE(bufoff, gbase, voff) do { _Pragma("unroll") for (int _i = 0; _i < 2; ++_i) \
        __builtin_amdgcn_global_load_lds((const unsigned*)((const char*)(gbase) + (voff)[_i]), (PG8_LAS unsigned*)(lds + (bufoff) + ldsw + _i * 8192), 16, 0, 0); } while (0)
#define PG8_LDA(dst, b, h) do { _Pragma("unroll") for (int m = 0; m < 4; ++m) _Pragma("unroll") for (int k = 0; k < 2; ++k) dst[m][k] = *(const PG8_LAS bf16x8*)(lds + PG8_SA(b, h) + aoff + m * 2048 + k * 1024); } while (0)
#define PG8_LDB(dst, b, h) do { _Pragma("unroll") for (int n = 0; n < 2; ++n) _Pragma("unroll") for (int k = 0; k < 2; ++k) dst[n][k] = *(const PG8_LAS bf16x8*)(lds + PG8_SB(b, h) + boff + n * 2048 + k * 1024); } while (0)
#define PG8_MMA(ai, bj, At, Bt) do { __builtin_amdgcn_s_setprio(1); _Pragma("unroll") for (int m = 0; m < 4; ++m) _Pragma("unroll") for (int n = 0; n < 2; ++n) _Pragma("unroll") for (int k = 0; k < 2; ++k) \
        acc[ai][bj][m][n] = __builtin_amdgcn_mfma_f32_16x16x32_bf16(Bt[n][k], At[m][k], acc[ai][bj][m][n], 0, 0, 0); __builtin_amdgcn_s_setprio(0); } while (0)
#define PG8_WAIT_V(n) asm volatile("s_waitcnt vmcnt(" #n ")" ::: "memory")
#define PG8_WAIT_L(n) asm volatile("s_waitcnt lgkmcnt(" #n ")" ::: "memory")
#define PG8_BAR __builtin_amdgcn_s_barrier()
#define PG8_SCHED __builtin_amdgcn_sched_barrier(0)
    Unit cur, nxt; int ui = 0;
    if (!S.next(0, cur)) return;
    f32x4 acc[2][2][4][2];
#pragma unroll
    for (int a = 0; a < 2; ++a)
#pragma unroll
        for (int b = 0; b < 2; ++b)
#pragma unroll
            for (int m = 0; m < 4; ++m)
#pragma unroll
                for (int n = 0; n < 2; ++n) acc[a][b][m][n] = (f32x4){0.f, 0.f, 0.f, 0.f};
    bf16x8 At[4][2], B0[2][2], B1[2][2];
    const char* cA = (const char*)g.A + (size_t)cur.pm * tstep; const char* cB = (const char*)g.Bt + (size_t)cur.pn * tstep;
    S.a_ready(cur);
    if constexpr (SP2) {
        PG8_STAGE(PG8_SB(0, 0), cB, voffB); PG8_STAGE(PG8_SB(0, 1), cB + hstep, voffB); PG8_STAGE(PG8_SA(0, 0), cA, voffA); PG8_STAGE(PG8_SA(0, 1), cA + hstep, voffA);
        if (wr == 1) PG8_BAR;
        PG8_WAIT_V(2); PG8_BAR;
        PG8_STAGE(PG8_SB(1, 0), cB + kstep, voffB); PG8_STAGE(PG8_SA(1, 0), cA + kstep, voffA); PG8_STAGE(PG8_SB(1, 1), cB + hstep + kstep, voffB);
        PG8_WAIT_V(6); PG8_BAR;
    } else {
        PG8_STAGE(PG8_SB(0, 0), cB, voffB); PG8_STAGE(PG8_SA(0, 0), cA, voffA); PG8_STAGE(PG8_SB(0, 1), cB + hstep, voffB); PG8_STAGE(PG8_SA(0, 1), cA + hstep, voffA);
        if (wr == 1) PG8_BAR;
        PG8_WAIT_V(4); PG8_BAR;
        PG8_STAGE(PG8_SB(1, 0), cB + kstep, voffB); PG8_STAGE(PG8_SA(1, 0), cA + kstep, voffA); PG8_STAGE(PG8_SB(1, 1), cB + hstep + kstep, voffB);
        PG8_WAIT_V(6); PG8_BAR;
    }
    for (;;) {
        const bool has_next = S.next(ui + 1, nxt);
        const char* nA = has_next ? (const char*)g.A + (size_t)nxt.pm * tstep : cA; const char* nB = has_next ? (const char*)g.Bt + (size_t)nxt.pn * tstep : cB;
        for (int t = 0; t < nt; t += 2) {
            const bool last = (t == nt - 2);
            const char* a1 = cA + (size_t)(t + 1) * kstep;
            const char* a2 = last ? nA : cA + (size_t)(t + 2) * kstep; const char* b2 = last ? nB : cB + (size_t)(t + 2) * kstep;
            const char* a3 = a2 + kstep; const char* b3 = b2 + kstep;
            if (last && has_next) S.a_ready(nxt);
            if constexpr (SP2) {
            PG8_LDB(B0, 0, 0); PG8_LDB(B1, 0, 1); PG8_SCHED; PG8_LDA(At, 0, 0); PG8_STAGE(PG8_SA(1, 1), a1 + hstep, voffA);
            PG8_WAIT_V(8); PG8_WAIT_L(0); PG8_BAR; PG8_MMA(0, 0, At, B0); PG8_MMA(0, 1, At, B1); PG8_BAR; PG8_SCHED;
            PG8_LDA(At, 0, 1); PG8_STAGE(PG8_SB(0, 0), b2, voffB); PG8_STAGE(PG8_SB(0, 1), b2 + hstep, voffB); PG8_STAGE(PG8_SA(0, 0), a2, voffA);
            PG8_WAIT_V(8); PG8_WAIT_L(0); PG8_BAR; PG8_MMA(1, 0, At, B0); PG8_MMA(1, 1, At, B1); PG8_BAR; PG8_SCHED;
            PG8_LDB(B0, 1, 0); PG8_LDB(B1, 1, 1); PG8_SCHED; PG8_LDA(At, 1, 0); PG8_STAGE(PG8_SA(0, 1), a2 + hstep, voffA);
            PG8_WAIT_V(8); PG8_WAIT_L(0); PG8_BAR; PG8_MMA(0, 0, At, B0); PG8_MMA(0, 1, At, B1); PG8_BAR; PG8_SCHED;
            PG8_LDA(At, 1, 1); PG8_STAGE(PG8_SB(1, 0), b3, voffB); PG8_STAGE(PG8_SB(1, 1), b3 + hstep, voffB); PG8_STAGE(PG8_SA(1, 0), a3, voffA);
            PG8_WAIT_V(8); PG8_WAIT_L(0); PG8_BAR; PG8_MMA(1, 0, At, B0); PG8_MMA(1, 1, At, B1); PG8_BAR; PG8_SCHED;
            } else {
            PG8_LDB(B0, 0, 0); PG8_SCHED; PG8_LDA(At, 0, 0); PG8_STAGE(PG8_SA(1, 1), a1 + hstep, voffA);
            PG8_WAIT_L(8); PG8_BAR; PG8_WAIT_L(0); PG8_MMA(0, 0, At, B0); PG8_BAR; PG8_SCHED;
            PG8_LDB(B1, 0, 1); PG8_STAGE(PG8_SB(0, 0), b2, voffB);
            PG8_BAR; PG8_WAIT_L(0); PG8_MMA(0, 1, At, B1); PG8_BAR;
            PG8_LDA(At, 0, 1); PG8_STAGE(PG8_SA(0, 0), a2, voffA);
            PG8_BAR; PG8_WAIT_L(0); PG8_MMA(1, 0, At, B0); PG8_BAR; PG8_SCHED;
            PG8_STAGE(PG8_SB(0, 1), b2 + hstep, voffB);
            PG8_WAIT_V(6); PG8_BAR; PG8_MMA(1, 1, At, B1); PG8_BAR;
            PG8_LDB(B0, 1, 0); PG8_SCHED; PG8_LDA(At, 1, 0); PG8_STAGE(PG8_SA(0, 1), a2 + hstep, voffA);
            PG8_WAIT_L(8); PG8_BAR; PG8_WAIT_L(0); PG8_MMA(0, 0, At, B0); PG8_BAR; PG8_SCHED;
            PG8_LDB(B1, 1, 1); PG8_STAGE(PG8_SB(1, 0), b3, voffB);
            PG8_BAR; PG8_WAIT_L(0); PG8_MMA(0, 1, At, B1); PG8_BAR;
            PG8_LDA(At, 1, 1); PG8_STAGE(PG8_SA(1, 0), a3, voffA);
            PG8_BAR; PG8_WAIT_L(0); PG8_MMA(1, 0, At, B0); PG8_BAR; PG8_SCHED;
            PG8_STAGE(PG8_SB(1, 1), b3 + hstep, voffB);
            PG8_WAIT_V(6); PG8_BAR; PG8_MMA(1, 1, At, B1); PG8_BAR;
            }
        }
        if constexpr (ALIGN_EPI) { if (wr == 0) PG8_BAR; }
        if constexpr (!Epi::AFTER_DRAIN) { E(acc, cur, wr, wc, fr, fq); S.done(cur); }
        if (!has_next) break;
#pragma unroll
        for (int a = 0; a < 2; ++a)
#pragma unroll
            for (int b = 0; b < 2; ++b)
#pragma unroll
                for (int m = 0; m < 4; ++m)
#pragma unroll
                    for (int n = 0; n < 2; ++n) acc[a][b][m][n] = (f32x4){0.f, 0.f, 0.f, 0.f};
        cur = nxt; cA = nA; cB = nB; ++ui;
        if constexpr (ALIGN_EPI) { if (wr == 1) PG8_BAR; }
    }
    PG8_WAIT_V(0);
    if constexpr (!ALIGN_EPI) { if (wr == 0) PG8_BAR; }
    PG8_BAR;
    if constexpr (Epi::AFTER_DRAIN) { E.fused(acc, cur, wr, wc, fr, fq, lds, wid, lane); S.done(cur); }
#undef PG8_SA
#undef PG8_SB
#undef PG8_STAGE
#undef PG8_LDA
#undef PG8_LDB
#undef PG8_MMA
#undef PG8_WAIT_V
#undef PG8_WAIT_L
#undef PG8_BAR
#undef PG8_SCHED
}
}

#ifndef PG8_SP2
#define PG8_SP2 true
#endif
#ifndef PG8_ALIGN
#define PG8_ALIGN true
#endif
#define LAS __attribute__((address_space(3)))
typedef unsigned short bf16_t;
typedef short bf16x8 __attribute__((ext_vector_type(8)));
typedef float f32x4 __attribute__((ext_vector_type(4)));
typedef float f32x16 __attribute__((ext_vector_type(16)));
typedef unsigned u32x4 __attribute__((ext_vector_type(4)));
typedef unsigned u32x2 __attribute__((ext_vector_type(2)));
using pg8::Unit;

constexpr int NTOK = 32768, NPROMPT = 16384, DM = 1024, DFF = 4096;
constexpr int NZA = 1536;
constexpr float EPS = 1e-5f;
constexpr float C2 = 0.125f * 1.4426950408889634f;
constexpr float LAM_INIT = 0.2f;
constexpr size_t MiB = 1u << 20;
constexpr size_t WS_SUMSQ = 0;
constexpr size_t WS_BAR = 512 * 1024, BAR_BYTES = 16384;
constexpr size_t WS_WIN = 1 * MiB, WS_WOUT = 6 * MiB, WS_W1 = 8 * MiB, WS_W2 = 24 * MiB, WS_CIN = 40 * MiB, WS_COUT = 46 * MiB, WS_ROPE = 48 * MiB;
constexpr size_t WS_HB = 49 * MiB;
constexpr size_t WS_BIG = 113 * MiB;
constexpr size_t WS_END = 241 * MiB;
constexpr int LDS_BYTES = 147456;

struct Params { const float* in[20]; float* out; unsigned char* ws; };

typedef float f32x2_t __attribute__((ext_vector_type(2))); typedef __bf16 bf16x2_t __attribute__((ext_vector_type(2)));
__device__ __forceinline__ unsigned cvtpk(float lo, float hi) { f32x2_t v = {lo, hi}; bf16x2_t b = __builtin_convertvector(v, bf16x2_t); return __builtin_bit_cast(unsigned, b); }
__device__ __forceinline__ u32x4 pack8(f32x4 a, f32x4 b) { u32x4 w; w.x = cvtpk(a[0], a[1]); w.y = cvtpk(a[2], a[3]); w.z = cvtpk(b[0], b[1]); w.w = cvtpk(b[2], b[3]); return w; }
__device__ __forceinline__ float bflo(unsigned x) { return __uint_as_float(x << 16); }
__device__ __forceinline__ float bfhi(unsigned x) { return __uint_as_float(x & 0xffff0000u); }
__device__ __forceinline__ void unpack8(u32x4 w, f32x4& a, f32x4& b) { a = (f32x4){bflo(w.x), bfhi(w.x), bflo(w.y), bfhi(w.y)}; b = (f32x4){bflo(w.z), bfhi(w.z), bflo(w.w), bfhi(w.w)}; }
__device__ __forceinline__ float gelu_tanh(float x) { const float t = x * (1.0f + 0.044715f * x * x); const float e = __builtin_amdgcn_exp2f(-2.302208198f * t); return x * __builtin_amdgcn_rcpf(1.0f + e); }
__device__ __forceinline__ f32x4 gelu4(f32x4 v) { return (f32x4){gelu_tanh(v[0]), gelu_tanh(v[1]), gelu_tanh(v[2]), gelu_tanh(v[3])}; }
__device__ __forceinline__ float wave_sum(float v) {
#pragma unroll
    for (int o = 1; o < 64; o <<= 1) v += __shfl_xor(v, o);
    return v;
}
__device__ __forceinline__ int seqpos(int row) { return row < NPROMPT ? (row & 4095) : (row & 8191); }

struct EpiA {
    static constexpr bool PERM = true, AFTER_DRAIN = false;
    bf16_t* ZA; const float* rope;
    __device__ __forceinline__ void operator()(const f32x4 (&acc)[2][2][4][2], const Unit& u, int wr, int wc, int fr, int fq) const {
        const int row0 = u.pm * 256 + wr * 64 + fr, kind = u.pn >> 1, col0 = u.pn * 256 + wc * 32 + 8 * fq;
        const bool ropew = (kind != 0) && ((wc & 1) == 0);
        const float sgn = (fq == 0) ? -1.f : 1.f, sc = (kind == 1) ? C2 : 1.f;
#pragma unroll
        for (int ai = 0; ai < 2; ++ai)
#pragma unroll
            for (int m = 0; m < 4; ++m) {
                const int row = row0 + ai * 128 + m * 16;
                f32x4 c0 = {1.f, 1.f, 1.f, 1.f}, c1 = c0, s0 = {0.f, 0.f, 0.f, 0.f}, s1 = s0;
                if (ropew) { const float* rp = rope + seqpos(row) * 16; c0 = *(const f32x4*)rp; c1 = *(const f32x4*)(rp + 4); s0 = *(const f32x4*)(rp + 8); s1 = *(const f32x4*)(rp + 12); }
                bf16_t* op = ZA + (size_t)row * NZA + col0;
#pragma unroll
                for (int bj = 0; bj < 2; ++bj) {
                    f32x4 v0 = acc[ai][bj][m][0], v1 = acc[ai][bj][m][1];
                    if (kind == 0) { v0 = gelu4(v0); v1 = gelu4(v1); }
                    else {
                        if (ropew) {
                            f32x4 p0, p1;
#pragma unroll
                            for (int e = 0; e < 4; ++e) { p0[e] = __shfl_xor(v0[e], 16); p1[e] = __shfl_xor(v1[e], 16); }
                            if (fq < 2) { v0 = v0 * c0 + (p0 * s0) * sgn; v1 = v1 * c1 + (p1 * s1) * sgn; }
                        }
                        v0 = v0 * sc; v1 = v1 * sc;
                    }
                    *(u32x4*)(op + bj * 128) = pack8(v0, v1);
                }
                asm volatile("" ::: "memory");
            }
    }
};
struct EpiB {
    static constexpr bool PERM = true, AFTER_DRAIN = false;
    bf16_t* ZT;
    __device__ __forceinline__ void operator()(const f32x4 (&acc)[2][2][4][2], const Unit& u, int wr, int wc, int fr, int fq) const {
        const int row0 = u.pm * 256 + wr * 64 + fr, col0 = u.pn * 256 + wc * 32 + 8 * fq; const bool act = u.pm < 2;
#pragma unroll
        for (int ai = 0; ai < 2; ++ai)
#pragma unroll
            for (int m = 0; m < 4; ++m) {
                bf16_t* op = ZT + (size_t)(row0 + ai * 128 + m * 16) * NTOK + col0;
#pragma unroll
                for (int bj = 0; bj < 2; ++bj) {
                    f32x4 v0 = acc[ai][bj][m][0], v1 = acc[ai][bj][m][1];
                    if (act) { v0 = gelu4(v0); v1 = gelu4(v1); }
                    *(u32x4*)(op + bj * 128) = pack8(v0, v1);
                }
            }
    }
};
template <int MODE> struct EpiRes {
    static constexpr bool PERM = true, AFTER_DRAIN = false;
    const float* res0; const float* res1; float* H; bf16_t* HB; float* sumsq; int rowbase;
    __device__ __forceinline__ void operator()(const f32x4 (&acc)[2][2][4][2], const Unit& u, int wr, int wc, int fr, int fq) const {
        const int row0 = rowbase + u.pm * 256 + wr * 64 + fr, col0 = u.pn * 256 + wc * 32 + 8 * fq;
#pragma unroll
        for (int ai = 0; ai < 2; ++ai)
#pragma unroll
            for (int m = 0; m < 4; ++m) {
                const int row = row0 + ai * 128 + m * 16;
                const size_t off = (size_t)row * DM + col0; float ss = 0.f;
#pragma unroll
                for (int bj = 0; bj < 2; ++bj) {
                    f32x4 r0, r1;
                    if (MODE == 0) { const float* rp = (row < NPROMPT ? res0 : res1) + off + bj * 128; r0 = *(const f32x4*)rp; r1 = *(const f32x4*)(rp + 4); }
                    else unpack8(*(const u32x4*)(HB + off + bj * 128), r0, r1);
                    const f32x4 v0 = acc[ai][bj][m][0] + r0, v1 = acc[ai][bj][m][1] + r1;
                    if (MODE == 2) { *(f32x4*)(H + off + bj * 128) = v0; *(f32x4*)(H + off + bj * 128 + 4) = v1; }
                    else *(u32x4*)(HB + off + bj * 128) = pack8(v0, v1);
                    ss += (v0[0] * v0[0] + v0[1] * v0[1]) + (v0[2] * v0[2] + v0[3] * v0[3]) + (v1[0] * v1[0] + v1[1] * v1[1]) + (v1[2] * v1[2] + v1[3] * v1[3]);
                }
                ss += __shfl_xor(ss, 16); ss += __shfl_xor(ss, 32);
                if (fq == 0) __hip_atomic_fetch_add(sumsq + row, ss, __ATOMIC_RELAXED, __HIP_MEMORY_SCOPE_AGENT);
                asm volatile("" ::: "memory");
            }
    }
};
struct EpiFfn1 {
    static constexpr bool PERM = true, AFTER_DRAIN = false;
    bf16_t* HID; const float* sumsq; int rowbase;
    __device__ __forceinline__ void operator()(const f32x4 (&acc)[2][2][4][2], const Unit& u, int wr, int wc, int fr, int fq) const {
        const int lrow0 = u.pm * 256 + wr * 64 + fr, col0 = u.pn * 256 + wc * 32 + 8 * fq;
#pragma unroll
        for (int ai = 0; ai < 2; ++ai)
#pragma unroll
            for (int m = 0; m < 4; ++m) {
                const int lrow = lrow0 + ai * 128 + m * 16;
                const float rs = __builtin_amdgcn_rsqf(sumsq[rowbase + lrow] * (1.0f / DM) + EPS);
                bf16_t* op = HID + (size_t)lrow * DFF + col0;
#pragma unroll
                for (int bj = 0; bj < 2; ++bj) {
                    f32x4 v0 = acc[ai][bj][m][0] * rs, v1 = acc[ai][bj][m][1] * rs;
#pragma unroll
                    for (int e = 0; e < 4; ++e) { const float a = fmaxf(v0[e], 0.f), b = fmaxf(v1[e], 0.f); v0[e] = a * a; v1[e] = b * b; }
                    *(u32x4*)(op + bj * 128) = pack8(v0, v1);
                }
                asm volatile("" ::: "memory");
            }
    }
};
struct EpiConvT {
    static constexpr bool PERM = true, AFTER_DRAIN = false;
    bf16_t* T; const float* sumsq;
    __device__ __forceinline__ void operator()(const f32x4 (&acc)[2][2][4][2], const Unit& u, int wr, int wc, int fr, int fq) const {
        const int row0 = u.pm * 256 + wr * 64 + fr, ch0 = u.pn * 128 + wc * 32 + 8 * fq;
#pragma unroll
        for (int ai = 0; ai < 2; ++ai)
#pragma unroll
            for (int m = 0; m < 4; ++m) {
                const int row = row0 + ai * 128 + m * 16;
                const float rs = __builtin_amdgcn_rsqf(sumsq[row] * (1.0f / DM) + EPS), rs2 = rs * rs;
                const f32x4 v0 = acc[ai][0][m][0] * acc[ai][1][m][0] * rs2, v1 = acc[ai][0][m][1] * acc[ai][1][m][1] * rs2;
                *(u32x4*)(T + (size_t)row * DM + ch0) = pack8(v0, v1);
                asm volatile("" ::: "memory");
            }
    }
};
struct EpiConvU {
    static constexpr bool PERM = true, AFTER_DRAIN = false;
    bf16_t* U; const bf16_t* T; const float* sumsq; const float* cw;
    __device__ __forceinline__ void operator()(const f32x4 (&acc)[2][2][4][2], const Unit& u, int wr, int wc, int fr, int fq) const {
        const int row0 = u.pm * 256 + wr * 64 + fr;
#pragma unroll
        for (int bj = 0; bj < 2; ++bj) {
            const int ch0 = u.pn * 256 + bj * 128 + wc * 32 + 8 * fq;
            const f32x4 w0a = *(const f32x4*)(cw + ch0), w0b = *(const f32x4*)(cw + ch0 + 4), w1a = *(const f32x4*)(cw + DM + ch0), w1b = *(const f32x4*)(cw + DM + ch0 + 4),
                        w2a = *(const f32x4*)(cw + 2 * DM + ch0), w2b = *(const f32x4*)(cw + 2 * DM + ch0 + 4);
#pragma unroll
            for (int ai = 0; ai < 2; ++ai)
#pragma unroll
                for (int m = 0; m < 4; ++m) {
                    const int row = row0 + ai * 128 + m * 16, pos = seqpos(row), slen = row < NPROMPT ? 4096 : 8192;
                    const float rs = __builtin_amdgcn_rsqf(sumsq[row] * (1.0f / DM) + EPS);
                    const bf16_t* tp = T + (size_t)row * DM + ch0;
                    const u32x4 z = {0u, 0u, 0u, 0u};
                    const u32x4 tc = *(const u32x4*)tp;
                    const u32x4 tl = (pos > 0) ? *(const u32x4*)(tp - DM) : z;
                    const u32x4 tn = (pos < slen - 1) ? *(const u32x4*)(tp + DM) : z;
                    f32x4 ca, cb, la, lb, na, nb; unpack8(tc, ca, cb); unpack8(tl, la, lb); unpack8(tn, na, nb);
                    const f32x4 ya = w0a * la + w1a * ca + w2a * na, yb = w0b * lb + w1b * cb + w2b * nb;
                    const f32x4 v0 = acc[ai][bj][m][0] * rs * ya, v1 = acc[ai][bj][m][1] * rs * yb;
                    *(u32x4*)(U + (size_t)row * DM + ch0) = pack8(v0, v1);
                    asm volatile("" ::: "memory");
                }
        }
    }
};

template <int MAP> __device__ __forceinline__ int orow_map(int n) {
    if (MAP == 1) { const int b = n >> 9; const int ob = (b == 0) ? 0 : (b == 1) ? 3 : (b == 2) ? 1 : (b == 3) ? 2 : 4; return ob * 512 + (n & 511); }
    if (MAP == 2) { if (n < 1024) return 2048 + n; const int hs = (n >= 2048) ? 1 : 0; const int ch = n - 1024 - hs * 1024; return (ch >> 7) * 256 + hs * 128 + (ch & 127); }
    return n;
}
template <int MAP> __device__ __forceinline__ void transpose_item(const float* W, int K, int N, bf16_t* WT, const float* gk, LAS float* scr, int item, int lane) {
    const int nblk = N / 32, kb = item / nblk, nb = item % nblk, k0 = 64 * kb, n0 = 32 * nb;
#pragma unroll 8
    for (int i = 0; i < 32; ++i) { const int kk = 2 * i + (lane >> 5); float v = W[(size_t)(k0 + kk) * N + n0 + (lane & 31)]; if (gk) v *= gk[k0 + kk]; scr[kk * 33 + (lane & 31)] = v; }
    asm volatile("s_waitcnt lgkmcnt(0)" ::: "memory");
    const int c = lane & 7; const int or0 = orow_map<MAP>(n0);
#pragma unroll
    for (int j = 0; j < 4; ++j) { const int n = (lane >> 3) + 8 * j; const LAS float* s = scr + (8 * c) * 33 + n;
        u32x4 o; o.x = cvtpk(s[0 * 33], s[1 * 33]); o.y = cvtpk(s[2 * 33], s[3 * 33]); o.z = cvtpk(s[4 * 33], s[5 * 33]); o.w = cvtpk(s[6 * 33], s[7 * 33]);
        *(u32x4*)(WT + (size_t)(or0 + n) * K + k0 + 8 * c) = o; }
    asm volatile("s_waitcnt lgkmcnt(0)" ::: "memory");
}
__device__ __forceinline__ void rms_row_to_bf16(const float* xrow, const float* g, bf16_t* orow, int lane) {
    const f32x4* xr = (const f32x4*)xrow + lane; const f32x4* gr = (const f32x4*)g + lane;
    f32x4 v[4]; float s = 0.f;
#pragma unroll
    for (int j = 0; j < 4; ++j) { v[j] = xr[64 * j]; s += (v[j][0] * v[j][0] + v[j][1] * v[j][1]) + (v[j][2] * v[j][2] + v[j][3] * v[j][3]); }
    const float rstd = 1.0f / sqrtf(wave_sum(s) * (1.0f / DM) + EPS);
    u32x2* o8 = (u32x2*)orow + lane;
#pragma unroll
    for (int j = 0; j < 4; ++j) { const f32x4 gg = gr[64 * j]; const f32x4 y = v[j] * rstd * gg; u32x2 w; w.x = cvtpk(y[0], y[1]); w.y = cvtpk(y[2], y[3]); o8[64 * j] = w; }
}

__device__ __forceinline__ int swap23(int x) { return (x & ~12) | ((x & 4) << 1) | ((x & 8) >> 1); }
__device__ __forceinline__ float half_swap_max(float v) { auto rr = __builtin_amdgcn_permlane32_swap(__float_as_uint(v), __float_as_uint(v), false, false); return fmaxf(__uint_as_float(rr[0]), __uint_as_float(rr[1])); }
__device__ __forceinline__ float half_swap_sum(float v) { auto rr = __builtin_amdgcn_permlane32_swap(__float_as_uint(v), __float_as_uint(v), false, false); return __uint_as_float(rr[0]) + __uint_as_float(rr[1]); }

#define SBAR() __builtin_amdgcn_sched_barrier(0)
#define MFMA32(a, b, c) __builtin_amdgcn_mfma_f32_32x32x16_bf16((a), (b), (c), 0, 0, 0)
#ifdef ATT_PRIO
#define PRIO_HI() __builtin_amdgcn_s_setprio(2)
#define PRIO_LO() __builtin_amdgcn_s_setprio(0)
#else
#define PRIO_HI() do {} while (0)
#define PRIO_LO() do {} while (0)
#endif
__device__ __forceinline__ float max3f(float a, float b, float c) { float r; asm("v_max3_f32 %0, %1, %2, %3" : "=v"(r) : "v"(a), "v"(b), "v"(c)); return r; }
__device__ __forceinline__ void glds16(const void* gsrc, unsigned lds_dst) { unsigned keep;
    asm volatile("s_mov_b32 %0, m0\n\ts_mov_b32 m0, %2\n\ts_nop 0\n\tglobal_load_lds_dwordx4 %1, off\n\ts_mov_b32 m0, %0" : "=&s"(keep) : "v"(gsrc), "s"(lds_dst) : "memory"); }
#define WAIT_BAR(N) asm volatile("s_waitcnt vmcnt(" #N ") lgkmcnt(0)\n\ts_barrier" ::: "memory")
constexpr int ATT_STAGE = 32768;
__device__ __forceinline__ void att_step(LAS unsigned char* lds, const int t, const int NT, const int j, const int r32, const int hi, const int swz,
                                         const bf16x8 (&qr)[4], f32x16 (&o)[4], f32x16& C0, f32x16& C1, f32x16& N0, f32x16& N1, f32x16& negm, float& mrun, float& lsum,
                                         const bf16_t* const (&ksrc)[2], const bf16_t* const (&vsrc)[2], const unsigned kdma, const unsigned vdma, int& sl0, int& sl1, int& sl2) {
    const bool k3 = (t + 3 < NT), v2 = (t + 2 < NT);
    if (k3) {
#pragma unroll
        for (int i = 0; i < 2; ++i) glds16(ksrc[i] + (size_t)(t + 3) * 64 * NZA, (unsigned)__builtin_amdgcn_readfirstlane(kdma + sl0 + i * 1024));
#ifdef PROBE_T3
#pragma unroll
        for (int i = 0; i < 2; ++i) glds16(ksrc[i] + (size_t)(t + 3) * 64 * NZA, (unsigned)__builtin_amdgcn_readfirstlane(kdma + sl0 + i * 1024));
#endif
    }
    if (v2) {
#pragma unroll
        for (int i = 0; i < 2; ++i) glds16(vsrc[i] + (t + 2) * 64, (unsigned)__builtin_amdgcn_readfirstlane(vdma + sl2 + i * 1024));
#ifdef PROBE_T3
#pragma unroll
        for (int i = 0; i < 2; ++i) glds16(vsrc[i] + (t + 2) * 64, (unsigned)__builtin_amdgcn_readfirstlane(vdma + sl2 + i * 1024));
#endif
    }
    const LAS unsigned char* kb = lds + sl1 + j * 8192 + r32 * 128;
    const LAS unsigned char* vb = lds + sl0 + 16384 + r32 * 128;
#define KOFF(d0) ((((2 * (d0) + hi) ^ swz)) * 16)
#define VLD(b, jj) (*(const LAS bf16x8*)(vb + (b) * 4096 + ((((2 * (jj) + hi) ^ swz)) * 16)))
#ifdef PROBE_T1
#define VDUP(jj) do { _Pragma("unroll") for (int b_ = 0; b_ < 4; ++b_) { const bf16x8 d_ = *(volatile const LAS bf16x8*)(vb + b_ * 4096 + ((((2 * (jj) + hi) ^ swz)) * 16)); dsum[b_] = d_; } } while (0)
#define VUSE() asm volatile("" :: "v"(dsum[0]), "v"(dsum[1]), "v"(dsum[2]), "v"(dsum[3]))
#else
#define VDUP(jj) do {} while (0)
#define VUSE() do {} while (0)
#endif
    bf16x8 ka[4][2];
#pragma unroll
    for (int d0 = 0; d0 < 2; ++d0) { ka[d0][0] = *(const LAS bf16x8*)(kb + KOFF(d0)); ka[d0][1] = *(const LAS bf16x8*)(kb + 4096 + KOFF(d0)); }
    SBAR();
    float ma, mb;
    N0 = MFMA32(ka[0][0], qr[0], negm);
    ma = max3f(C0[0], C0[1], C0[2]); mb = max3f(C0[3], C0[4], C0[5]); ma = max3f(ma, C0[6], C0[7]); mb = max3f(mb, C0[8], C0[9]); SBAR();
    N1 = MFMA32(ka[0][1], qr[0], negm);
#pragma unroll
    for (int d0 = 2; d0 < 4; ++d0) { ka[d0][0] = *(const LAS bf16x8*)(kb + KOFF(d0)); ka[d0][1] = *(const LAS bf16x8*)(kb + 4096 + KOFF(d0)); }
    ma = max3f(ma, C0[10], C0[11]); mb = max3f(mb, C0[12], C0[13]); ma = max3f(ma, C0[14], C0[15]); mb = max3f(mb, C1[0], C1[1]); SBAR();
    N0 = MFMA32(ka[1][0], qr[1], N0);
    ma = max3f(ma, C1[2], C1[3]); mb = max3f(mb, C1[4], C1[5]); ma = max3f(ma, C1[6], C1[7]); mb = max3f(mb, C1[8], C1[9]); SBAR();
    N1 = MFMA32(ka[1][1], qr[1], N1);
    ma = max3f(ma, C1[10], C1[11]); mb = max3f(mb, C1[12], C1[13]); ma = max3f(ma, C1[14], C1[15]); SBAR();
    float rm = fmaxf(ma, mb);
    rm = half_swap_max(rm);
    if (__builtin_expect(__any(rm > 6.0f), 0)) {
        const float dm = fmaxf(rm, 0.f), alpha = __builtin_amdgcn_exp2f(-dm);
        mrun += dm; lsum *= alpha;
#pragma unroll
        for (int b = 0; b < 4; ++b)
#pragma unroll
            for (int r = 0; r < 16; ++r) o[b][r] *= alpha;
#pragma unroll
        for (int r = 0; r < 16; ++r) { C0[r] -= dm; C1[r] -= dm; N0[r] -= dm; N1[r] -= dm; negm[r] = -mrun; }
    }
    float s0 = 0.f, s1 = 0.f;
    u32x4 pw[4];
    bf16x8 va[4], vn[4];
#ifdef PROBE_T1
    bf16x8 dsum[4];
#endif
#ifdef PROBE_T2
#define XDUP(x) do { float d_ = (x); asm volatile("v_exp_f32 %0, %0" : "+v"(d_)); } while (0)
#else
#define XDUP(x) do {} while (0)
#endif
#define VQ(P, base, g, i) do { XDUP(P[(base) + 2 * (i)]); XDUP(P[(base) + 2 * (i) + 1]); const float e0_ = __builtin_amdgcn_exp2f(P[(base) + 2 * (i)]), e1_ = __builtin_amdgcn_exp2f(P[(base) + 2 * (i) + 1]); s0 += e0_; s1 += e1_; asm volatile("" : "+v"(s0), "+v"(s1)); pw[g][i] = cvtpk(e0_, e1_); } while (0)
    SBAR();
#pragma unroll
    for (int b = 0; b < 4; ++b) va[b] = VLD(b, 0);
    VDUP(0);
    N0 = MFMA32(ka[2][0], qr[2], N0); VQ(C0, 0, 0, 0); SBAR();
    N1 = MFMA32(ka[2][1], qr[2], N1); VQ(C0, 0, 0, 1); SBAR();
    N0 = MFMA32(ka[3][0], qr[3], N0); VQ(C0, 0, 0, 2); SBAR();
    N1 = MFMA32(ka[3][1], qr[3], N1); VQ(C0, 0, 0, 3); SBAR();
#pragma unroll
    for (int b = 0; b < 4; ++b) vn[b] = VLD(b, 1);
    VDUP(1);
    { const bf16x8 pb = __builtin_bit_cast(bf16x8, pw[0]);
      o[0] = MFMA32(va[0], pb, o[0]); VQ(C0, 8, 1, 0); SBAR();
      o[1] = MFMA32(va[1], pb, o[1]); VQ(C0, 8, 1, 1); SBAR();
      o[2] = MFMA32(va[2], pb, o[2]); VQ(C0, 8, 1, 2); SBAR();
      o[3] = MFMA32(va[3], pb, o[3]); VQ(C0, 8, 1, 3); SBAR(); }
#pragma unroll
    for (int b = 0; b < 4; ++b) va[b] = VLD(b, 2);
    VDUP(2);
    { const bf16x8 pb = __builtin_bit_cast(bf16x8, pw[1]);
      o[0] = MFMA32(vn[0], pb, o[0]); VQ(C1, 0, 2, 0); SBAR();
      o[1] = MFMA32(vn[1], pb, o[1]); VQ(C1, 0, 2, 1); SBAR();
      o[2] = MFMA32(vn[2], pb, o[2]); VQ(C1, 0, 2, 2); SBAR();
      o[3] = MFMA32(vn[3], pb, o[3]); VQ(C1, 0, 2, 3); SBAR(); }
#pragma unroll
    for (int b = 0; b < 4; ++b) vn[b] = VLD(b, 3);
    VDUP(3);
    { const bf16x8 pb = __builtin_bit_cast(bf16x8, pw[2]);
      o[0] = MFMA32(va[0], pb, o[0]); VQ(C1, 8, 3, 0); SBAR();
      o[1] = MFMA32(va[1], pb, o[1]); VQ(C1, 8, 3, 1); SBAR();
      o[2] = MFMA32(va[2], pb, o[2]); VQ(C1, 8, 3, 2); SBAR();
      o[3] = MFMA32(va[3], pb, o[3]); VQ(C1, 8, 3, 3); SBAR(); }
    { const bf16x8 pb = __builtin_bit_cast(bf16x8, pw[3]);
      o[0] = MFMA32(vn[0], pb, o[0]);
      o[1] = MFMA32(vn[1], pb, o[1]);
      o[2] = MFMA32(vn[2], pb, o[2]);
      o[3] = MFMA32(vn[3], pb, o[3]); }
    VUSE();
    lsum += s0 + s1;
#undef VQ
#undef KOFF
#undef VLD
#ifdef PROBE_T3
    if (k3) WAIT_BAR(8); else WAIT_BAR(0);
#else
    if (k3) WAIT_BAR(4); else WAIT_BAR(0);
#endif
    { const int s_ = sl0; sl0 = sl1; sl1 = sl2; sl2 = s_; }
}

__device__ __forceinline__ void attn_unit(LAS unsigned char* lds, const bf16_t* __restrict__ ZA, const bf16_t* __restrict__ ZT, bf16_t* __restrict__ CAT, const float* __restrict__ subg,
                                          float lam, int seqrow0, int slen, int h, int qb) {
    int tid_ = threadIdx.x; asm volatile("" : "+v"(tid_));
    const int tid = tid_, lane = tid & 63, r32 = lane & 31, hi = lane >> 5;
    const int wid = __builtin_amdgcn_readfirstlane(tid >> 6), j = wid >> 2, sub = wid & 3;
    const int qrow = seqrow0 + qb * 128 + sub * 32 + r32;
    bf16x8 qr[4];
#pragma unroll
    for (int d0 = 0; d0 < 4; ++d0) qr[d0] = *(const bf16x8*)(ZA + (size_t)qrow * NZA + 512 + h * 128 + j * 64 + d0 * 16 + hi * 8);
    const bf16_t* ksrc[2]; const bf16_t* vsrc[2];
#pragma unroll
    for (int i = 0; i < 2; ++i) {
        const int pc = 2 * wid + i, jj = pc >> 3, rho = (pc & 7) * 8 + (lane >> 3), cs = lane & 7, dch = cs ^ ((rho >> 1) & 7), kv = (rho & ~15) | swap23(rho & 15);
        ksrc[i] = ZA + (size_t)(seqrow0 + kv) * NZA + 1024 + h * 128 + jj * 64 + dch * 8;
        const int d = pc * 8 + (lane >> 3), vch = cs ^ ((d >> 1) & 7);
        vsrc[i] = ZT + (size_t)(512 + h * 128 + d) * NTOK + seqrow0 + vch * 8;
    }
    const unsigned lds0 = (unsigned)(uintptr_t)lds;
    const unsigned kdma = lds0 + wid * 2048, vdma = lds0 + 16384 + wid * 2048;
    const int NT = slen / 64;
    const int swz = (r32 >> 1) & 7;
#pragma unroll
    for (int i = 0; i < 2; ++i) {
        glds16(ksrc[i], (unsigned)__builtin_amdgcn_readfirstlane(kdma + i * 1024));
        glds16(vsrc[i], (unsigned)__builtin_amdgcn_readfirstlane(vdma + i * 1024));
        glds16(ksrc[i] + (size_t)64 * NZA, (unsigned)__builtin_amdgcn_readfirstlane(kdma + ATT_STAGE + i * 1024));
        glds16(vsrc[i] + 64, (unsigned)__builtin_amdgcn_readfirstlane(vdma + ATT_STAGE + i * 1024));
        glds16(ksrc[i] + (size_t)128 * NZA, (unsigned)__builtin_amdgcn_readfirstlane(kdma + 2 * ATT_STAGE + i * 1024));
    }
    WAIT_BAR(0);
    f32x16 o[4], SA0, SA1, SB0, SB1;
#pragma unroll
    for (int b = 0; b < 4; ++b)
#pragma unroll
        for (int r = 0; r < 16; ++r) o[b][r] = 0.f;
#pragma unroll
    for (int r = 0; r < 16; ++r) { SA0[r] = 0.f; SA1[r] = 0.f; }
    {
        const LAS unsigned char* kb = lds + j * 8192 + r32 * 128;
#pragma unroll
        for (int d0 = 0; d0 < 4; ++d0) {
            const int off = ((2 * d0 + hi) ^ swz) * 16;
            const bf16x8 a0 = *(const LAS bf16x8*)(kb + off), a1 = *(const LAS bf16x8*)(kb + 4096 + off);
            SA0 = MFMA32(a0, qr[d0], SA0); SA1 = MFMA32(a1, qr[d0], SA1);
        }
    }
    float mrun, lsum = 0.f; f32x16 negm;
    {
        float rm = fmaxf(SA0[0], SA1[0]);
#pragma unroll
        for (int r = 1; r < 16; ++r) rm = fmaxf(rm, fmaxf(SA0[r], SA1[r]));
        mrun = half_swap_max(rm);
#pragma unroll
        for (int r = 0; r < 16; ++r) { SA0[r] -= mrun; SA1[r] -= mrun; negm[r] = -mrun; }
    }
    asm volatile("s_nop 15\n\ts_nop 7" : "+v"(SA0), "+v"(SA1));
    WAIT_BAR(0);
    int sl0 = 0, sl1 = ATT_STAGE, sl2 = 2 * ATT_STAGE;
    for (int t = 0; t < NT; t += 2) {
        att_step(lds, t, NT, j, r32, hi, swz, qr, o, SA0, SA1, SB0, SB1, negm, mrun, lsum, ksrc, vsrc, kdma, vdma, sl0, sl1, sl2);
        att_step(lds, t + 1, NT, j, r32, hi, swz, qr, o, SB0, SB1, SA0, SA1, negm, mrun, lsum, ksrc, vsrc, kdma, vdma, sl0, sl1, sl2);
    }
    const float inv = 1.0f / half_swap_sum(lsum);
    LAS float* X = (LAS float*)lds + sub * 4096 + lane;
    if (j == 1) {
        const float f = inv * lam;
#pragma unroll
        for (int b = 0; b < 4; ++b)
#pragma unroll
            for (int r = 0; r < 16; ++r) X[(b * 16 + r) * 64] = o[b][r] * f;
    }
    __syncthreads();
    if (j == 0) {
        float ss = 0.f;
#pragma unroll
        for (int b = 0; b < 4; ++b)
#pragma unroll
            for (int r = 0; r < 16; ++r) { const float v = o[b][r] * inv - X[(b * 16 + r) * 64]; o[b][r] = v; ss += v * v; }
        ss = half_swap_sum(ss);
        const float rs = __builtin_amdgcn_rsqf(ss * (1.0f / 128.0f) + EPS) * (1.0f - LAM_INIT);
        bf16_t* op = CAT + (size_t)qrow * DM + 512 + h * 128;
#pragma unroll
        for (int b = 0; b < 4; ++b)
#pragma unroll
            for (int a = 0; a < 4; ++a) {
                const int d0 = 32 * b + 8 * a + 4 * hi; const f32x4 g = *(const f32x4*)(subg + d0);
                u32x2 w; w.x = cvtpk(o[b][4 * a] * rs * g[0], o[b][4 * a + 1] * rs * g[1]); w.y = cvtpk(o[b][4 * a + 2] * rs * g[2], o[b][4 * a + 3] * rs * g[3]);
                *(u32x2*)(op + d0) = w;
            }
    }
    __syncthreads();
}

__device__ __forceinline__ void gmlp_item(LAS unsigned char* lds, const bf16_t* __restrict__ ZA, const bf16_t* __restrict__ ZT, bf16_t* __restrict__ CAT, const float* __restrict__ Wsg,
                                          const float* __restrict__ vng, const float* __restrict__ bsg, int ck, int g) {
    int tid_ = threadIdx.x; asm volatile("" : "+v"(tid_));
    const int tid = tid_, lane = tid & 63, r32 = lane & 31, hi = lane >> 5;
    const int wid = __builtin_amdgcn_readfirstlane(tid >> 6);
    const int R0 = ck * 128;
    LAS float* red = (LAS float*)(lds + 32768); LAS float* rstd = (LAS float*)(lds + 32768 + 2048);
#pragma unroll
    for (int i = 0; i < 4; ++i) {
        const int c = tid + 512 * i, e = c >> 4, ch = c & 15;
        const u32x4 v = *(const u32x4*)(ZT + (size_t)(g * 128 + e) * NTOK + R0 + ch * 8);
        *(LAS u32x4*)(lds + e * 256 + ((ch ^ (e & 15)) * 16)) = v;
    }
    __syncthreads();
    { const int q = tid & 127, part = tid >> 7; float s = 0.f;
#pragma unroll 8
      for (int ee = 0; ee < 32; ++ee) { const int e = part * 32 + ee; const unsigned short b = *(const LAS unsigned short*)(lds + e * 256 + (((q >> 3) ^ (e & 15)) * 16) + (q & 7) * 2); const float v = __uint_as_float((unsigned)b << 16); s += v * v; }
      red[part * 128 + q] = s; }
    __syncthreads();
    if (tid < 128) rstd[tid] = __builtin_amdgcn_rsqf((red[tid] + red[128 + tid] + red[256 + tid] + red[384 + tid]) * (1.0f / 128.0f) + EPS);
    __syncthreads();
    const int eblk = wid & 3, pb0 = 2 * (wid >> 2);
    f32x16 acc[2];
#pragma unroll
    for (int r = 0; r < 16; ++r) { acc[0][r] = 0.f; acc[1][r] = 0.f; }
#pragma unroll
    for (int kk = 0; kk < 8; ++kk) {
        const bf16x8 a = *(const LAS bf16x8*)(lds + (32 * eblk + r32) * 256 + (((2 * kk + hi) ^ (r32 & 15)) * 16));
        const f32x4 ra = *(const LAS f32x4*)(rstd + 16 * kk + 8 * hi), rb = *(const LAS f32x4*)(rstd + 16 * kk + 8 * hi + 4);
#pragma unroll
        for (int pp = 0; pp < 2; ++pp) {
            const float* wp = Wsg + (size_t)(32 * (pb0 + pp) + r32) * 128 + 16 * kk + 8 * hi;
            const f32x4 wa = *(const f32x4*)wp * ra, wb = *(const f32x4*)(wp + 4) * rb;
            const bf16x8 b = __builtin_bit_cast(bf16x8, pack8(wa, wb));
            acc[pp] = __builtin_amdgcn_mfma_f32_32x32x16_bf16(a, b, acc[pp], 0, 0, 0);
        }
    }
#pragma unroll
    for (int pp = 0; pp < 2; ++pp) {
        const int p = 32 * (pb0 + pp) + r32, row = R0 + p; const float bs = bsg[p];
#pragma unroll
        for (int a4 = 0; a4 < 4; ++a4) {
            const int e0 = 32 * eblk + 8 * a4 + 4 * hi; const f32x4 gv = *(const f32x4*)(vng + e0);
            const u32x2 uu = *(const u32x2*)(ZA + (size_t)row * NZA + g * 128 + e0);
            const float o0 = bflo(uu.x) * (gv[0] * acc[pp][4 * a4] + bs), o1 = bfhi(uu.x) * (gv[1] * acc[pp][4 * a4 + 1] + bs),
                        o2 = bflo(uu.y) * (gv[2] * acc[pp][4 * a4 + 2] + bs), o3 = bfhi(uu.y) * (gv[3] * acc[pp][4 * a4 + 3] + bs);
            u32x2 w; w.x = cvtpk(o0, o1); w.y = cvtpk(o2, o3);
            *(u32x2*)(CAT + (size_t)row * DM + g * 128 + e0) = w;
        }
    }
    __syncthreads();
}

#define XB_TMO      128
#define XB_XCNT(j)  (256  + 64 * (j))
#define XB_XSUB(j)  (1280 + 64 * (j))
#define XB_XGEN(j)  (2304 + 64 * (j))
#define XB_TOP      3328
#define XB_TOPGEN   3392
#define XCD_BAR_WORDS 3456
#define XB_SPIN_CAP (1u << 18)

__device__ __forceinline__ unsigned xb_ld(unsigned* p)              { return __hip_atomic_load(p, __ATOMIC_RELAXED, __HIP_MEMORY_SCOPE_AGENT); }
__device__ __forceinline__ unsigned xb_add(unsigned* p, unsigned v) { return __hip_atomic_fetch_add(p, v, __ATOMIC_RELAXED, __HIP_MEMORY_SCOPE_AGENT); }
__device__ __forceinline__ unsigned xb_xcc_id() { return (unsigned)__builtin_amdgcn_s_getreg((3 << 11) | 20) & 0xFu; }
#define XB_SPIN(cond, bar) do { unsigned _sp = 0; while (cond) { __builtin_amdgcn_s_sleep(1); \
    if ((++_sp & 255u) == 0u) { if (xb_ld(&(bar)[XB_TMO])) break; if (_sp > XB_SPIN_CAP) { atomicAdd(&(bar)[XB_TMO], 1u); break; } } } } while (0)

struct XcdBarrier {
    unsigned* bar; unsigned x;
    volatile LAS unsigned* st;
};

__device__ __forceinline__ XcdBarrier xcd_barrier_post(unsigned* bar, volatile LAS unsigned* st) {
    XcdBarrier b; b.bar = bar; b.x = xb_xcc_id(); b.st = st;
    if (threadIdx.x == 0) (void)xb_add(&bar[XB_XCNT(b.x)], 1u);
    return b;
}
__device__ __forceinline__ void xcd_barrier_complete(unsigned* bar, unsigned x, unsigned& nloc, unsigned& nx) {
    const unsigned G = gridDim.x * gridDim.y * gridDim.z;
    unsigned sum, cnt, mine, sp = 0u;
    for (;;) {
        sum = 0u; cnt = 0u; mine = 0u;
#pragma unroll
        for (unsigned j = 0; j < 16; ++j) { const unsigned c = xb_ld(&bar[XB_XCNT(j)]); sum += c; cnt += (c > 0u) ? 1u : 0u; mine = (j == x) ? c : mine; }
        if (sum == G) break;
        __builtin_amdgcn_s_sleep(1);
        if ((++sp & 255u) == 0u) { if (xb_ld(&bar[XB_TMO])) break; if (sp > XB_SPIN_CAP) { atomicAdd(&bar[XB_TMO], 1u); break; } }
    }
    nloc = mine > 0u ? mine : 1u; nx = cnt > 0u ? cnt : 1u;
}

__device__ __forceinline__ void xcd_barrier(const XcdBarrier& b) {
    asm volatile("s_waitcnt vmcnt(0)" ::: "memory");
    __syncthreads();
    if (threadIdx.x == 0) {
        unsigned* bar = b.bar;
        __builtin_amdgcn_s_waitcnt(0);
        unsigned nloc = b.st[0], nx = b.st[1];
        if (nloc == 0u) { xcd_barrier_complete(bar, b.x, nloc, nx); b.st[0] = nloc; b.st[1] = nx; }
        const unsigned old = xb_add(&bar[XB_XSUB(b.x)], 1u);
        const unsigned gen = old / nloc;
        if (old + 1u == (gen + 1u) * nloc) {
            __builtin_amdgcn_fence(__ATOMIC_RELEASE, "agent");
            asm volatile("s_waitcnt vmcnt(0)" ::: "memory");
            const unsigned og = xb_add(&bar[XB_TOP], 1u);
            const unsigned tg = og / nx;
            if (og + 1u == (tg + 1u) * nx) xb_add(&bar[XB_TOPGEN], 1u);
            else XB_SPIN(xb_ld(&bar[XB_TOPGEN]) == tg, bar);
            __builtin_amdgcn_fence(__ATOMIC_ACQUIRE, "agent");
            xb_add(&bar[XB_XGEN(b.x)], 1u);
            asm volatile("s_waitcnt vmcnt(0)" ::: "memory");
        } else {
            XB_SPIN(xb_ld(&bar[XB_XGEN(b.x)]) == gen, bar);
            __builtin_amdgcn_fence(__ATOMIC_ACQUIRE, "agent");
            asm volatile("s_waitcnt vmcnt(0)" ::: "memory");
        }
    }
    __syncthreads();
}

#define GEMM_RUN(EPI, g, E) do { pg8::StaticOrder S_; S_.init((g).M, (g).N, G, (int)blockIdx.x); pg8::gemm_phase<EPI, pg8::StaticOrder, PG8_ALIGN, PG8_SP2>(lds, (g), S_, (E)); } while (0)
#ifdef USE_CG_FIRST
#define GRID_SYNC0() grid.sync()
#else
#define GRID_SYNC0() do { if (P.ws == nullptr) grid.sync(); xcd_barrier(bar); } while (0)
#endif
#ifdef USE_CG_SYNC
#define GRID_SYNC() grid.sync()
#else
#define GRID_SYNC() xcd_barrier(bar)
#endif
#ifndef PHMASK
#define PHMASK 0xffff
#endif
#define PH(n) (((PHMASK) >> (n)) & 1)
#ifndef REP_P2
#define REP_P2 1
#endif
#ifndef REP_P1
#define REP_P1 1
#endif
#ifndef REP_FFN1
#define REP_FFN1 1
#endif
#ifndef REP_CONV
#define REP_CONV 1
#endif
#ifndef REP_P0
#define REP_P0 1
#endif

__global__ void __launch_bounds__(512) mega_fwd(Params P) {
    extern __shared__ __attribute__((aligned(16))) unsigned char lds_raw[];
    LAS unsigned char* lds = (LAS unsigned char*)lds_raw;
    cg::grid_group grid = cg::this_grid();
    const int tid = threadIdx.x, lane = tid & 63, wave = __builtin_amdgcn_readfirstlane(tid >> 6);
    const int G = gridDim.x, bx = blockIdx.x;
    const int vcu = (G % 8 == 0) ? (bx % 8) * (G / 8) + bx / 8 : bx;
    unsigned char* ws = P.ws;
    const float* x_prompt = P.in[0]; const float* x_sample = P.in[1];
    float* sumsq = (float*)(ws + WS_SUMSQ);
    volatile LAS unsigned* MISC = (volatile LAS unsigned*)(lds + 131072 + 320);
    if (tid < 64) MISC[tid] = 0u;
    __syncthreads();
    XcdBarrier bar = xcd_barrier_post((unsigned*)(ws + WS_BAR), MISC + 8);
    bf16_t* WinT = (bf16_t*)(ws + WS_WIN); bf16_t* WoutT = (bf16_t*)(ws + WS_WOUT); bf16_t* W1T = (bf16_t*)(ws + WS_W1); bf16_t* W2T = (bf16_t*)(ws + WS_W2);
    bf16_t* CinT = (bf16_t*)(ws + WS_CIN); bf16_t* CoutT = (bf16_t*)(ws + WS_COUT); float* rope = (float*)(ws + WS_ROPE);
    bf16_t* ZT = (bf16_t*)(ws + WS_HB); bf16_t* HB = (bf16_t*)(ws + WS_HB);
    bf16_t* XN = (bf16_t*)(ws + WS_BIG); bf16_t* CAT = (bf16_t*)(ws + WS_BIG); bf16_t* HID = (bf16_t*)(ws + WS_BIG);
    bf16_t* TB = (bf16_t*)(ws + WS_BIG); bf16_t* UB = (bf16_t*)(ws + WS_BIG + 64 * MiB);
    bf16_t* ZA = (bf16_t*)P.out; float* H = P.out;

    if (PH(0)) {
        LAS float* scr = (LAS float*)(lds + wave * 16384);
        const int gw = vcu * 8 + wave, NGW = G * 8;
        constexpr int I_EIN = 16 * 80, I_EOUT = 16 * 32, I_W1 = 16 * 128, I_W2 = 64 * 32, I_CIN = 16 * 96, I_COUT = 16 * 32;
        constexpr int NITEMS = I_EIN + I_EOUT + 2 * I_W1 + 2 * I_W2 + I_CIN + I_COUT;
        for (int it = gw; it < NITEMS; it += NGW) {
            int r = it;
            if (r < I_EIN) { transpose_item<1>(P.in[6], DM, 2560, WinT, nullptr, scr, r, lane); continue; } r -= I_EIN;
            if (r < I_EOUT) { transpose_item<0>(P.in[7], DM, DM, WoutT, nullptr, scr, r, lane); continue; } r -= I_EOUT;
            if (r < I_W1) { transpose_item<0>(P.in[4], DM, DFF, W1T, P.in[3], scr, r, lane); continue; } r -= I_W1;
            if (r < I_W1) { transpose_item<0>(P.in[4] + (size_t)DM * DFF, DM, DFF, W1T + (size_t)DM * DFF, P.in[3] + DM, scr, r, lane); continue; } r -= I_W1;
            if (r < I_W2) { transpose_item<0>(P.in[5], DFF, DM, W2T, nullptr, scr, r, lane); continue; } r -= I_W2;
            if (r < I_W2) { transpose_item<0>(P.in[5] + (size_t)DM * DFF, DFF, DM, W2T + (size_t)DM * DFF, nullptr, scr, r, lane); continue; } r -= I_W2;
            if (r < I_CIN) { transpose_item<2>(P.in[16], DM, 3072, CinT, P.in[2] + DM, scr, r, lane); continue; } r -= I_CIN;
            transpose_item<0>(P.in[18], DM, DM, CoutT, nullptr, scr, r, lane);
        }
        for (int m = gw; m < NTOK; m += NGW) {
            const float* xr = (m < NPROMPT) ? x_prompt + (size_t)m * DM : x_sample + (size_t)(m - NPROMPT) * DM;
            rms_row_to_bf16(xr, P.in[2], XN + (size_t)m * DM, lane);
        }
        const int gt = vcu * 512 + tid, NGT = G * 512;
        for (int i = gt; i < 4 * NTOK; i += NGT) sumsq[i] = 0.f;
        for (int i = gt; i < 8192 * 8; i += NGT) {
            const int pos = i >> 3, fi = i & 7;
            const float inv = exp2f(-(float)fi * 0.125f * 18.931568569324174f);
            const float ang = (float)pos * inv;
            const double ad = (double)ang; const double kq = rint(ad * 0.15915494309189535); const float rr = (float)(ad - kq * 6.283185307179586);
            rope[pos * 16 + fi] = __cosf(rr); rope[pos * 16 + 8 + fi] = __sinf(rr);
        }
    }
    GRID_SYNC0();

    if (PH(1)) {
        pg8::Gemm ga{XN, WinT, NTOK, 1536, DM}; EpiA ea{ZA, rope};
        pg8::Gemm gb{WinT + (size_t)1536 * DM, XN, 1024, NTOK, DM}; EpiB eb{ZT};
#pragma unroll 1
        for (int rep_ = 0; rep_ < REP_P1; ++rep_) {
        GEMM_RUN(EpiA, ga, ea);
        GEMM_RUN(EpiB, gb, eb);
        }
    }
    GRID_SYNC();

    if (PH(2)) {
        float s1 = 0.f, s2 = 0.f;
        for (int i = 0; i < 64; ++i) { s1 += P.in[11][i] * P.in[12][i]; s2 += P.in[13][i] * P.in[14][i]; }
        const float lam = __expf(s1) - __expf(s2) + LAM_INIT;
        for (int rep_ = 0; rep_ < REP_P2; ++rep_)
        for (int k = vcu; k < 256; k += G) {
#pragma unroll 1
            for (int w = 0; w < 2; ++w) { const int idx = 2 * k + w, bh = idx >> 6, qb = idx & 63; attn_unit(lds, ZA, ZT, CAT, P.in[15], lam, NPROMPT + (bh >> 2) * 8192, 8192, bh & 3, qb); }
#pragma unroll 1
            for (int w = 0; w < 2; ++w) { const int idx = 2 * k + w, bh = idx >> 5, qb = idx & 31; attn_unit(lds, ZA, ZT, CAT, P.in[15], lam, (bh >> 2) * 4096, 4096, bh & 3, qb); }
        }
        for (int it = vcu; it < 1024; it += G) { const int ck = it >> 2, g = it & 3; gmlp_item(lds, ZA, ZT, CAT, P.in[9] + (size_t)g * 16384, P.in[8] + g * 128, P.in[10] + g * 128, ck, g); }
    }
    GRID_SYNC();

    if (PH(3)) {
        pg8::Gemm g{CAT, WoutT, NTOK, DM, DM}; EpiRes<0> e{x_prompt, x_sample - (size_t)NPROMPT * DM, H, HB, sumsq, 0};
        GEMM_RUN(EpiRes<0>, g, e);
    }
    GRID_SYNC();

#pragma unroll 1
    for (int hf = 0; hf < 2 && PH(4); ++hf) {
        if (PH(10)) { pg8::Gemm g{HB + (size_t)hf * 16384 * DM, W1T, 16384, DFF, DM}; EpiFfn1 e{HID, sumsq, hf * 16384};
#pragma unroll 1
          for (int rep_ = 0; rep_ < REP_FFN1; ++rep_) GEMM_RUN(EpiFfn1, g, e); }
        GRID_SYNC();
        if (PH(11)) { pg8::Gemm g{HID, W2T, 16384, DM, DFF}; EpiRes<1> e{nullptr, nullptr, H, HB, sumsq + NTOK, hf * 16384}; GEMM_RUN(EpiRes<1>, g, e); }
        GRID_SYNC();
    }

    if (PH(5)) { pg8::Gemm g{HB, CinT, NTOK, 2048, DM}; EpiConvT e{TB, sumsq + NTOK};
#pragma unroll 1
      for (int rep_ = 0; rep_ < REP_CONV; ++rep_) GEMM_RUN(EpiConvT, g, e); }
    GRID_SYNC();
    if (PH(6)) { pg8::Gemm g{HB, CinT + (size_t)2048 * DM, NTOK, DM, DM}; EpiConvU e{UB, TB, sumsq + NTOK, P.in[17]};
#pragma unroll 1
      for (int rep_ = 0; rep_ < REP_CONV; ++rep_) GEMM_RUN(EpiConvU, g, e); }
    GRID_SYNC();
    if (PH(7)) { pg8::Gemm g{UB, CoutT, NTOK, DM, DM}; EpiRes<1> e{nullptr, nullptr, H, HB, sumsq + 2 * NTOK, 0}; GEMM_RUN(EpiRes<1>, g, e); }
    GRID_SYNC();

#pragma unroll 1
    for (int hf = 0; hf < 2 && PH(8); ++hf) {
        { pg8::Gemm g{HB + (size_t)hf * 16384 * DM, W1T + (size_t)DM * DFF, 16384, DFF, DM}; EpiFfn1 e{HID, sumsq + 2 * NTOK, hf * 16384};
#pragma unroll 1
          for (int rep_ = 0; rep_ < REP_FFN1; ++rep_) GEMM_RUN(EpiFfn1, g, e); }
        GRID_SYNC();
        { pg8::Gemm g{HID, W2T + (size_t)DM * DFF, 16384, DM, DFF}; EpiRes<1> e{nullptr, nullptr, H, HB, sumsq + 3 * NTOK, hf * 16384}; GEMM_RUN(EpiRes<1>, g, e); }
        GRID_SYNC();
    }

    if (PH(9)) {
        const int gw = vcu * 8 + wave, NGW = G * 8; const float* fg = P.in[19];
        for (int m = gw; m < NTOK; m += NGW) {
            const float rs = 1.0f / sqrtf(sumsq[3 * NTOK + m] * (1.0f / DM) + EPS);
            const u32x4* br = (const u32x4*)(HB + (size_t)m * DM) + lane; float* hr = H + (size_t)m * DM + 8 * lane; const float* gr = fg + 8 * lane;
#pragma unroll
            for (int jx = 0; jx < 2; ++jx) { f32x4 a, b; unpack8(br[64 * jx], a, b);
                *(f32x4*)(hr + 512 * jx) = a * rs * *(const f32x4*)(gr + 512 * jx); *(f32x4*)(hr + 512 * jx + 4) = b * rs * *(const f32x4*)(gr + 512 * jx + 4); }
        }
    }
}

extern "C" void kernel_launch(void* const* d_in, const int* in_sizes, int n_in, void* d_out, int out_size, void* d_ws, size_t ws_size, hipStream_t stream) {
    static int grid = 0;
    if (grid == 0) {
        if (n_in != 20 || out_size != NTOK * DM || ws_size < WS_END) { fprintf(stderr, "kernel_launch: unexpected shapes (n_in %d out %d ws %zu)\n", n_in, out_size, ws_size); grid = -1; return; }
        int dev = 0, cus = 0, per_cu = 0;
        hipGetDevice(&dev); hipDeviceGetAttribute(&cus, hipDeviceAttributeMultiprocessorCount, dev);
        if (hipFuncSetAttribute((const void*)mega_fwd, hipFuncAttributeMaxDynamicSharedMemorySize, LDS_BYTES) != hipSuccess) { fprintf(stderr, "kernel_launch: hipFuncSetAttribute failed\n"); grid = -1; return; }
        if (hipOccupancyMaxActiveBlocksPerMultiprocessor(&per_cu, (const void*)mega_fwd, 512, LDS_BYTES) != hipSuccess || per_cu < 1) { fprintf(stderr, "kernel_launch: occupancy query says %d\n", per_cu); per_cu = 1; }
        (void)hipGetLastError();
        grid = cus * per_cu;
    }
    if (grid < 0) return;
    if (hipMemsetAsync((char*)d_ws + WS_BAR, 0, BAR_BYTES, stream) != hipSuccess) { fprintf(stderr, "kernel_launch: memset failed\n"); return; }
    Params p{};
    for (int i = 0; i < 20; ++i) p.in[i] = (const float*)d_in[i];
    p.out = (float*)d_out; p.ws = (unsigned char*)d_ws;
    void* args[] = {&p};
    hipError_t e = hipLaunchCooperativeKernel((const void*)mega_fwd, dim3(grid), dim3(512), args, LDS_BYTES, stream);
    if (e != hipSuccess) fprintf(stderr, "kernel_launch: cooperative launch failed: %s (grid %d)\n", hipGetErrorString(e), grid);
}
```

```cpp
#include <hip/hip_runtime.h>
#include <hip/hip_cooperative_groups.h>
#include <cstdio>
#include <cstdint>
namespace cg = cooperative_groups;
namespace pg8 {
#define PG8_LAS __attribute__((address_space(3)))
typedef unsigned short bf16_t;
typedef short bf16x8 __attribute__((ext_vector_type(8)));
typedef float f32x4 __attribute__((ext_vector_type(4)));
typedef unsigned u32x4 __attribute__((ext_vector_type(4)));
constexpr int BM = 256, BK = 64, HALF = 128, HTB = HALF * BK * 2  , STAGE_BYTES = 8 * HTB, NXCD = 8, WGM = 8;

__host__ __device__ __forceinline__ int lds_byte(int r, int c) { const int st = (r >> 4) * 2 + (c >> 5), rr = r & 15, cc = c & 31, ob = rr * 64 + cc * 2; return st * 1024 + (ob ^ (((ob >> 9) & 1) << 5)); }
__host__ __device__ __forceinline__ void stage_rc(int b, int& R, int& C) { const int st = b / 1024, sb = b % 1024, swz = sb ^ (((sb >> 9) & 1) << 5); R = (st >> 1) * 16 + swz / 64; C = (st & 1) * 32 + (swz % 64) / 2; }
__host__ __device__ __forceinline__ int perm32(int rho) { const int n = rho >> 4, i = rho & 15; return 8 * (i >> 2) + 4 * n + (i & 3); }

struct Unit { int pm, pn; };
struct Gemm { const bf16_t* A; const bf16_t* Bt; int M, N, K; };

struct StaticOrder {
    int nM, nN, nwg, G, c;
    __host__ __device__ void init(int M, int N, int G_, int c_) { nM = M / BM; nN = N / BM; nwg = nM * nN; G = G_; c = c_; }
    __host__ __device__ bool next(int i, Unit& u) const {
        const long L = (long)i * G + c; if (L >= nwg) return false;
        int wgid = (int)L; { const int q = nwg / NXCD, r = nwg % NXCD, xcd = wgid % NXCD, off = wgid / NXCD; wgid = (xcd < r ? xcd * (q + 1) : r * (q + 1) + (xcd - r) * q) + off; }
        const int nig = WGM * nN, gid = wgid / nig, fm = gid * WGM, gsz = (nM - fm) < WGM ? (nM - fm) : WGM;
        u.pm = fm + ((wgid % nig) % gsz); u.pn = (wgid % nig) / gsz; return true;
    }
    __device__ __forceinline__ void a_ready(const Unit&) const {}
    __device__ __forceinline__ void done(const Unit&) const {}
};

__device__ __forceinline__ unsigned cvt_pk_bf16(float lo, float hi) { unsigned r; asm volatile("v_cvt_pk_bf16_f32 %0, %1, %2" : "=v"(r) : "v"(lo), "v"(hi)); return r; }
typedef float f32x2 __attribute__((ext_vector_type(2)));
__device__ __forceinline__ f32x2 gelu_pk(f32x2 v) {
    const f32x2 av = __builtin_elementwise_abs(v), d = av * 0.2316418882f + 1.0f;
    f32x2 t; t.x = __builtin_amdgcn_rcpf(d.x); t.y = __builtin_amdgcn_rcpf(d.y);
    f32x2 q = t * 0.5307027145f + (-0.7265760135f); q = q * t + 0.7107068705f; q = q * t + (-0.142248368f); q = q * t + 0.127414796f; q = q * t;
    const f32x2 s = (v * v) * (-0.72134752044f);
    f32x2 e; e.x = __builtin_amdgcn_exp2f(s.x); e.y = __builtin_amdgcn_exp2f(s.y);
    const f32x2 m = v * (q * e), r = v - m;
    f32x2 o; o.x = v.x < 0.f ? m.x : r.x; o.y = v.y < 0.f ? m.y : r.y; return o;
}

template <class Epi, class Sched, bool ALIGN_EPI = false, bool SP2 = false>
__device__ __forceinline__ void gemm_phase(PG8_LAS unsigned char* lds, const Gemm g, const Sched& S, const Epi& E) {
    int tid_ = threadIdx.x; asm volatile("" : "+v"(tid_));
    const int tid = tid_, wid = __builtin_amdgcn_readfirstlane(tid >> 6), lane = tid & 63, wr = wid >> 2, wc = wid & 3, fr = lane & 15, fq = lane >> 4;
    const int K = g.K, nt = K / BK;
    unsigned voffA[2], voffB[2];
#pragma unroll
    for (int i = 0; i < 2; ++i) { int R, C; stage_rc(tid * 16 + i * 8192, R, C); const int Rb = Epi::PERM ? ((R & ~31) + perm32(R & 31)) : R;
        voffA[i] = (unsigned)(R * K + C) * 2u; voffB[i] = (unsigned)(Rb * K + C) * 2u; }
    const size_t kstep = (size_t)(BK * 2);
    const size_t hstep = (size_t)HALF * K * 2;
    const size_t tstep = 2 * hstep;
    const unsigned ldsw = (unsigned)wid * 1024u;
    const int aoff = lds_byte(wr * 64 + fr, fq * 8), boff = lds_byte(wc * 32 + fr, fq * 8);
#define PG8_SA(b, h) (((b) * 2 + (h)) * HTB)
#define PG8_SB(b, h) ((4 + (b) * 2 + (h)) * HTB)
#define PG8_STAGE(bufoff, gbase, voff) do { _Pragma("unroll") for (int _i = 0; _i < 2; ++_i) \
        __builtin_amdgcn_global_load_lds((const unsigned*)((const char*)(gbase) + (voff)[_i]), (PG8_LAS unsigned*)(lds + (bufoff) + ldsw + _i * 8192), 16, 0, 0); } while (0)
#define PG8_LDA(dst, b, h) do { _Pragma("unroll") for (int m = 0; m < 4; ++m) _Pragma("unroll") for (int k = 0; k < 2; ++k) dst[m][k] = *(const PG8_LAS bf16x8*)(lds + PG8_SA(b, h) + aoff + m * 2048 + k * 1024); } while (0)
#define PG8_LDB(dst, b, h) do { _Pragma("unroll") for (int n = 0; n < 2; ++n) _Pragma("unroll") for (int k = 0; k < 2; ++k) dst[n][k] = *(const PG8_LAS bf16x8*)(lds + PG8_SB(b, h) + boff + n * 2048 + k * 1024); } while (0)
#define PG8_MMA(ai, bj, At, Bt) do { __builtin_amdgcn_s_setprio(1); _Pragma("unroll") for (int m = 0; m < 4; ++m) _Pragma("unroll") for (int n = 0; n < 2; ++n) _Pragma("unroll") for (int k = 0; k < 2; ++k) \
        acc[ai][bj][m][n] = __builtin_amdgcn_mfma_f32_16x16x32_bf16(Bt[n][k], At[m][k], acc[ai][bj][m][n], 0, 0, 0); __builtin_amdgcn_s_setprio(0); } while (0)
#define PG8_WAIT_V(n) asm volatile("s_waitcnt vmcnt(" #n ")" ::: "memory")
#define PG8_WAIT_L(n) asm volatile("s_waitcnt lgkmcnt(" #n ")" ::: "memory")
#define PG8_BAR __builtin_amdgcn_s_barrier()
#define PG8_SCHED __builtin_amdgcn_sched_barrier(0)
    Unit cur, nxt; int ui = 0;
    if (!S.next(0, cur)) return;
    f32x4 acc[2][2][4][2];
#pragma unroll
    for (int a = 0; a < 2; ++a)
#pragma unroll
        for (int b = 0; b < 2; ++b)
#pragma unroll
            for (int m = 0; m < 4; ++m)
#pragma unroll
                for (int n = 0; n < 2; ++n) acc[a][b][m][n] = (f32x4){0.f, 0.f, 0.f, 0.f};
    bf16x8 At[4][2], B0[2][2], B1[2][2];
    const char* cA = (const char*)g.A + (size_t)cur.pm * tstep; const char* cB = (const char*)g.Bt + (size_t)cur.pn * tstep;
    S.a_ready(cur);
    if constexpr (SP2) {
        PG8_STAGE(PG8_SB(0, 0), cB, voffB); PG8_STAGE(PG8_SB(0, 1), cB + hstep, voffB); PG8_STAGE(PG8_SA(0, 0), cA, voffA); PG8_STAGE(PG8_SA(0, 1), cA + hstep, voffA);
        if (wr == 1) PG8_BAR;
        PG8_WAIT_V(2); PG8_BAR;
        PG8_STAGE(PG8_SB(1, 0), cB + kstep, voffB); PG8_STAGE(PG8_SA(1, 0), cA + kstep, voffA); PG8_STAGE(PG8_SB(1, 1), cB + hstep + kstep, voffB);
        PG8_WAIT_V(6); PG8_BAR;
    } else {
        PG8_STAGE(PG8_SB(0, 0), cB, voffB); PG8_STAGE(PG8_SA(0, 0), cA, voffA); PG8_STAGE(PG8_SB(0, 1), cB + hstep, voffB); PG8_STAGE(PG8_SA(0, 1), cA + hstep, voffA);
        if (wr == 1) PG8_BAR;
        PG8_WAIT_V(4); PG8_BAR;
        PG8_STAGE(PG8_SB(1, 0), cB + kstep, voffB); PG8_STAGE(PG8_SA(1, 0), cA + kstep, voffA); PG8_STAGE(PG8_SB(1, 1), cB + hstep + kstep, voffB);
        PG8_WAIT_V(6); PG8_BAR;
    }
    for (;;) {
        const bool has_next = S.next(ui + 1, nxt);
        const char* nA = has_next ? (const char*)g.A + (size_t)nxt.pm * tstep : cA; const char* nB = has_next ? (const char*)g.Bt + (size_t)nxt.pn * tstep : cB;
        for (int t = 0; t < nt; t += 2) {
            const bool last = (t == nt - 2);
            const char* a1 = cA + (size_t)(t + 1) * kstep;
            const char* a2 = last ? nA : cA + (size_t)(t + 2) * kstep; const char* b2 = last ? nB : cB + (size_t)(t + 2) * kstep;
            const char* a3 = a2 + kstep; const char* b3 = b2 + kstep;
            if (last && has_next) S.a_ready(nxt);
            if constexpr (SP2) {
            PG8_LDB(B0, 0, 0); PG8_LDB(B1, 0, 1); PG8_SCHED; PG8_LDA(At, 0, 0); PG8_STAGE(PG8_SA(1, 1), a1 + hstep, voffA);
            PG8_WAIT_V(8); PG8_WAIT_L(0); PG8_BAR; PG8_MMA(0, 0, At, B0); PG8_MMA(0, 1, At, B1); PG8_BAR; PG8_SCHED;
            PG8_LDA(At, 0, 1); PG8_STAGE(PG8_SB(0, 0), b2, voffB); PG8_STAGE(PG8_SB(0, 1), b2 + hstep, voffB); PG8_STAGE(PG8_SA(0, 0), a2, voffA);
            PG8_WAIT_V(8); PG8_WAIT_L(0); PG8_BAR; PG8_MMA(1, 0, At, B0); PG8_MMA(1, 1, At, B1); PG8_BAR; PG8_SCHED;
            PG8_LDB(B0, 1, 0); PG8_LDB(B1, 1, 1); PG8_SCHED; PG8_LDA(At, 1, 0); PG8_STAGE(PG8_SA(0, 1), a2 + hstep, voffA);
            PG8_WAIT_V(8); PG8_WAIT_L(0); PG8_BAR; PG8_MMA(0, 0, At, B0); PG8_MMA(0, 1, At, B1); PG8_BAR; PG8_SCHED;
            PG8_LDA(At, 1, 1); PG8_STAGE(PG8_SB(1, 0), b3, voffB); PG8_STAGE(PG8_SB(1, 1), b3 + hstep, voffB); PG8_STAGE(PG8_SA(1, 0), a3, voffA);
            PG8_WAIT_V(8); PG8_WAIT_L(0); PG8_BAR; PG8_MMA(1, 0, At, B0); PG8_MMA(1, 1, At, B1); PG8_BAR; PG8_SCHED;
            } else {
            PG8_LDB(B0, 0, 0); PG8_SCHED; PG8_LDA(At, 0, 0); PG8_STAGE(PG8_SA(1, 1), a1 + hstep, voffA);
            PG8_WAIT_L(8); PG8_BAR; PG8_WAIT_L(0); PG8_MMA(0, 0, At, B0); PG8_BAR; PG8_SCHED;
            PG8_LDB(B1, 0, 1); PG8_STAGE(PG8_SB(0, 0), b2, voffB);
            PG8_BAR; PG8_WAIT_L(0); PG8_MMA(0, 1, At, B1); PG8_BAR;
            PG8_LDA(At, 0, 1); PG8_STAGE(PG8_SA(0, 0), a2, voffA);
            PG8_BAR; PG8_WAIT_L(0); PG8_MMA(1, 0, At, B0); PG8_BAR; PG8_SCHED;
            PG8_STAGE(PG8_SB(0, 1), b2 + hstep, voffB);
            PG8_WAIT_V(6); PG8_BAR; PG8_MMA(1, 1, At, B1); PG8_BAR;
            PG8_LDB(B0, 1, 0); PG8_SCHED; PG8_LDA(At, 1, 0); PG8_STAGE(PG8_SA(0, 1), a2 + hstep, voffA);
            PG8_WAIT_L(8); PG8_BAR; PG8_WAIT_L(0); PG8_MMA(0, 0, At, B0); PG8_BAR; PG8_SCHED;
            PG8_LDB(B1, 1, 1); PG8_STAGE(PG8_SB(1, 0), b3, voffB);
            PG8_BAR; PG8_WAIT_L(0); PG8_MMA(0, 1, At, B1); PG8_BAR;
            PG8_LDA(At, 1, 1); PG8_STAGE(PG8_SA(1, 0), a3, voffA);
            PG8_BAR; PG8_WAIT_L(0); PG8_MMA(1, 0, At, B0); PG8_BAR; PG8_SCHED;
            PG8_STAGE(PG8_SB(1, 1), b3 + hstep, voffB);
            PG8_WAIT_V(6); PG8_BAR; PG8_MMA(1, 1, At, B1); PG8_BAR;
            }
        }
        if constexpr (ALIGN_EPI) { if (wr == 0) PG8_BAR; }
        if constexpr (!Epi::AFTER_DRAIN) { E(acc, cur, wr, wc, fr, fq); S.done(cur); }
        if (!has_next) break;
#pragma unroll
        for (int a = 0; a < 2; ++a)
#pragma unroll
            for (int b = 0; b < 2; ++b)
#pragma unroll
                for (int m = 0; m < 4; ++m)
#pragma unroll
                    for (int n = 0; n < 2; ++n) acc[a][b][m][n] = (f32x4){0.f, 0.f, 0.f, 0.f};
        cur = nxt; cA = nA; cB = nB; ++ui;
        if constexpr (ALIGN_EPI) { if (wr == 1) PG8_BAR; }
    }
    PG8_WAIT_V(0);
    if constexpr (!ALIGN_EPI) { if (wr == 0) PG8_BAR; }
    PG8_BAR;
    if constexpr (Epi::AFTER_DRAIN) { E.fused(acc, cur, wr, wc, fr, fq, lds, wid, lane); S.done(cur); }
#undef PG8_SA
#undef PG8_SB
#undef PG8_STAGE
#undef PG8_LDA
#undef PG8_LDB
#undef PG8_MMA
#undef PG8_WAIT_V
#undef PG8_WAIT_L
#undef PG8_BAR
#undef PG8_SCHED
}
}

#ifndef PG8_SP2
#define PG8_SP2 true
#endif
#ifndef PG8_ALIGN
#define PG8_ALIGN true
#endif
#define LAS __attribute__((address_space(3)))
typedef unsigned short bf16_t;
typedef short bf16x8 __attribute__((ext_vector_type(8)));
typedef float f32x4 __attribute__((ext_vector_type(4)));
typedef float f32x16 __attribute__((ext_vector_type(16)));
typedef unsigned u32x4 __attribute__((ext_vector_type(4)));
typedef unsigned u32x2 __attribute__((ext_vector_type(2)));
using pg8::Unit;

constexpr int NTOK = 32768, NPROMPT = 16384, DM = 1024, DFF = 4096;
constexpr int NZA = 1536;
constexpr float EPS = 1e-5f;
constexpr float C2 = 0.125f * 1.4426950408889634f;
constexpr float LAM_INIT = 0.2f;
constexpr size_t MiB = 1u << 20;
constexpr size_t WS_SUMSQ = 0;
constexpr size_t WS_BAR = 512 * 1024, BAR_BYTES = 16384;
constexpr size_t WS_WIN = 1 * MiB, WS_WOUT = 6 * MiB, WS_W1 = 8 * MiB, WS_W2 = 24 * MiB, WS_CIN = 40 * MiB, WS_COUT = 46 * MiB, WS_ROPE = 48 * MiB;
constexpr size_t WS_HB = 49 * MiB;
constexpr size_t WS_BIG = 113 * MiB;
constexpr size_t WS_END = 241 * MiB;
constexpr int LDS_BYTES = 147456;

struct Params { const float* in[20]; float* out; unsigned char* ws; int ffn_parts; int pad; };

typedef float f32x2_t __attribute__((ext_vector_type(2))); typedef __bf16 bf16x2_t __attribute__((ext_vector_type(2)));
__device__ __forceinline__ unsigned cvtpk(float lo, float hi) { f32x2_t v = {lo, hi}; bf16x2_t b = __builtin_convertvector(v, bf16x2_t); return __builtin_bit_cast(unsigned, b); }
__device__ __forceinline__ u32x4 pack8(f32x4 a, f32x4 b) { u32x4 w; w.x = cvtpk(a[0], a[1]); w.y = cvtpk(a[2], a[3]); w.z = cvtpk(b[0], b[1]); w.w = cvtpk(b[2], b[3]); return w; }
#ifdef NT_STORES
__device__ __forceinline__ void st16(bf16_t* p, u32x4 v) { __builtin_nontemporal_store(v, (u32x4*)p); }
#else
__device__ __forceinline__ void st16(bf16_t* p, u32x4 v) { *(u32x4*)p = v; }
#endif
__device__ __forceinline__ float bflo(unsigned x) { return __uint_as_float(x << 16); }
__device__ __forceinline__ float bfhi(unsigned x) { return __uint_as_float(x & 0xffff0000u); }
__device__ __forceinline__ void unpack8(u32x4 w, f32x4& a, f32x4& b) { a = (f32x4){bflo(w.x), bfhi(w.x), bflo(w.y), bfhi(w.y)}; b = (f32x4){bflo(w.z), bfhi(w.z), bflo(w.w), bfhi(w.w)}; }
__device__ __forceinline__ float gelu_tanh(float x) { const float t = x * (1.0f + 0.044715f * x * x); const float e = __builtin_amdgcn_exp2f(-2.302208198f * t); return x * __builtin_amdgcn_rcpf(1.0f + e); }
__device__ __forceinline__ f32x4 gelu4(f32x4 v) { return (f32x4){gelu_tanh(v[0]), gelu_tanh(v[1]), gelu_tanh(v[2]), gelu_tanh(v[3])}; }
__device__ __forceinline__ float wave_sum(float v) {
#pragma unroll
    for (int o = 1; o < 64; o <<= 1) v += __shfl_xor(v, o);
    return v;
}
__device__ __forceinline__ int seqpos(int row) { return row < NPROMPT ? (row & 4095) : (row & 8191); }

struct EpiA {
    static constexpr bool PERM = true, AFTER_DRAIN = false;
    bf16_t* ZA; const float* rope;
    __device__ __forceinline__ void operator()(const f32x4 (&acc)[2][2][4][2], const Unit& u, int wr, int wc, int fr, int fq) const {
        const int row0 = u.pm * 256 + wr * 64 + fr, kind = u.pn >> 1, col0 = u.pn * 256 + wc * 32 + 8 * fq;
        const bool ropew = (kind != 0) && ((wc & 1) == 0);
        const float sgn = (fq == 0) ? -1.f : 1.f, sc = (kind == 1) ? C2 : 1.f;
#pragma unroll
        for (int aih = 0; aih < 4; ++aih) {
            const int ai = aih >> 1, mh = (aih & 1) * 2;
            f32x4 c0[4], c1[4], s0[4], s1[4];
            if (ropew) {
#pragma unroll
                for (int m = mh; m < mh + 2; ++m) { const float* rp = rope + seqpos(row0 + ai * 128 + m * 16) * 16; c0[m] = *(const f32x4*)rp; c1[m] = *(const f32x4*)(rp + 4); s0[m] = *(const f32x4*)(rp + 8); s1[m] = *(const f32x4*)(rp + 12); }
            }
#pragma unroll
            for (int m = mh; m < mh + 2; ++m) {
                const int row = row0 + ai * 128 + m * 16;
                bf16_t* op = ZA + (size_t)row * NZA + col0;
#pragma unroll
                for (int bj = 0; bj < 2; ++bj) {
                    f32x4 v0 = acc[ai][bj][m][0], v1 = acc[ai][bj][m][1];
                    if (kind == 0) { v0 = gelu4(v0); v1 = gelu4(v1); }
                    else {
                        if (ropew) {
                            f32x4 p0, p1;
#pragma unroll
                            for (int e = 0; e < 4; ++e) { p0[e] = __shfl_xor(v0[e], 16); p1[e] = __shfl_xor(v1[e], 16); }
                            if (fq < 2) { v0 = v0 * c0[m] + (p0 * s0[m]) * sgn; v1 = v1 * c1[m] + (p1 * s1[m]) * sgn; }
                        }
                        v0 = v0 * sc; v1 = v1 * sc;
                    }
                    *(u32x4*)(op + bj * 128) = pack8(v0, v1);
                }
            }
            asm volatile("" ::: "memory");
        }
    }
};
struct EpiB {
    static constexpr bool PERM = true, AFTER_DRAIN = false;
    bf16_t* ZT;
    __device__ __forceinline__ void operator()(const f32x4 (&acc)[2][2][4][2], const Unit& u, int wr, int wc, int fr, int fq) const {
        const int row0 = u.pm * 256 + wr * 64 + fr, col0 = u.pn * 256 + wc * 32 + 8 * fq; const bool act = u.pm < 2;
#pragma unroll
        for (int ai = 0; ai < 2; ++ai)
#pragma unroll
            for (int m = 0; m < 4; ++m) {
                bf16_t* op = ZT + (size_t)(row0 + ai * 128 + m * 16) * NTOK + col0;
#pragma unroll
                for (int bj = 0; bj < 2; ++bj) {
                    f32x4 v0 = acc[ai][bj][m][0], v1 = acc[ai][bj][m][1];
                    if (act) { v0 = gelu4(v0); v1 = gelu4(v1); }
                    *(u32x4*)(op + bj * 128) = pack8(v0, v1);
                }
            }
    }
};
template <int MODE> struct EpiRes {
    static constexpr bool PERM = true, AFTER_DRAIN = false;
    const float* res0; const float* res1; float* H; bf16_t* HB; float* sumsq; int rowbase;
    __device__ __forceinline__ void operator()(const f32x4 (&acc)[2][2][4][2], const Unit& u, int wr, int wc, int fr, int fq) const {
        const int row0 = rowbase + u.pm * 256 + wr * 64 + fr, col0 = u.pn * 256 + wc * 32 + 8 * fq;
#pragma unroll
        for (int ai = 0; ai < 2; ++ai) {
            f32x4 r0[4][2], r1[4][2];
#pragma unroll
            for (int m = 0; m < 4; ++m) {
                const int row = row0 + ai * 128 + m * 16; const size_t off = (size_t)row * DM + col0;
#pragma unroll
                for (int bj = 0; bj < 2; ++bj) {
                    if (MODE == 0) { const float* rp = (row < NPROMPT ? res0 : res1) + off + bj * 128; r0[m][bj] = *(const f32x4*)rp; r1[m][bj] = *(const f32x4*)(rp + 4); }
                    else { const u32x4 w = *(const u32x4*)(HB + off + bj * 128); r0[m][bj] = __builtin_bit_cast(f32x4, w); }
                }
            }
#pragma unroll
            for (int m = 0; m < 4; ++m) {
                const int row = row0 + ai * 128 + m * 16; const size_t off = (size_t)row * DM + col0; float ss = 0.f;
#pragma unroll
                for (int bj = 0; bj < 2; ++bj) {
                    f32x4 a, b;
                    if (MODE == 0) { a = r0[m][bj]; b = r1[m][bj]; } else unpack8(__builtin_bit_cast(u32x4, r0[m][bj]), a, b);
                    const f32x4 v0 = acc[ai][bj][m][0] + a, v1 = acc[ai][bj][m][1] + b;
                    if (MODE == 2) { *(f32x4*)(H + off + bj * 128) = v0; *(f32x4*)(H + off + bj * 128 + 4) = v1; }
                    else *(u32x4*)(HB + off + bj * 128) = pack8(v0, v1);
                    ss += (v0[0] * v0[0] + v0[1] * v0[1]) + (v0[2] * v0[2] + v0[3] * v0[3]) + (v1[0] * v1[0] + v1[1] * v1[1]) + (v1[2] * v1[2] + v1[3] * v1[3]);
                }
                ss += __shfl_xor(ss, 16); ss += __shfl_xor(ss, 32);
                if (fq == 0) __hip_atomic_fetch_add(sumsq + row, ss, __ATOMIC_RELAXED, __HIP_MEMORY_SCOPE_AGENT);
            }
            asm volatile("" ::: "memory");
        }
    }
};
struct EpiFfn1 {
    static constexpr bool PERM = true, AFTER_DRAIN = false;
    bf16_t* HID; const float* sumsq; int rowbase;
    __device__ __forceinline__ void operator()(const f32x4 (&acc)[2][2][4][2], const Unit& u, int wr, int wc, int fr, int fq) const {
        const int lrow0 = u.pm * 256 + wr * 64 + fr, col0 = u.pn * 256 + wc * 32 + 8 * fq;
        float rs[2][4];
#pragma unroll
        for (int ai = 0; ai < 2; ++ai)
#pragma unroll
            for (int m = 0; m < 4; ++m) rs[ai][m] = sumsq[rowbase + lrow0 + ai * 128 + m * 16];
#pragma unroll
        for (int ai = 0; ai < 2; ++ai)
#pragma unroll
            for (int m = 0; m < 4; ++m) {
                const int lrow = lrow0 + ai * 128 + m * 16;
                const float r = __builtin_amdgcn_rsqf(rs[ai][m] * (1.0f / DM) + EPS);
                bf16_t* op = HID + (size_t)lrow * DFF + col0;
#pragma unroll
                for (int bj = 0; bj < 2; ++bj) {
                    f32x4 v0 = acc[ai][bj][m][0] * r, v1 = acc[ai][bj][m][1] * r;
#pragma unroll
                    for (int e = 0; e < 4; ++e) { const float a = fmaxf(v0[e], 0.f), b = fmaxf(v1[e], 0.f); v0[e] = a * a; v1[e] = b * b; }
                    st16(op + bj * 128, pack8(v0, v1));
                }
            }
    }
};
struct EpiConvT {
    static constexpr bool PERM = true, AFTER_DRAIN = false;
    bf16_t* T; const float* sumsq;
    __device__ __forceinline__ void operator()(const f32x4 (&acc)[2][2][4][2], const Unit& u, int wr, int wc, int fr, int fq) const {
        const int row0 = u.pm * 256 + wr * 64 + fr, ch0 = u.pn * 128 + wc * 32 + 8 * fq;
        float rs[2][4];
#pragma unroll
        for (int ai = 0; ai < 2; ++ai)
#pragma unroll
            for (int m = 0; m < 4; ++m) rs[ai][m] = sumsq[row0 + ai * 128 + m * 16];
#pragma unroll
        for (int ai = 0; ai < 2; ++ai)
#pragma unroll
            for (int m = 0; m < 4; ++m) {
                const int row = row0 + ai * 128 + m * 16;
                const float r = __builtin_amdgcn_rsqf(rs[ai][m] * (1.0f / DM) + EPS), rs2 = r * r;
                const f32x4 v0 = acc[ai][0][m][0] * acc[ai][1][m][0] * rs2, v1 = acc[ai][0][m][1] * acc[ai][1][m][1] * rs2;
                *(u32x4*)(T + (size_t)row * DM + ch0) = pack8(v0, v1);
            }
    }
};
struct EpiConvU {
    static constexpr bool PERM = true, AFTER_DRAIN = false;
    bf16_t* U; const bf16_t* T; const float* sumsq; const float* cw;
    __device__ __forceinline__ void operator()(const f32x4 (&acc)[2][2][4][2], const Unit& u, int wr, int wc, int fr, int fq) const {
        const int row0 = u.pm * 256 + wr * 64 + fr;
        float rs[2][4];
#pragma unroll
        for (int ai = 0; ai < 2; ++ai)
#pragma unroll
            for (int m = 0; m < 4; ++m) rs[ai][m] = sumsq[row0 + ai * 128 + m * 16];
#pragma unroll
        for (int bj = 0; bj < 2; ++bj) {
            const int ch0 = u.pn * 256 + bj * 128 + wc * 32 + 8 * fq;
            const f32x4 w0a = *(const f32x4*)(cw + ch0), w0b = *(const f32x4*)(cw + ch0 + 4), w1a = *(const f32x4*)(cw + DM + ch0), w1b = *(const f32x4*)(cw + DM + ch0 + 4),
                        w2a = *(const f32x4*)(cw + 2 * DM + ch0), w2b = *(const f32x4*)(cw + 2 * DM + ch0 + 4);
#pragma unroll
            for (int aih = 0; aih < 4; ++aih) {
                const int ai = aih >> 1, mh = (aih & 1) * 2;
                u32x4 tc[4], tl[4], tn[4];
#pragma unroll
                for (int m = mh; m < mh + 2; ++m) {
                    const int row = row0 + ai * 128 + m * 16, pos = seqpos(row), slen = row < NPROMPT ? 4096 : 8192;
                    const bf16_t* tp = T + (size_t)row * DM + ch0; const u32x4 z = {0u, 0u, 0u, 0u};
                    tc[m] = *(const u32x4*)tp; tl[m] = (pos > 0) ? *(const u32x4*)(tp - DM) : z; tn[m] = (pos < slen - 1) ? *(const u32x4*)(tp + DM) : z;
                }
#pragma unroll
                for (int m = mh; m < mh + 2; ++m) {
                    const int row = row0 + ai * 128 + m * 16;
                    const float r = __builtin_amdgcn_rsqf(rs[ai][m] * (1.0f / DM) + EPS);
                    f32x4 ca, cb, la, lb, na, nb; unpack8(tc[m], ca, cb); unpack8(tl[m], la, lb); unpack8(tn[m], na, nb);
                    const f32x4 ya = w0a * la + w1a * ca + w2a * na, yb = w0b * lb + w1b * cb + w2b * nb;
                    const f32x4 v0 = acc[ai][bj][m][0] * r * ya, v1 = acc[ai][bj][m][1] * r * yb;
                    *(u32x4*)(U + (size_t)row * DM + ch0) = pack8(v0, v1);
                }
                asm volatile("" ::: "memory");
            }
        }
    }
};

template <int MAP> __device__ __forceinline__ int orow_map(int n) {
    if (MAP == 1) { const int b = n >> 9; const int ob = (b == 0) ? 0 : (b == 1) ? 3 : (b == 2) ? 1 : (b == 3) ? 2 : 4; return ob * 512 + (n & 511); }
    if (MAP == 2) { if (n < 1024) return 2048 + n; const int hs = (n >= 2048) ? 1 : 0; const int ch = n - 1024 - hs * 1024; return (ch >> 7) * 256 + hs * 128 + (ch & 127); }
    return n;
}
template <int MAP> __device__ __forceinline__ void transpose_item(const float* W, int K, int N, bf16_t* WT, const float* gk, LAS float* scr, int item, int lane) {
    const int nblk = N / 32, kb = item / nblk, nb = item % nblk, k0 = 64 * kb, n0 = 32 * nb;
#pragma unroll 8
    for (int i = 0; i < 32; ++i) { const int kk = 2 * i + (lane >> 5); float v = W[(size_t)(k0 + kk) * N + n0 + (lane & 31)]; if (gk) v *= gk[k0 + kk]; scr[kk * 33 + (lane & 31)] = v; }
    asm volatile("s_waitcnt lgkmcnt(0)" ::: "memory");
    const int c = lane & 7; const int or0 = orow_map<MAP>(n0);
#pragma unroll
    for (int j = 0; j < 4; ++j) { const int n = (lane >> 3) + 8 * j; const LAS float* s = scr + (8 * c) * 33 + n;
        u32x4 o; o.x = cvtpk(s[0 * 33], s[1 * 33]); o.y = cvtpk(s[2 * 33], s[3 * 33]); o.z = cvtpk(s[4 * 33], s[5 * 33]); o.w = cvtpk(s[6 * 33], s[7 * 33]);
        *(u32x4*)(WT + (size_t)(or0 + n) * K + k0 + 8 * c) = o; }
    asm volatile("s_waitcnt lgkmcnt(0)" ::: "memory");
}
__device__ __forceinline__ void rms_row_to_bf16(const float* xrow, const float* g, bf16_t* orow, int lane) {
    const f32x4* xr = (const f32x4*)xrow + lane; const f32x4* gr = (const f32x4*)g + lane;
    f32x4 v[4]; float s = 0.f;
#pragma unroll
    for (int j = 0; j < 4; ++j) { v[j] = xr[64 * j]; s += (v[j][0] * v[j][0] + v[j][1] * v[j][1]) + (v[j][2] * v[j][2] + v[j][3] * v[j][3]); }
    const float rstd = 1.0f / sqrtf(wave_sum(s) * (1.0f / DM) + EPS);
    u32x2* o8 = (u32x2*)orow + lane;
#pragma unroll
    for (int j = 0; j < 4; ++j) { const f32x4 gg = gr[64 * j]; const f32x4 y = v[j] * rstd * gg; u32x2 w; w.x = cvtpk(y[0], y[1]); w.y = cvtpk(y[2], y[3]); o8[64 * j] = w; }
}

__device__ __forceinline__ int swap23(int x) { return (x & ~12) | ((x & 4) << 1) | ((x & 8) >> 1); }
__device__ __forceinline__ float half_swap_max(float v) { auto rr = __builtin_amdgcn_permlane32_swap(__float_as_uint(v), __float_as_uint(v), false, false); return fmaxf(__uint_as_float(rr[0]), __uint_as_float(rr[1])); }
__device__ __forceinline__ float half_swap_sum(float v) { auto rr = __builtin_amdgcn_permlane32_swap(__float_as_uint(v), __float_as_uint(v), false, false); return __uint_as_float(rr[0]) + __uint_as_float(rr[1]); }

#define SBAR() __builtin_amdgcn_sched_barrier(0)
#define MFMA32(a, b, c) __builtin_amdgcn_mfma_f32_32x32x16_bf16((a), (b), (c), 0, 0, 0)
#ifdef ATT_PRIO
#define PRIO_HI() __builtin_amdgcn_s_setprio(2)
#define PRIO_LO() __builtin_amdgcn_s_setprio(0)
#else
#define PRIO_HI() do {} while (0)
#define PRIO_LO() do {} while (0)
#endif
__device__ __forceinline__ float max3f(float a, float b, float c) { float r; asm("v_max3_f32 %0, %1, %2, %3" : "=v"(r) : "v"(a), "v"(b), "v"(c)); return r; }
__device__ __forceinline__ void glds16(const void* gsrc, unsigned lds_dst) { unsigned keep;
    asm volatile("s_mov_b32 %0, m0\n\ts_mov_b32 m0, %2\n\ts_nop 0\n\tglobal_load_lds_dwordx4 %1, off\n\ts_mov_b32 m0, %0" : "=&s"(keep) : "v"(gsrc), "s"(lds_dst) : "memory"); }
#define WAIT_BAR(N) asm volatile("s_waitcnt vmcnt(" #N ") lgkmcnt(0)\n\ts_barrier" ::: "memory")
constexpr int ATT_STAGE = 32768;
__device__ __forceinline__ void att_step(LAS unsigned char* lds, const int t, const int NT, const int j, const int r32, const int hi, const int swz,
                                         const bf16x8 (&qr)[4], f32x16 (&o)[4], f32x16& C0, f32x16& C1, f32x16& N0, f32x16& N1, f32x16& negm, float& mrun, float& lsum,
                                         const bf16_t* const (&ksrc)[2], const bf16_t* const (&vsrc)[2], const unsigned kdma, const unsigned vdma, int& sl0, int& sl1, int& sl2) {
    const bool k3 = (t + 3 < NT), v2 = (t + 2 < NT);
    if (k3) {
#pragma unroll
        for (int i = 0; i < 2; ++i) glds16(ksrc[i] + (size_t)(t + 3) * 64 * NZA, (unsigned)__builtin_amdgcn_readfirstlane(kdma + sl0 + i * 1024));
#ifdef PROBE_T3
#pragma unroll
        for (int i = 0; i < 2; ++i) glds16(ksrc[i] + (size_t)(t + 3) * 64 * NZA, (unsigned)__builtin_amdgcn_readfirstlane(kdma + sl0 + i * 1024));
#endif
    }
    if (v2) {
#pragma unroll
        for (int i = 0; i < 2; ++i) glds16(vsrc[i] + (t + 2) * 64, (unsigned)__builtin_amdgcn_readfirstlane(vdma + sl2 + i * 1024));
#ifdef PROBE_T3
#pragma unroll
        for (int i = 0; i < 2; ++i) glds16(vsrc[i] + (t + 2) * 64, (unsigned)__builtin_amdgcn_readfirstlane(vdma + sl2 + i * 1024));
#endif
    }
    const LAS unsigned char* kb = lds + sl1 + j * 8192 + r32 * 128;
    const LAS unsigned char* vb = lds + sl0 + 16384 + r32 * 128;
#define KOFF(d0) ((((2 * (d0) + hi) ^ swz)) * 16)
#define VLD(b, jj) (*(const LAS bf16x8*)(vb + (b) * 4096 + ((((2 * (jj) + hi) ^ swz)) * 16)))
#ifdef PROBE_T1
#define VDUP(jj) do { _Pragma("unroll") for (int b_ = 0; b_ < 4; ++b_) { const bf16x8 d_ = *(volatile const LAS bf16x8*)(vb + b_ * 4096 + ((((2 * (jj) + hi) ^ swz)) * 16)); dsum[b_] = d_; } } while (0)
#define VUSE() asm volatile("" :: "v"(dsum[0]), "v"(dsum[1]), "v"(dsum[2]), "v"(dsum[3]))
#else
#define VDUP(jj) do {} while (0)
#define VUSE() do {} while (0)
#endif
    bf16x8 ka[4][2];
#pragma unroll
    for (int d0 = 0; d0 < 2; ++d0) { ka[d0][0] = *(const LAS bf16x8*)(kb + KOFF(d0)); ka[d0][1] = *(const LAS bf16x8*)(kb + 4096 + KOFF(d0)); }
    SBAR();
    float ma, mb;
    N0 = MFMA32(ka[0][0], qr[0], negm);
    ma = max3f(C0[0], C0[1], C0[2]); mb = max3f(C0[3], C0[4], C0[5]); ma = max3f(ma, C0[6], C0[7]); mb = max3f(mb, C0[8], C0[9]); SBAR();
    N1 = MFMA32(ka[0][1], qr[0], negm);
#pragma unroll
    for (int d0 = 2; d0 < 4; ++d0) { ka[d0][0] = *(const LAS bf16x8*)(kb + KOFF(d0)); ka[d0][1] = *(const LAS bf16x8*)(kb + 4096 + KOFF(d0)); }
    ma = max3f(ma, C0[10], C0[11]); mb = max3f(mb, C0[12], C0[13]); ma = max3f(ma, C0[14], C0[15]); mb = max3f(mb, C1[0], C1[1]); SBAR();
    N0 = MFMA32(ka[1][0], qr[1], N0);
    ma = max3f(ma, C1[2], C1[3]); mb = max3f(mb, C1[4], C1[5]); ma = max3f(ma, C1[6], C1[7]); mb = max3f(mb, C1[8], C1[9]); SBAR();
    N1 = MFMA32(ka[1][1], qr[1], N1);
    ma = max3f(ma, C1[10], C1[11]); mb = max3f(mb, C1[12], C1[13]); ma = max3f(ma, C1[14], C1[15]); SBAR();
    float rm = fmaxf(ma, mb);
    rm = half_swap_max(rm);
    if (__builtin_expect(__any(rm > 6.0f), 0)) {
        const float dm = fmaxf(rm, 0.f), alpha = __builtin_amdgcn_exp2f(-dm);
        mrun += dm; lsum *= alpha;
#pragma unroll
        for (int b = 0; b < 4; ++b)
#pragma unroll
            for (int r = 0; r < 16; ++r) o[b][r] *= alpha;
#pragma unroll
        for (int r = 0; r < 16; ++r) { C0[r] -= dm; C1[r] -= dm; N0[r] -= dm; N1[r] -= dm; negm[r] = -mrun; }
    }
    float s0 = 0.f, s1 = 0.f;
    u32x4 pw[4];
    bf16x8 va[4], vn[4];
#ifdef PROBE_T1
    bf16x8 dsum[4];
#endif
#ifdef PROBE_T2
#define XDUP(x) do { float d_ = (x); asm volatile("v_exp_f32 %0, %0" : "+v"(d_)); } while (0)
#else
#define XDUP(x) do {} while (0)
#endif
#define VQ(P, base, g, i) do { XDUP(P[(base) + 2 * (i)]); XDUP(P[(base) + 2 * (i) + 1]); const float e0_ = __builtin_amdgcn_exp2f(P[(base) + 2 * (i)]), e1_ = __builtin_amdgcn_exp2f(P[(base) + 2 * (i) + 1]); s0 += e0_; s1 += e1_; asm volatile("" : "+v"(s0), "+v"(s1)); pw[g][i] = cvtpk(e0_, e1_); } while (0)
    SBAR();
#pragma unroll
    for (int b = 0; b < 4; ++b) va[b] = VLD(b, 0);
    VDUP(0);
    N0 = MFMA32(ka[2][0], qr[2], N0); VQ(C0, 0, 0, 0); SBAR();
    N1 = MFMA32(ka[2][1], qr[2], N1); VQ(C0, 0, 0, 1); SBAR();
    N0 = MFMA32(ka[3][0], qr[3], N0); VQ(C0, 0, 0, 2); SBAR();
    N1 = MFMA32(ka[3][1], qr[3], N1); VQ(C0, 0, 0, 3); SBAR();
#pragma unroll
    for (int b = 0; b < 4; ++b) vn[b] = VLD(b, 1);
    VDUP(1);
    { const bf16x8 pb = __builtin_bit_cast(bf16x8, pw[0]);
      o[0] = MFMA32(va[0], pb, o[0]); VQ(C0, 8, 1, 0); SBAR();
      o[1] = MFMA32(va[1], pb, o[1]); VQ(C0, 8, 1, 1); SBAR();
      o[2] = MFMA32(va[2], pb, o[2]); VQ(C0, 8, 1, 2); SBAR();
      o[3] = MFMA32(va[3], pb, o[3]); VQ(C0, 8, 1, 3); SBAR(); }
#pragma unroll
    for (int b = 0; b < 4; ++b) va[b] = VLD(b, 2);
    VDUP(2);
    { const bf16x8 pb = __builtin_bit_cast(bf16x8, pw[1]);
      o[0] = MFMA32(vn[0], pb, o[0]); VQ(C1, 0, 2, 0); SBAR();
      o[1] = MFMA32(vn[1], pb, o[1]); VQ(C1, 0, 2, 1); SBAR();
      o[2] = MFMA32(vn[2], pb, o[2]); VQ(C1, 0, 2, 2); SBAR();
      o[3] = MFMA32(vn[3], pb, o[3]); VQ(C1, 0, 2, 3); SBAR(); }
#pragma unroll
    for (int b = 0; b < 4; ++b) vn[b] = VLD(b, 3);
    VDUP(3);
    { const bf16x8 pb = __builtin_bit_cast(bf16x8, pw[2]);
      o[0] = MFMA32(va[0], pb, o[0]); VQ(C1, 8, 3, 0); SBAR();
      o[1] = MFMA32(va[1], pb, o[1]); VQ(C1, 8, 3, 1); SBAR();
      o[2] = MFMA32(va[2], pb, o[2]); VQ(C1, 8, 3, 2); SBAR();
      o[3] = MFMA32(va[3], pb, o[3]); VQ(C1, 8, 3, 3); SBAR(); }
    { const bf16x8 pb = __builtin_bit_cast(bf16x8, pw[3]);
      o[0] = MFMA32(vn[0], pb, o[0]);
      o[1] = MFMA32(vn[1], pb, o[1]);
      o[2] = MFMA32(vn[2], pb, o[2]);
      o[3] = MFMA32(vn[3], pb, o[3]); }
    VUSE();
    lsum += s0 + s1;
#undef VQ
#undef KOFF
#undef VLD
#ifdef PROBE_T3
    if (k3) WAIT_BAR(8); else WAIT_BAR(0);
#else
    if (k3) WAIT_BAR(4); else WAIT_BAR(0);
#endif
    { const int s_ = sl0; sl0 = sl1; sl1 = sl2; sl2 = s_; }
}

__device__ __forceinline__ void attn_unit(LAS unsigned char* lds, const bf16_t* __restrict__ ZA, const bf16_t* __restrict__ ZT, bf16_t* __restrict__ CAT, const float* __restrict__ subg,
                                          float lam, int seqrow0, int slen, int h, int qb) {
    int tid_ = threadIdx.x; asm volatile("" : "+v"(tid_));
    const int tid = tid_, lane = tid & 63, r32 = lane & 31, hi = lane >> 5;
    const int wid = __builtin_amdgcn_readfirstlane(tid >> 6), j = wid >> 2, sub = wid & 3;
    const int qrow = seqrow0 + qb * 128 + sub * 32 + r32;
    bf16x8 qr[4];
#pragma unroll
    for (int d0 = 0; d0 < 4; ++d0) qr[d0] = *(const bf16x8*)(ZA + (size_t)qrow * NZA + 512 + h * 128 + j * 64 + d0 * 16 + hi * 8);
    const bf16_t* ksrc[2]; const bf16_t* vsrc[2];
#pragma unroll
    for (int i = 0; i < 2; ++i) {
        const int pc = 2 * wid + i, jj = pc >> 3, rho = (pc & 7) * 8 + (lane >> 3), cs = lane & 7, dch = cs ^ ((rho >> 1) & 7), kv = (rho & ~15) | swap23(rho & 15);
        ksrc[i] = ZA + (size_t)(seqrow0 + kv) * NZA + 1024 + h * 128 + jj * 64 + dch * 8;
        const int d = pc * 8 + (lane >> 3), vch = cs ^ ((d >> 1) & 7);
        vsrc[i] = ZT + (size_t)(512 + h * 128 + d) * NTOK + seqrow0 + vch * 8;
    }
    const unsigned lds0 = (unsigned)(uintptr_t)lds;
    const unsigned kdma = lds0 + wid * 2048, vdma = lds0 + 16384 + wid * 2048;
    const int NT = slen / 64;
    const int swz = (r32 >> 1) & 7;
#pragma unroll
    for (int i = 0; i < 2; ++i) {
        glds16(ksrc[i], (unsigned)__builtin_amdgcn_readfirstlane(kdma + i * 1024));
        glds16(vsrc[i], (unsigned)__builtin_amdgcn_readfirstlane(vdma + i * 1024));
        glds16(ksrc[i] + (size_t)64 * NZA, (unsigned)__builtin_amdgcn_readfirstlane(kdma + ATT_STAGE + i * 1024));
        glds16(vsrc[i] + 64, (unsigned)__builtin_amdgcn_readfirstlane(vdma + ATT_STAGE + i * 1024));
        glds16(ksrc[i] + (size_t)128 * NZA, (unsigned)__builtin_amdgcn_readfirstlane(kdma + 2 * ATT_STAGE + i * 1024));
    }
    WAIT_BAR(0);
    f32x16 o[4], SA0, SA1, SB0, SB1;
#pragma unroll
    for (int b = 0; b < 4; ++b)
#pragma unroll
        for (int r = 0; r < 16; ++r) o[b][r] = 0.f;
#pragma unroll
    for (int r = 0; r < 16; ++r) { SA0[r] = 0.f; SA1[r] = 0.f; }
    {
        const LAS unsigned char* kb = lds + j * 8192 + r32 * 128;
#pragma unroll
        for (int d0 = 0; d0 < 4; ++d0) {
            const int off = ((2 * d0 + hi) ^ swz) * 16;
            const bf16x8 a0 = *(const LAS bf16x8*)(kb + off), a1 = *(const LAS bf16x8*)(kb + 4096 + off);
            SA0 = MFMA32(a0, qr[d0], SA0); SA1 = MFMA32(a1, qr[d0], SA1);
        }
    }
    float mrun, lsum = 0.f; f32x16 negm;
    {
        float rm = fmaxf(SA0[0], SA1[0]);
#pragma unroll
        for (int r = 1; r < 16; ++r) rm = fmaxf(rm, fmaxf(SA0[r], SA1[r]));
        mrun = half_swap_max(rm);
#pragma unroll
        for (int r = 0; r < 16; ++r) { SA0[r] -= mrun; SA1[r] -= mrun; negm[r] = -mrun; }
    }
    asm volatile("s_nop 15\n\ts_nop 7" : "+v"(SA0), "+v"(SA1));
    WAIT_BAR(0);
    int sl0 = 0, sl1 = ATT_STAGE, sl2 = 2 * ATT_STAGE;
#ifndef NO_ATT_PRIO
    if (wid >= 4) __builtin_amdgcn_s_setprio(1);
#endif
    for (int t = 0; t < NT; t += 2) {
        att_step(lds, t, NT, j, r32, hi, swz, qr, o, SA0, SA1, SB0, SB1, negm, mrun, lsum, ksrc, vsrc, kdma, vdma, sl0, sl1, sl2);
        att_step(lds, t + 1, NT, j, r32, hi, swz, qr, o, SB0, SB1, SA0, SA1, negm, mrun, lsum, ksrc, vsrc, kdma, vdma, sl0, sl1, sl2);
    }
#ifndef NO_ATT_PRIO
    __builtin_amdgcn_s_setprio(0);
#endif
    const float inv = 1.0f / half_swap_sum(lsum);
    LAS float* X = (LAS float*)lds + sub * 4096 + lane;
    if (j == 1) {
        const float f = inv * lam;
#pragma unroll
        for (int b = 0; b < 4; ++b)
#pragma unroll
            for (int r = 0; r < 16; ++r) X[(b * 16 + r) * 64] = o[b][r] * f;
    }
    __syncthreads();
    if (j == 0) {
        float ss = 0.f;
#pragma unroll
        for (int b = 0; b < 4; ++b)
#pragma unroll
            for (int r = 0; r < 16; ++r) { const float v = o[b][r] * inv - X[(b * 16 + r) * 64]; o[b][r] = v; ss += v * v; }
        ss = half_swap_sum(ss);
        const float rs = __builtin_amdgcn_rsqf(ss * (1.0f / 128.0f) + EPS) * (1.0f - LAM_INIT);
        bf16_t* op = CAT + (size_t)qrow * DM + 512 + h * 128;
#pragma unroll
        for (int b = 0; b < 4; ++b)
#pragma unroll
            for (int a = 0; a < 4; ++a) {
                const int d0 = 32 * b + 8 * a + 4 * hi; const f32x4 g = *(const f32x4*)(subg + d0);
                u32x2 w; w.x = cvtpk(o[b][4 * a] * rs * g[0], o[b][4 * a + 1] * rs * g[1]); w.y = cvtpk(o[b][4 * a + 2] * rs * g[2], o[b][4 * a + 3] * rs * g[3]);
                *(u32x2*)(op + d0) = w;
            }
    }
    __syncthreads();
}

__device__ __forceinline__ void gmlp_item(LAS unsigned char* lds, const bf16_t* __restrict__ ZA, const bf16_t* __restrict__ ZT, bf16_t* __restrict__ CAT, const float* __restrict__ Wsg,
                                          const float* __restrict__ vng, const float* __restrict__ bsg, int ck, int g) {
    int tid_ = threadIdx.x; asm volatile("" : "+v"(tid_));
    const int tid = tid_, lane = tid & 63, r32 = lane & 31, hi = lane >> 5;
    const int wid = __builtin_amdgcn_readfirstlane(tid >> 6);
    const int R0 = ck * 128;
    LAS float* red = (LAS float*)(lds + 32768); LAS float* rstd = (LAS float*)(lds + 32768 + 2048);
#pragma unroll
    for (int i = 0; i < 4; ++i) {
        const int c = tid + 512 * i, e = c >> 4, ch = c & 15;
        const u32x4 v = *(const u32x4*)(ZT + (size_t)(g * 128 + e) * NTOK + R0 + ch * 8);
        *(LAS u32x4*)(lds + e * 256 + ((ch ^ (e & 15)) * 16)) = v;
    }
    __syncthreads();
    { const int q = tid & 127, part = tid >> 7; float s = 0.f;
#pragma unroll 8
      for (int ee = 0; ee < 32; ++ee) { const int e = part * 32 + ee; const unsigned short b = *(const LAS unsigned short*)(lds + e * 256 + (((q >> 3) ^ (e & 15)) * 16) + (q & 7) * 2); const float v = __uint_as_float((unsigned)b << 16); s += v * v; }
      red[part * 128 + q] = s; }
    __syncthreads();
    if (tid < 128) rstd[tid] = __builtin_amdgcn_rsqf((red[tid] + red[128 + tid] + red[256 + tid] + red[384 + tid]) * (1.0f / 128.0f) + EPS);
    __syncthreads();
    const int eblk = wid & 3, pb0 = 2 * (wid >> 2);
    f32x16 acc[2];
#pragma unroll
    for (int r = 0; r < 16; ++r) { acc[0][r] = 0.f; acc[1][r] = 0.f; }
#pragma unroll
    for (int kk = 0; kk < 8; ++kk) {
        const bf16x8 a = *(const LAS bf16x8*)(lds + (32 * eblk + r32) * 256 + (((2 * kk + hi) ^ (r32 & 15)) * 16));
        const f32x4 ra = *(const LAS f32x4*)(rstd + 16 * kk + 8 * hi), rb = *(const LAS f32x4*)(rstd + 16 * kk + 8 * hi + 4);
#pragma unroll
        for (int pp = 0; pp < 2; ++pp) {
            const float* wp = Wsg + (size_t)(32 * (pb0 + pp) + r32) * 128 + 16 * kk + 8 * hi;
            const f32x4 wa = *(const f32x4*)wp * ra, wb = *(const f32x4*)(wp + 4) * rb;
            const bf16x8 b = __builtin_bit_cast(bf16x8, pack8(wa, wb));
            acc[pp] = __builtin_amdgcn_mfma_f32_32x32x16_bf16(a, b, acc[pp], 0, 0, 0);
        }
    }
#pragma unroll
    for (int pp = 0; pp < 2; ++pp) {
        const int p = 32 * (pb0 + pp) + r32, row = R0 + p; const float bs = bsg[p];
#pragma unroll
        for (int a4 = 0; a4 < 4; ++a4) {
            const int e0 = 32 * eblk + 8 * a4 + 4 * hi; const f32x4 gv = *(const f32x4*)(vng + e0);
            const u32x2 uu = *(const u32x2*)(ZA + (size_t)row * NZA + g * 128 + e0);
            const float o0 = bflo(uu.x) * (gv[0] * acc[pp][4 * a4] + bs), o1 = bfhi(uu.x) * (gv[1] * acc[pp][4 * a4 + 1] + bs),
                        o2 = bflo(uu.y) * (gv[2] * acc[pp][4 * a4 + 2] + bs), o3 = bfhi(uu.y) * (gv[3] * acc[pp][4 * a4 + 3] + bs);
            u32x2 w; w.x = cvtpk(o0, o1); w.y = cvtpk(o2, o3);
            *(u32x2*)(CAT + (size_t)row * DM + g * 128 + e0) = w;
        }
    }
    __syncthreads();
}

#define XB_TMO      128
#define XB_XCNT(j)  (256  + 64 * (j))
#define XB_XSUB(j)  (1280 + 64 * (j))
#define XB_XGEN(j)  (2304 + 64 * (j))
#define XB_TOP      3328
#define XB_TOPGEN   3392
#define XCD_BAR_WORDS 3456
#define XB_SPIN_CAP (1u << 18)

__device__ __forceinline__ unsigned xb_ld(unsigned* p)              { return __hip_atomic_load(p, __ATOMIC_RELAXED, __HIP_MEMORY_SCOPE_AGENT); }
__device__ __forceinline__ unsigned xb_add(unsigned* p, unsigned v) { return __hip_atomic_fetch_add(p, v, __ATOMIC_RELAXED, __HIP_MEMORY_SCOPE_AGENT); }
__device__ __forceinline__ unsigned xb_xcc_id() { return (unsigned)__builtin_amdgcn_s_getreg((3 << 11) | 20) & 0xFu; }
#define XB_SPIN(cond, bar) do { unsigned _sp = 0; while (cond) { __builtin_amdgcn_s_sleep(1); \
    if ((++_sp & 255u) == 0u) { if (xb_ld(&(bar)[XB_TMO])) break; if (_sp > XB_SPIN_CAP) { atomicAdd(&(bar)[XB_TMO], 1u); break; } } } } while (0)

struct XcdBarrier {
    unsigned* bar; unsigned x;
    volatile LAS unsigned* st;
};

__device__ __forceinline__ XcdBarrier xcd_barrier_post(unsigned* bar, volatile LAS unsigned* st) {
    XcdBarrier b; b.bar = bar; b.x = xb_xcc_id(); b.st = st;
    if (threadIdx.x == 0) (void)xb_add(&bar[XB_XCNT(b.x)], 1u);
    return b;
}
__device__ __forceinline__ void xcd_barrier_complete(unsigned* bar, unsigned x, unsigned& nloc, unsigned& nx) {
    const unsigned G = gridDim.x * gridDim.y * gridDim.z;
    unsigned sum, cnt, mine, sp = 0u;
    for (;;) {
        sum = 0u; cnt = 0u; mine = 0u;
#pragma unroll
        for (unsigned j = 0; j < 16; ++j) { const unsigned c = xb_ld(&bar[XB_XCNT(j)]); sum += c; cnt += (c > 0u) ? 1u : 0u; mine = (j == x) ? c : mine; }
        if (sum == G) break;
        __builtin_amdgcn_s_sleep(1);
        if ((++sp & 255u) == 0u) { if (xb_ld(&bar[XB_TMO])) break; if (sp > XB_SPIN_CAP) { atomicAdd(&bar[XB_TMO], 1u); break; } }
    }
    nloc = mine > 0u ? mine : 1u; nx = cnt > 0u ? cnt : 1u;
}

__device__ __forceinline__ void xcd_barrier(const XcdBarrier& b) {
    asm volatile("s_waitcnt vmcnt(0)" ::: "memory");
    __syncthreads();
    if (threadIdx.x == 0) {
        unsigned* bar = b.bar;
        __builtin_amdgcn_s_waitcnt(0);
        unsigned nloc = b.st[0], nx = b.st[1];
        if (nloc == 0u) { xcd_barrier_complete(bar, b.x, nloc, nx); b.st[0] = nloc; b.st[1] = nx; }
        const unsigned old = xb_add(&bar[XB_XSUB(b.x)], 1u);
        const unsigned gen = old / nloc;
        if (old + 1u == (gen + 1u) * nloc) {
            __builtin_amdgcn_fence(__ATOMIC_RELEASE, "agent");
            asm volatile("s_waitcnt vmcnt(0)" ::: "memory");
            const unsigned og = xb_add(&bar[XB_TOP], 1u);
            const unsigned tg = og / nx;
            if (og + 1u == (tg + 1u) * nx) xb_add(&bar[XB_TOPGEN], 1u);
            else XB_SPIN(xb_ld(&bar[XB_TOPGEN]) == tg, bar);
            __builtin_amdgcn_fence(__ATOMIC_ACQUIRE, "agent");
            xb_add(&bar[XB_XGEN(b.x)], 1u);
            asm volatile("s_waitcnt vmcnt(0)" ::: "memory");
        } else {
            XB_SPIN(xb_ld(&bar[XB_XGEN(b.x)]) == gen, bar);
            __builtin_amdgcn_fence(__ATOMIC_ACQUIRE, "agent");
            asm volatile("s_waitcnt vmcnt(0)" ::: "memory");
        }
    }
    __syncthreads();
}

#define GEMM_RUN(EPI, g, E) do { pg8::StaticOrder S_; S_.init((g).M, (g).N, G, (int)blockIdx.x); pg8::gemm_phase<EPI, pg8::StaticOrder, PG8_ALIGN, PG8_SP2>(lds, (g), S_, (E)); } while (0)
#ifdef USE_CG_FIRST
#define GRID_SYNC0() grid.sync()
#else
#define GRID_SYNC0() do { if (P.ws == nullptr) grid.sync(); xcd_barrier(bar); } while (0)
#endif
#ifdef USE_CG_SYNC
#define GRID_SYNC() grid.sync()
#else
#define GRID_SYNC() xcd_barrier(bar)
#endif
#ifndef PHMASK
#define PHMASK 0xffff
#endif
#define PH(n) (((PHMASK) >> (n)) & 1)
#ifndef REP_P2
#define REP_P2 1
#endif
#ifndef REP_P1
#define REP_P1 1
#endif
#ifndef REP_FFN1
#define REP_FFN1 1
#endif
#ifndef REP_CONV
#define REP_CONV 1
#endif
#ifndef REP_P0
#define REP_P0 1
#endif

__global__ void __launch_bounds__(512) mega_fwd(Params P) {
    extern __shared__ __attribute__((aligned(16))) unsigned char lds_raw[];
    LAS unsigned char* lds = (LAS unsigned char*)lds_raw;
    cg::grid_group grid = cg::this_grid();
    const int tid = threadIdx.x, lane = tid & 63, wave = __builtin_amdgcn_readfirstlane(tid >> 6);
    const int G = gridDim.x, bx = blockIdx.x;
    const int vcu = (G % 8 == 0) ? (bx % 8) * (G / 8) + bx / 8 : bx;
    unsigned char* ws = P.ws;
    const float* x_prompt = P.in[0]; const float* x_sample = P.in[1];
    float* sumsq = (float*)(ws + WS_SUMSQ);
    volatile LAS unsigned* MISC = (volatile LAS unsigned*)(lds + 131072 + 320);
    if (tid < 64) MISC[tid] = 0u;
    __syncthreads();
    XcdBarrier bar = xcd_barrier_post((unsigned*)(ws + WS_BAR), MISC + 8);
    bf16_t* WinT = (bf16_t*)(ws + WS_WIN); bf16_t* WoutT = (bf16_t*)(ws + WS_WOUT); bf16_t* W1T = (bf16_t*)(ws + WS_W1); bf16_t* W2T = (bf16_t*)(ws + WS_W2);
    bf16_t* CinT = (bf16_t*)(ws + WS_CIN); bf16_t* CoutT = (bf16_t*)(ws + WS_COUT); float* rope = (float*)(ws + WS_ROPE);
    bf16_t* ZT = (bf16_t*)(ws + WS_HB); bf16_t* HB = (bf16_t*)(ws + WS_HB);
    bf16_t* XN = (bf16_t*)(ws + WS_BIG); bf16_t* CAT = (bf16_t*)(ws + WS_BIG); bf16_t* HID = (bf16_t*)(ws + WS_BIG);
    bf16_t* TB = (bf16_t*)(ws + WS_BIG); bf16_t* UB = (bf16_t*)(ws + WS_BIG + 64 * MiB);
    bf16_t* ZA = (bf16_t*)P.out; float* H = P.out;
    const int nparts = P.ffn_parts, prows = NTOK / nparts;

    if (PH(0)) {
        LAS float* scr = (LAS float*)(lds + wave * 16384);
        const int gw = vcu * 8 + wave, NGW = G * 8;
        constexpr int I_EIN = 16 * 80, I_EOUT = 16 * 32, I_W1 = 16 * 128, I_W2 = 64 * 32, I_CIN = 16 * 96, I_COUT = 16 * 32;
        constexpr int NITEMS = I_EIN + I_EOUT + 2 * I_W1 + 2 * I_W2 + I_CIN + I_COUT;
        for (int it = gw; it < NITEMS; it += NGW) {
            int r = it;
            if (r < I_EIN) { transpose_item<1>(P.in[6], DM, 2560, WinT, nullptr, scr, r, lane); continue; } r -= I_EIN;
            if (r < I_EOUT) { transpose_item<0>(P.in[7], DM, DM, WoutT, nullptr, scr, r, lane); continue; } r -= I_EOUT;
            if (r < I_W1) { transpose_item<0>(P.in[4], DM, DFF, W1T, P.in[3], scr, r, lane); continue; } r -= I_W1;
            if (r < I_W1) { transpose_item<0>(P.in[4] + (size_t)DM * DFF, DM, DFF, W1T + (size_t)DM * DFF, P.in[3] + DM, scr, r, lane); continue; } r -= I_W1;
            if (r < I_W2) { transpose_item<0>(P.in[5], DFF, DM, W2T, nullptr, scr, r, lane); continue; } r -= I_W2;
            if (r < I_W2) { transpose_item<0>(P.in[5] + (size_t)DM * DFF, DFF, DM, W2T + (size_t)DM * DFF, nullptr, scr, r, lane); continue; } r -= I_W2;
            if (r < I_CIN) { transpose_item<2>(P.in[16], DM, 3072, CinT, P.in[2] + DM, scr, r, lane); continue; } r -= I_CIN;
            transpose_item<0>(P.in[18], DM, DM, CoutT, nullptr, scr, r, lane);
        }
        for (int m = gw; m < NTOK; m += NGW) {
            const float* xr = (m < NPROMPT) ? x_prompt + (size_t)m * DM : x_sample + (size_t)(m - NPROMPT) * DM;
            rms_row_to_bf16(xr, P.in[2], XN + (size_t)m * DM, lane);
        }
        const int gt = vcu * 512 + tid, NGT = G * 512;
        for (int i = gt; i < 4 * NTOK; i += NGT) sumsq[i] = 0.f;
        for (int i = gt; i < 8192 * 8; i += NGT) {
            const int pos = i >> 3, fi = i & 7;
            const float inv = exp2f(-(float)fi * 0.125f * 18.931568569324174f);
            const float ang = (float)pos * inv;
            const double ad = (double)ang; const double kq = rint(ad * 0.15915494309189535); const float rr = (float)(ad - kq * 6.283185307179586);
            rope[pos * 16 + fi] = __cosf(rr); rope[pos * 16 + 8 + fi] = __sinf(rr);
        }
    }
    GRID_SYNC0();

    if (PH(1)) {
        pg8::Gemm ga{XN, WinT, NTOK, 1536, DM}; EpiA ea{ZA, rope};
        pg8::Gemm gb{WinT + (size_t)1536 * DM, XN, 1024, NTOK, DM}; EpiB eb{ZT};
#pragma unroll 1
        for (int rep_ = 0; rep_ < REP_P1; ++rep_) {
        GEMM_RUN(EpiA, ga, ea);
        GEMM_RUN(EpiB, gb, eb);
        }
    }
    GRID_SYNC();

    if (PH(2)) {
        float s1 = 0.f, s2 = 0.f;
        for (int i = 0; i < 64; ++i) { s1 += P.in[11][i] * P.in[12][i]; s2 += P.in[13][i] * P.in[14][i]; }
        const float lam = __expf(s1) - __expf(s2) + LAM_INIT;
        for (int rep_ = 0; rep_ < REP_P2; ++rep_)
        for (int k = vcu; k < 256; k += G) {
#pragma unroll 1
            for (int w = 0; w < 2; ++w) { const int idx = 2 * k + w, bh = idx >> 6, qb = idx & 63; attn_unit(lds, ZA, ZT, CAT, P.in[15], lam, NPROMPT + (bh >> 2) * 8192, 8192, bh & 3, qb); }
#pragma unroll 1
            for (int w = 0; w < 2; ++w) { const int idx = 2 * k + w, bh = idx >> 5, qb = idx & 31; attn_unit(lds, ZA, ZT, CAT, P.in[15], lam, (bh >> 2) * 4096, 4096, bh & 3, qb); }
        }
        for (int it = vcu; it < 1024; it += G) { const int ck = it >> 2, g = it & 3; gmlp_item(lds, ZA, ZT, CAT, P.in[9] + (size_t)g * 16384, P.in[8] + g * 128, P.in[10] + g * 128, ck, g); }
    }
    GRID_SYNC();

    if (PH(3)) {
        pg8::Gemm g{CAT, WoutT, NTOK, DM, DM}; EpiRes<0> e{x_prompt, x_sample - (size_t)NPROMPT * DM, H, HB, sumsq, 0};
        GEMM_RUN(EpiRes<0>, g, e);
    }
    GRID_SYNC();

#pragma unroll 1
    for (int hf = 0; hf < nparts && PH(4); ++hf) {
        if (PH(10)) { pg8::Gemm g{HB + (size_t)hf * prows * DM, W1T, prows, DFF, DM}; EpiFfn1 e{HID, sumsq, hf * prows};
#pragma unroll 1
          for (int rep_ = 0; rep_ < REP_FFN1; ++rep_) GEMM_RUN(EpiFfn1, g, e); }
        GRID_SYNC();
        if (PH(11)) { pg8::Gemm g{HID, W2T, prows, DM, DFF}; EpiRes<1> e{nullptr, nullptr, H, HB, sumsq + NTOK, hf * prows}; GEMM_RUN(EpiRes<1>, g, e); }
        GRID_SYNC();
    }

    if (PH(5)) { pg8::Gemm g{HB, CinT, NTOK, 2048, DM}; EpiConvT e{TB, sumsq + NTOK};
#pragma unroll 1
      for (int rep_ = 0; rep_ < REP_CONV; ++rep_) GEMM_RUN(EpiConvT, g, e); }
    GRID_SYNC();
    if (PH(6)) { pg8::Gemm g{HB, CinT + (size_t)2048 * DM, NTOK, DM, DM}; EpiConvU e{UB, TB, sumsq + NTOK, P.in[17]};
#pragma unroll 1
      for (int rep_ = 0; rep_ < REP_CONV; ++rep_) GEMM_RUN(EpiConvU, g, e); }
    GRID_SYNC();
    if (PH(7)) { pg8::Gemm g{UB, CoutT, NTOK, DM, DM}; EpiRes<1> e{nullptr, nullptr, H, HB, sumsq + 2 * NTOK, 0}; GEMM_RUN(EpiRes<1>, g, e); }
    GRID_SYNC();

#pragma unroll 1
    for (int hf = 0; hf < nparts && PH(8); ++hf) {
        { pg8::Gemm g{HB + (size_t)hf * prows * DM, W1T + (size_t)DM * DFF, prows, DFF, DM}; EpiFfn1 e{HID, sumsq + 2 * NTOK, hf * prows};
#pragma unroll 1
          for (int rep_ = 0; rep_ < REP_FFN1; ++rep_) GEMM_RUN(EpiFfn1, g, e); }
        GRID_SYNC();
        { pg8::Gemm g{HID, W2T + (size_t)DM * DFF, prows, DM, DFF}; EpiRes<1> e{nullptr, nullptr, H, HB, sumsq + 3 * NTOK, hf * prows}; GEMM_RUN(EpiRes<1>, g, e); }
        GRID_SYNC();
    }

    if (PH(9)) {
        const int gw = vcu * 8 + wave, NGW = G * 8; const float* fg = P.in[19];
        for (int m = gw; m < NTOK; m += NGW) {
            const float rs = 1.0f / sqrtf(sumsq[3 * NTOK + m] * (1.0f / DM) + EPS);
            const u32x4* br = (const u32x4*)(HB + (size_t)m * DM) + lane; float* hr = H + (size_t)m * DM + 8 * lane; const float* gr = fg + 8 * lane;
#pragma unroll
            for (int jx = 0; jx < 2; ++jx) { f32x4 a, b; unpack8(br[64 * jx], a, b);
                *(f32x4*)(hr + 512 * jx) = a * rs * *(const f32x4*)(gr + 512 * jx); *(f32x4*)(hr + 512 * jx + 4) = b * rs * *(const f32x4*)(gr + 512 * jx + 4); }
        }
    }
}

extern "C" void kernel_launch(void* const* d_in, const int* in_sizes, int n_in, void* d_out, int out_size, void* d_ws, size_t ws_size, hipStream_t stream) {
    static int grid = 0;
    if (grid == 0) {
        if (n_in != 20 || out_size != NTOK * DM || ws_size < WS_END) { fprintf(stderr, "kernel_launch: unexpected shapes (n_in %d out %d ws %zu)\n", n_in, out_size, ws_size); grid = -1; return; }
        int dev = 0, cus = 0, per_cu = 0;
        hipGetDevice(&dev); hipDeviceGetAttribute(&cus, hipDeviceAttributeMultiprocessorCount, dev);
        if (hipFuncSetAttribute((const void*)mega_fwd, hipFuncAttributeMaxDynamicSharedMemorySize, LDS_BYTES) != hipSuccess) { fprintf(stderr, "kernel_launch: hipFuncSetAttribute failed\n"); grid = -1; return; }
        if (hipOccupancyMaxActiveBlocksPerMultiprocessor(&per_cu, (const void*)mega_fwd, 512, LDS_BYTES) != hipSuccess || per_cu < 1) { fprintf(stderr, "kernel_launch: occupancy query says %d\n", per_cu); per_cu = 1; }
        (void)hipGetLastError();
        grid = cus * per_cu;
    }
    if (grid < 0) return;
    if (hipMemsetAsync((char*)d_ws + WS_BAR, 0, BAR_BYTES, stream) != hipSuccess) { fprintf(stderr, "kernel_launch: memset failed\n"); return; }
    Params p{};
    for (int i = 0; i < 20; ++i) p.in[i] = (const float*)d_in[i];
    p.out = (float*)d_out; p.ws = (unsigned char*)d_ws;
    p.ffn_parts = 2;
    void* args[] = {&p};
    hipError_t e = hipLaunchCooperativeKernel((const void*)mega_fwd, dim3(grid), dim3(512), args, LDS_BYTES, stream);
    if (e != hipSuccess) fprintf(stderr, "kernel_launch: cooperative launch failed: %s (grid %d)\n", hipGetErrorString(e), grid);
}
```
